# Optimizing an MI355X kernel written in HIP

```python
import math
import jax, jax.numpy as jnp
from jax import lax
import numpy as np

D_MODEL = 1024
BATCH = 4
SEQ = 4096
DEPTH = 1

POOL_WIDTH = 512
POOL_WINDOWS = (2, 4, 8, 16)
POOL_GROUPS = len(POOL_WINDOWS)
POOL_GROUP_WIDTH = POOL_WIDTH // POOL_GROUPS
N_HEADS = 8
HEAD_DIM = 64
ATTN_WIDTH = N_HEADS * HEAD_DIM
N_IDX_HEADS = 4
IDX_DIM = 64
IDX_SCALE = (IDX_DIM ** -0.5) * (N_IDX_HEADS ** -0.5)
ATTN_SCALE = HEAD_DIM ** -0.5
TOPK_MAX = 256
Q_BLOCK = 128
REL_BUCKETS = 32
REL_MAX_DIST = 128
N_BRANCHES = 2
N_EXPERTS = 32
TOP_K_EXPERTS = 4
D_FF = D_MODEL
SWIGLU_LIMIT = 7.0
SWIGLU_ALPHA = 1.702
RMS_EPS = 1e-5
NEG_BIG = -1e30
SPLIT_SIZES = (POOL_WIDTH, ATTN_WIDTH, ATTN_WIDTH, ATTN_WIDTH,
               N_IDX_HEADS * IDX_DIM, IDX_DIM, N_IDX_HEADS, N_BRANCHES * D_MODEL)
D_IN = sum(SPLIT_SIZES)

kernel_name = "hybrid_pool_dsa_gated_moe_block"


def rmsnorm(x, g):
    xf = x.astype(jnp.float32)
    y = xf * lax.rsqrt(jnp.mean(xf * xf, axis=-1, keepdims=True) + RMS_EPS)
    return (y * g.astype(jnp.float32)).astype(x.dtype)


def pool_mixer(u, w_grp, scale):
    b, s, _ = u.shape
    uf = u.astype(jnp.float32).reshape(b, s, POOL_GROUPS, POOL_GROUP_WIDTH)
    csum = lax.cumsum(uf, axis=1)
    t = jnp.arange(s)
    outs = []
    for g, w in enumerate(POOL_WINDOWS):
        cg = csum[:, :, g]
        shifted = jnp.pad(cg, ((0, 0), (w, 0), (0, 0)))[:, :s]
        cnt = jnp.minimum(t + 1, w).astype(jnp.float32)[None, :, None]
        outs.append((cg - shifted) / cnt - uf[:, :, g])
    pooled = jnp.stack(outs, axis=2)
    mixed = jnp.einsum('bsgc,gcd->bsgd', pooled, w_grp.astype(jnp.float32))
    mixed = mixed * scale.astype(jnp.float32).reshape(POOL_GROUPS, POOL_GROUP_WIDTH)
    return mixed.reshape(b, s, POOL_WIDTH).astype(u.dtype)


def rel_bucket(dist):
    n = jnp.maximum(dist, 0)
    max_exact = REL_BUCKETS // 2
    nf = jnp.maximum(n, 1).astype(jnp.float32)
    large = max_exact + (jnp.log(nf / max_exact) / math.log(REL_MAX_DIST / max_exact)
                         * (REL_BUCKETS - max_exact)).astype(jnp.int32)
    large = jnp.minimum(large, REL_BUCKETS - 1)
    return jnp.where(n < max_exact, n, large)


def dsa_attention(q, k, v, qi, ki, wi, rel_table):
    b, s = q.shape[0], q.shape[1]
    topk = min(TOPK_MAX, s // 4)
    nb = s // Q_BLOCK
    key_pos = jnp.arange(s)
    ki_f = ki.astype(jnp.float32)
    table = rel_table.astype(jnp.float32)
    gather = jax.vmap(lambda a, i: a[i])

    def to_blocks(a):
        return a.reshape((b, nb, Q_BLOCK) + a.shape[2:]).swapaxes(0, 1)

    def block_fn(args):
        qb, qib, wib, start = args
        t = start + jnp.arange(Q_BLOCK)
        sc = jnp.einsum('bqhd,bsd->bqhs', qib.astype(jnp.float32), ki_f)
        score = jnp.einsum('bqhs,bqh->bqs', jax.nn.relu(sc), wib.astype(jnp.float32)) * IDX_SCALE
        causal = key_pos[None, :] <= t[:, None]
        score = jnp.where(causal[None], score, -jnp.inf)
        _, idx = lax.top_k(score, topk)
        valid = idx <= t[None, :, None]
        k_sel = gather(k, idx).astype(jnp.float32)
        v_sel = gather(v, idx).astype(jnp.float32)
        logits = jnp.einsum('bqhd,bqkhd->bqhk', qb.astype(jnp.float32), k_sel) * ATTN_SCALE
        bias = table[rel_bucket(t[None, :, None] - idx)]
        logits = logits + bias.transpose(0, 1, 3, 2)
        logits = jnp.where(valid[:, :, None, :], logits, NEG_BIG)
        p = jax.nn.softmax(logits, axis=-1)
        out = jnp.einsum('bqhk,bqkhd->bqhd', p, v_sel)
        return out.astype(q.dtype)

    starts = jnp.arange(nb, dtype=jnp.int32) * Q_BLOCK
    outs = lax.map(block_fn, (to_blocks(q), to_blocks(qi), to_blocks(wi), starts))
    return outs.swapaxes(0, 1).reshape(b, s, ATTN_WIDTH)


def moe(h, w_router, b_router, w1, b1, w2, b2):
    b, s, d = h.shape
    hf = h.reshape(b * s, d)
    logits = hf.astype(jnp.float32) @ w_router.astype(jnp.float32) + b_router.astype(jnp.float32)
    top_vals, top_idx = lax.top_k(logits, TOP_K_EXPERTS)
    gates = jax.nn.softmax(top_vals, axis=-1)
    combine = jnp.sum(jax.nn.one_hot(top_idx, N_EXPERTS, dtype=jnp.float32) * gates[..., None], axis=1)
    out = jnp.zeros((b * s, d), jnp.float32)
    for e in range(N_EXPERTS):
        gu = hf @ w1[e] + b1[e]
        g_ = jnp.minimum(gu[:, :D_FF].astype(jnp.float32), SWIGLU_LIMIT)
        u_ = jnp.clip(gu[:, D_FF:].astype(jnp.float32), -SWIGLU_LIMIT, SWIGLU_LIMIT)
        act = (g_ * jax.nn.sigmoid(SWIGLU_ALPHA * g_) * (u_ + 1.0)).astype(h.dtype)
        out = out + combine[:, e:e + 1] * (act @ w2[e] + b2[e]).astype(jnp.float32)
    return out.reshape(b, s, d).astype(h.dtype)


def setup_inputs(seed: int = 0) -> dict:
    key = jax.random.key(seed)
    ks = jax.random.split(key, 20)
    f32 = jnp.float32
    nrm = lambda k, shape, sc: jax.random.normal(k, shape, f32) * sc
    return {
        "x": nrm(ks[0], (BATCH, SEQ, D_MODEL), 1.0),
        "mix_norm": 1.0 + nrm(ks[1], (DEPTH, D_MODEL), 0.02),
        "w_in": nrm(ks[2], (DEPTH, D_MODEL, D_IN), D_MODEL ** -0.5),
        "pool_w": nrm(ks[3], (DEPTH, POOL_GROUPS, POOL_GROUP_WIDTH, POOL_GROUP_WIDTH), POOL_GROUP_WIDTH ** -0.5),
        "pool_scale": 1.0 + nrm(ks[4], (DEPTH, POOL_WIDTH), 0.1),
        "w_branch_pool": nrm(ks[5], (DEPTH, POOL_WIDTH, D_MODEL), POOL_WIDTH ** -0.5),
        "w_branch_attn": nrm(ks[6], (DEPTH, ATTN_WIDTH, D_MODEL), ATTN_WIDTH ** -0.5),
        "rel_bias": nrm(ks[7], (REL_BUCKETS, N_HEADS), 0.5),
        "w_out": nrm(ks[8], (DEPTH, D_MODEL, D_MODEL), D_MODEL ** -0.5),
        "ffn_norm": 1.0 + nrm(ks[9], (DEPTH, D_MODEL), 0.02),
        "w_router": nrm(ks[10], (DEPTH, D_MODEL, N_EXPERTS), D_MODEL ** -0.5),
        "b_router": nrm(ks[11], (DEPTH, N_EXPERTS), 0.01),
        "w1": nrm(ks[12], (DEPTH, N_EXPERTS, D_MODEL, 2 * D_FF), D_MODEL ** -0.5),
        "b1": nrm(ks[13], (DEPTH, N_EXPERTS, 2 * D_FF), 0.01),
        "w2": nrm(ks[14], (DEPTH, N_EXPERTS, D_FF, D_MODEL), D_FF ** -0.5),
        "b2": nrm(ks[15], (DEPTH, N_EXPERTS, D_MODEL), 0.01),
        "final_norm": 1.0 + nrm(ks[16], (D_MODEL,), 0.02),
    }


def reference(x, mix_norm, w_in, pool_w, pool_scale, w_branch_pool, w_branch_attn, rel_bias,
              w_out, ffn_norm, w_router, b_router, w1, b1, w2, b2, final_norm):
    b, s, _ = x.shape
    offsets = [int(o) for o in np.cumsum(SPLIT_SIZES)[:-1]]
    for l in range(DEPTH):
        h = rmsnorm(x, mix_norm[l])
        z = h @ w_in[l]
        z_pool, z_q, z_k, z_v, z_qi, z_ki, z_wi, z_gate = jnp.split(z, offsets, axis=-1)
        y_pool = pool_mixer(z_pool, pool_w[l], pool_scale[l]) @ w_branch_pool[l]
        q = z_q.reshape(b, s, N_HEADS, HEAD_DIM)
        k = z_k.reshape(b, s, N_HEADS, HEAD_DIM)
        v = z_v.reshape(b, s, N_HEADS, HEAD_DIM)
        qi = z_qi.reshape(b, s, N_IDX_HEADS, IDX_DIM)
        y_attn = dsa_attention(q, k, v, qi, z_ki, z_wi, rel_bias) @ w_branch_attn[l]
        gates = jax.nn.sigmoid(z_gate.astype(jnp.float32)).reshape(b, s, N_BRANCHES, D_MODEL)
        merged = gates[:, :, 0] * y_pool.astype(jnp.float32) + gates[:, :, 1] * y_attn.astype(jnp.float32)
        x = x + merged.astype(x.dtype) @ w_out[l]
        h2 = rmsnorm(x, ffn_norm[l])
        x = x + moe(h2, w_router[l], b_router[l], w1[l], b1[l], w2[l], b2[l])
    return rmsnorm(x, final_norm)
```

```cpp
#include <hip/hip_runtime.h>
#include <cstdio>
#include <cstdint>
#include <hip/hip_bf16.h>
#include <cmath>
#ifndef DUP
#define DUP 0
#endif
#define REP(k) for (int rep_ = 0; rep_ < 1 + ((DUP >> (k)) & 1); ++rep_)

#define LAS __attribute__((address_space(3)))
#define GAS __attribute__((address_space(1)))
typedef unsigned short bf16;
typedef short bf16x8 __attribute__((ext_vector_type(8)));
typedef float f32x4 __attribute__((ext_vector_type(4)));
typedef float f32x2 __attribute__((ext_vector_type(2)));
typedef float f32x16 __attribute__((ext_vector_type(16)));
typedef unsigned u32x4 __attribute__((ext_vector_type(4)));
typedef unsigned u32x2 __attribute__((ext_vector_type(2)));
typedef unsigned long long u64;

constexpr int NB = 4, SEQ = 4096, NTOK = NB * SEQ, D = 1024;
constexpr int DIN = 4420, DINP = 4608;
constexpr int NE = 32, DFF = 1024, TOPK = 256;
constexpr float RMS_EPS = 1e-5f;
constexpr float LOG2E = 1.4426950408889634f;
constexpr float QSCALE = 0.125f * LOG2E;
constexpr int ACT_ROWS = 73728;
constexpr int NWAVES = 8;

constexpr size_t MiB = 1u << 20;
constexpr size_t WS_CTL = 0, CTL_ZERO_BYTES = 96 * 1024;
constexpr size_t WS_WIN = 2 * MiB;
constexpr size_t WS_WINI = 6 * MiB;
constexpr size_t WS_H8X = 80 * MiB;
constexpr size_t WS_WPC = 11 * MiB;
constexpr size_t WS_WBA = 12 * MiB;
constexpr size_t WS_WOUT = 13 * MiB;
constexpr size_t WS_W1 = 16 * MiB;
constexpr size_t WS_W2 = 144 * MiB;
constexpr size_t WS_H = 208 * MiB;
constexpr size_t WS_ZPOOL = 240 * MiB;
constexpr size_t WS_Q = 256 * MiB, WS_K = 272 * MiB, WS_V = 288 * MiB;
constexpr size_t WS_QI = 304 * MiB;
constexpr size_t WS_KI = 312 * MiB;
constexpr size_t WS_WI = 314 * MiB;
constexpr size_t WS_GATE = 316 * MiB;
constexpr size_t WS_POOLED = 380 * MiB;
constexpr size_t WS_AO = 396 * MiB;
constexpr size_t WS_MERGED = 412 * MiB;
constexpr size_t WS_X1 = 444 * MiB;
constexpr size_t WS_SC = 508 * MiB;
constexpr size_t WS_YS = 508 * MiB;
constexpr size_t WS_MASK = 764 * MiB;
constexpr size_t WS_SELIDX = 772 * MiB;
constexpr size_t WS_TOKGATE = 788 * MiB;
constexpr size_t WS_LIST = 790 * MiB;
constexpr size_t WS_ACT = 792 * MiB;
constexpr size_t WS_END = 936 * MiB;
constexpr int CW_BAR = 4096;
constexpr int CW_ECNT = 16384;

constexpr int RING_BYTES = 131072;
constexpr int LDSCTL_OFF = RING_BYTES, MISC_OFF = LDSCTL_OFF + 320;
constexpr int TAB_OFF = RING_BYTES + 1024;
constexpr int LDS_BYTES = 163840;
constexpr int BIAS_OFF = TAB_OFF + 14336;

#define RLX_AGENT __ATOMIC_RELAXED, __HIP_MEMORY_SCOPE_AGENT
#define LDS_WAIT() asm volatile("s_waitcnt lgkmcnt(0)" ::: "memory")
#define VM_WAIT() asm volatile("s_waitcnt vmcnt(0)" ::: "memory")
__device__ __forceinline__ unsigned f2bf(float f) { unsigned u = __builtin_bit_cast(unsigned, f); return (u + 0x7fffu + ((u >> 16) & 1u)) >> 16; }
__device__ __forceinline__ unsigned pk2(float lo, float hi) { return f2bf(lo) | (f2bf(hi) << 16); }
__device__ __forceinline__ float bflo(unsigned w) { return __uint_as_float(w << 16); }
__device__ __forceinline__ float bfhi(unsigned w) { return __uint_as_float(w & 0xffff0000u); }
__device__ __forceinline__ unsigned cvt_pk_bf16(float lo, float hi) { unsigned r; asm volatile("v_cvt_pk_bf16_f32 %0, %1, %2" : "=v"(r) : "v"(lo), "v"(hi)); return r; }
#define DPPF(v, ctrl, rmask) __int_as_float(__builtin_amdgcn_update_dpp(0, __float_as_int(v), ctrl, rmask, 0xf, false))
#define DPPU(v, ctrl, rmask) ((unsigned)__builtin_amdgcn_update_dpp(0, (int)(v), ctrl, rmask, 0xf, false))
__device__ __forceinline__ float wave_sum(float v) {
    v += DPPF(v, 0x111, 0xf); v += DPPF(v, 0x112, 0xf); v += DPPF(v, 0x114, 0xf); v += DPPF(v, 0x118, 0xf); v += DPPF(v, 0x142, 0xa); v += DPPF(v, 0x143, 0xc);
    return __int_as_float(__builtin_amdgcn_readlane(__float_as_int(v), 63));
}
__device__ __forceinline__ unsigned wave_max_u32(unsigned v) {
    v = max(v, DPPU(v, 0x111, 0xf)); v = max(v, DPPU(v, 0x112, 0xf)); v = max(v, DPPU(v, 0x114, 0xf)); v = max(v, DPPU(v, 0x118, 0xf)); v = max(v, DPPU(v, 0x142, 0xa)); v = max(v, DPPU(v, 0x143, 0xc));
    return (unsigned)__builtin_amdgcn_readlane((int)v, 63);
}
__device__ __forceinline__ float sigmoidf_(float x) { return __builtin_amdgcn_rcpf(1.0f + __builtin_amdgcn_exp2f(x * -1.4426950408889634f)); }

namespace pg8 {
constexpr int BM = 256, BK = 64, HALF = 128, HTB = HALF * BK * 2, STAGE_BYTES = 8 * HTB, NXCD = 8, WGM = 8;
__host__ __device__ __forceinline__ int lds_byte(int r, int c) { const int st = (r >> 4) * 2 + (c >> 5), rr = r & 15, cc = c & 31, ob = rr * 64 + cc * 2; return st * 1024 + (ob ^ (((ob >> 9) & 1) << 5)); }
__host__ __device__ __forceinline__ void stage_rc(int b, int& R, int& C) { const int st = b / 1024, sb = b % 1024, swz = sb ^ (((sb >> 9) & 1) << 5); R = (st >> 1) * 16 + swz / 64; C = (st & 1) * 32 + (swz % 64) / 2; }
__host__ __device__ __forceinline__ int perm32(int rho) { const int n = rho >> 4, i = rho & 15; return 8 * (i >> 2) + 4 * n + (i & 3); }

struct LaneRC { int R[2], C[2]; };
struct Unit { unsigned aoff[2][2]; const char* b0; const char* b1; int row0; int pn; int aux; int aux2; int aux3; int raw; };

__device__ __forceinline__ int xcd_remap(int L, int nwg) { const int q = nwg / NXCD, r = nwg % NXCD, xcd = L % NXCD, off = L / NXCD; return (xcd < r ? xcd * (q + 1) : r * (q + 1) + (xcd - r) * q) + off; }

struct DenseSched {
    int nM, nN, nwg, G, c, K; const char* Bt;
    __device__ __forceinline__ void init(int M, int N, int K_, const void* Bt_, int G_, int c_, int split_ = 0) { nM = M / BM; nN = N / BM; nwg = nM * nN; G = G_; c = c_; K = K_; Bt = (const char*)Bt_; split = (split_ && G_ == 256 && nwg == 896) ? 1 : 0; }
    int split;
    __device__ __forceinline__ bool next(int i, Unit& u, const LaneRC& rc) const {
        long L = (long)i * G + c;
        if (split) { if (i >= 3) { if (c < 128 || i >= 4) return false; L = 768 + (c - 128); } }
        if (L >= nwg) return false;
        const int wgid = xcd_remap((int)L, nwg);
        const int nig = WGM * nN, gid = wgid / nig, fm = gid * WGM, gsz = (nM - fm) < WGM ? (nM - fm) : WGM;
        const int pm = fm + ((wgid % nig) % gsz), pn = (wgid % nig) / gsz;
#pragma unroll
        for (int h = 0; h < 2; ++h)
#pragma unroll
            for (int i2 = 0; i2 < 2; ++i2) u.aoff[h][i2] = (unsigned)((pm * BM + h * HALF + rc.R[i2]) * K + rc.C[i2]) * 2u;
        u.b0 = Bt + (size_t)pn * BM * K * 2; u.b1 = u.b0 + (size_t)HALF * K * 2; u.row0 = pm * BM; u.pn = pn; u.aux = 0; u.aux2 = 0; u.aux3 = 0; u.raw = 0; return true;
    }
    __device__ __forceinline__ void finish(Unit&, const LaneRC&) const {}
};

typedef int i32x8 __attribute__((ext_vector_type(8))); typedef int i32x4 __attribute__((ext_vector_type(4)));
template <bool FP8> struct FragT;
template <> struct FragT<false> { struct type { bf16x8 k[2]; };
    static __device__ __forceinline__ void load(type& d, const LAS unsigned char* p) { d.k[0] = *(const LAS bf16x8*)p; d.k[1] = *(const LAS bf16x8*)(p + 1024); }
    static __device__ __forceinline__ f32x4 mma16(const type& b, const type& a, f32x4 c, int k) { return __builtin_amdgcn_mfma_f32_16x16x32_bf16(b.k[k], a.k[k], c, 0, 0, 0); }
    static __device__ __forceinline__ f32x4 mma8(const type&, const type&, f32x4 c, int, int) { return c; } };
template <> struct FragT<true> { typedef i32x8 type;
    static __device__ __forceinline__ void load(type& d, const LAS unsigned char* p) { const i32x4 lo = *(const LAS i32x4*)p, hi = *(const LAS i32x4*)(p + 1024); d = __builtin_shufflevector(lo, hi, 0, 1, 2, 3, 4, 5, 6, 7); }
    static __device__ __forceinline__ f32x4 mma16(const type&, const type&, f32x4 c, int) { return c; }
    static __device__ __forceinline__ f32x4 mma8(const type& b, const type& a, f32x4 c, int scw, int sca) { asm volatile("v_mfma_scale_f32_16x16x128_f8f6f4 %0, %1, %2, %0, %3, %4 op_sel_hi:[0,0,0]" : "+v"(c) : "v"(b), "v"(a), "v"(scw), "v"(sca)); return c; } };
template <class Epi, class Sched, bool ALIGN_EPI, bool FP8 = false, int SCW = 0x7f7f7f7f, int SCA = 0x7f7f7f7f>
__device__ __forceinline__ void gemm_phase(LAS unsigned char* lds, const char* gA, const int K, const Sched& S, const Epi& E) {
    int tid_ = threadIdx.x; asm volatile("" : "+v"(tid_));
    const int tid = tid_, wid = __builtin_amdgcn_readfirstlane(tid >> 6), lane = tid & 63, wr = wid >> 2, wc = wid & 3, fr = lane & 15, fq = lane >> 4;
    const int nt = K / BK;
    LaneRC rc; unsigned voffB[2];
#pragma unroll
    for (int i = 0; i < 2; ++i) { int R, C; stage_rc(tid * 16 + i * 8192, R, C); rc.R[i] = R; rc.C[i] = C; const int Rb = Epi::PERM ? ((R & ~31) + perm32(R & 31)) : R; voffB[i] = (unsigned)(Rb * K + C) * 2u; }
    const size_t kstep = (size_t)(BK * 2);
    const unsigned ldsw = (unsigned)wid * 1024u;
    const int aoff = lds_byte(wr * 64 + fr, fq * 8), boff = lds_byte(wc * 32 + fr, fq * 8);
#define PG8_SA(b, h) (((b) * 2 + (h)) * HTB)
#define PG8_SB(b, h) ((4 + (b) * 2 + (h)) * HTB)
#define PG8_STAGE(bufoff, gbase, voff) do { _Pragma("unroll") for (int _i = 0; _i < 2; ++_i) \
        __builtin_amdgcn_global_load_lds((const unsigned*)((const char*)(gbase) + (voff)[_i]), (LAS unsigned*)(lds + (bufoff) + ldsw + _i * 8192), 16, 0, 0); } while (0)
#define PG8_LDA(dst, b, h) do { _Pragma("unroll") for (int m = 0; m < 4; ++m) FragT<FP8>::load(dst[m], lds + PG8_SA(b, h) + aoff + m * 2048); } while (0)
#define PG8_LDB(dst, b, h) do { _Pragma("unroll") for (int n = 0; n < 2; ++n) FragT<FP8>::load(dst[n], lds + PG8_SB(b, h) + boff + n * 2048); } while (0)
#define PG8_MMA(ai, bj, At, Bt) do { __builtin_amdgcn_s_setprio(1); \
        if constexpr (FP8) { _Pragma("unroll") for (int m = 0; m < 4; ++m) _Pragma("unroll") for (int n = 0; n < 2; ++n) \
            acc[ai][bj][m][n] = FragT<FP8>::mma8(Bt[n], At[m], acc[ai][bj][m][n], SCW, SCA); } \
        else { _Pragma("unroll") for (int m = 0; m < 4; ++m) _Pragma("unroll") for (int n = 0; n < 2; ++n) _Pragma("unroll") for (int k = 0; k < 2; ++k) \
            acc[ai][bj][m][n] = FragT<FP8>::mma16(Bt[n], At[m], acc[ai][bj][m][n], k); } \
        __builtin_amdgcn_s_setprio(0); } while (0)
#define PG8_WAIT_V(n) asm volatile("s_waitcnt vmcnt(" #n ")" ::: "memory")
#define PG8_WAIT_L(n) asm volatile("s_waitcnt lgkmcnt(" #n ")" ::: "memory")
#define PG8_BAR __builtin_amdgcn_s_barrier()
#define PG8_SCHED __builtin_amdgcn_sched_barrier(0)
    Unit cur, nxt; int ui = 0;
    if (!S.next(0, cur, rc)) return;
    S.finish(cur, rc);
    f32x4 acc[2][2][4][2];
#pragma unroll
    for (int a = 0; a < 2; ++a)
#pragma unroll
        for (int b = 0; b < 2; ++b)
#pragma unroll
            for (int m = 0; m < 4; ++m)
#pragma unroll
                for (int n = 0; n < 2; ++n) acc[a][b][m][n] = (f32x4){0.f, 0.f, 0.f, 0.f};
    typedef typename FragT<FP8>::type frag_t;
    frag_t At[4], B0[2], B1[2];
    PG8_STAGE(PG8_SB(0, 0), cur.b0, voffB); PG8_STAGE(PG8_SB(0, 1), cur.b1, voffB); PG8_STAGE(PG8_SA(0, 0), gA, cur.aoff[0]); PG8_STAGE(PG8_SA(0, 1), gA, cur.aoff[1]);
    if (wr == 1) PG8_BAR;
    PG8_WAIT_V(2); PG8_BAR;
    PG8_STAGE(PG8_SB(1, 0), cur.b0 + kstep, voffB); PG8_STAGE(PG8_SA(1, 0), gA + kstep, cur.aoff[0]); PG8_STAGE(PG8_SB(1, 1), cur.b1 + kstep, voffB);
    PG8_WAIT_V(6); PG8_BAR;
    for (;;) {
        const bool has_next = S.next(ui + 1, nxt, rc);
        if (!has_next) nxt = cur;
#define PG8_TRIP(A1, A2, AO2, B2_0, B2_1) do { \
            const char* a1 = (A1); const char* a2 = (A2); const char* b2_0 = (B2_0); const char* b2_1 = (B2_1); const char* a3 = a2 + kstep; const char* b3_0 = b2_0 + kstep; const char* b3_1 = b2_1 + kstep; \
              \
            PG8_LDB(B0, 0, 0); PG8_LDB(B1, 0, 1); PG8_SCHED; PG8_LDA(At, 0, 0); PG8_STAGE(PG8_SA(1, 1), a1, cur.aoff[1]); \
            PG8_WAIT_V(8); PG8_WAIT_L(0); PG8_BAR; PG8_MMA(0, 0, At, B0); PG8_MMA(0, 1, At, B1); PG8_BAR; PG8_SCHED; \
              \
            PG8_LDA(At, 0, 1); PG8_STAGE(PG8_SB(0, 0), b2_0, voffB); PG8_STAGE(PG8_SB(0, 1), b2_1, voffB); PG8_STAGE(PG8_SA(0, 0), a2, (AO2)[0]); \
            PG8_WAIT_V(8); PG8_WAIT_L(0); PG8_BAR; PG8_MMA(1, 0, At, B0); PG8_MMA(1, 1, At, B1); PG8_BAR; PG8_SCHED; \
              \
            PG8_LDB(B0, 1, 0); PG8_LDB(B1, 1, 1); PG8_SCHED; PG8_LDA(At, 1, 0); PG8_STAGE(PG8_SA(0, 1), a2, (AO2)[1]); \
            PG8_WAIT_V(8); PG8_WAIT_L(0); PG8_BAR; PG8_MMA(0, 0, At, B0); PG8_MMA(0, 1, At, B1); PG8_BAR; PG8_SCHED; \
              \
            PG8_LDA(At, 1, 1); PG8_STAGE(PG8_SB(1, 0), b3_0, voffB); PG8_STAGE(PG8_SB(1, 1), b3_1, voffB); PG8_STAGE(PG8_SA(1, 0), a3, (AO2)[0]); \
            PG8_WAIT_V(8); PG8_WAIT_L(0); PG8_BAR; PG8_MMA(1, 0, At, B0); PG8_MMA(1, 1, At, B1); PG8_BAR; PG8_SCHED; } while (0)
#pragma unroll 1
        for (int t = 0; t < nt; t += 2) {
            const bool last = (t == nt - 2);
            unsigned ao2[2][2];
#pragma unroll
            for (int h = 0; h < 2; ++h)
#pragma unroll
                for (int i2 = 0; i2 < 2; ++i2) ao2[h][i2] = last ? nxt.aoff[h][i2] : cur.aoff[h][i2];
            PG8_TRIP(gA + (size_t)(t + 1) * kstep, last ? gA : gA + (size_t)(t + 2) * kstep, ao2, last ? nxt.b0 : cur.b0 + (size_t)(t + 2) * kstep, last ? nxt.b1 : cur.b1 + (size_t)(t + 2) * kstep);
        }
        if constexpr (ALIGN_EPI) { if (wr == 0) PG8_BAR; }
        if constexpr (FP8) asm volatile("s_nop 15\n\ts_nop 7" ::: "memory");
        E(acc, cur, wr, wc, fr, fq);
        if (!has_next) break;
#pragma unroll
        for (int a = 0; a < 2; ++a)
#pragma unroll
            for (int b = 0; b < 2; ++b)
#pragma unroll
                for (int m = 0; m < 4; ++m)
#pragma unroll
                    for (int n = 0; n < 2; ++n) acc[a][b][m][n] = (f32x4){0.f, 0.f, 0.f, 0.f};
        cur = nxt; ++ui;
        if constexpr (ALIGN_EPI) { if (wr == 1) PG8_BAR; }
    }
    PG8_WAIT_V(0);
    if constexpr (!ALIGN_EPI) { if (wr == 0) PG8_BAR; }
    PG8_BAR;
#undef PG8_SA
#undef PG8_SB
#undef PG8_STAGE
#undef PG8_LDA
#undef PG8_LDB
#undef PG8_MMA
#undef PG8_TRIP
#undef PG8_WAIT_V
#undef PG8_WAIT_L
#undef PG8_BAR
#undef PG8_SCHED
}
}

#define XB_TMO      128
#define XB_XCNT(j)  (256  + 64 * (j))
#define XB_XSUB(j)  (1280 + 64 * (j))
#define XB_XGEN(j)  (2304 + 64 * (j))
#define XB_TOP      3328
#define XB_TOPGEN   3392
#define XCD_BAR_WORDS 3456
#define XB_SPIN_CAP (1u << 18)
__device__ __forceinline__ unsigned xb_ld(unsigned* p)              { return __hip_atomic_load(p, __ATOMIC_RELAXED, __HIP_MEMORY_SCOPE_AGENT); }
__device__ __forceinline__ unsigned xb_add(unsigned* p, unsigned v) { return __hip_atomic_fetch_add(p, v, __ATOMIC_RELAXED, __HIP_MEMORY_SCOPE_AGENT); }
__device__ __forceinline__ unsigned xb_xcc_id() { return (unsigned)__builtin_amdgcn_s_getreg((3 << 11) | 20) & 0xFu; }
#define XB_SPIN(cond, bar) do { unsigned _sp = 0; while (cond) { __builtin_amdgcn_s_sleep(1); \
    if ((++_sp & 255u) == 0u) { if (xb_ld(&(bar)[XB_TMO])) break; if (_sp > XB_SPIN_CAP) { atomicAdd(&(bar)[XB_TMO], 1u); break; } } } } while (0)
struct XcdBarrier { unsigned* bar; unsigned x; volatile LAS unsigned* st; };
__device__ __forceinline__ XcdBarrier xcd_barrier_post(unsigned* bar, volatile LAS unsigned* st) {
    XcdBarrier b; b.bar = bar; b.x = xb_xcc_id(); b.st = st;
    if (threadIdx.x == 0) (void)xb_add(&bar[XB_XCNT(b.x)], 1u);
    return b;
}
__device__ __forceinline__ void xcd_barrier_complete(unsigned* bar, unsigned x, unsigned& nloc, unsigned& nx) {
    const unsigned G = gridDim.x * gridDim.y * gridDim.z;
    unsigned sum, cnt, mine, sp = 0u;
    for (;;) {
        sum = 0u; cnt = 0u; mine = 0u;
#pragma unroll
        for (unsigned j = 0; j < 16; ++j) { const unsigned c = xb_ld(&bar[XB_XCNT(j)]); sum += c; cnt += (c > 0u) ? 1u : 0u; mine = (j == x) ? c : mine; }
        if (sum == G) break;
        __builtin_amdgcn_s_sleep(1);
        if ((++sp & 255u) == 0u) { if (xb_ld(&bar[XB_TMO])) break; if (sp > XB_SPIN_CAP) { atomicAdd(&bar[XB_TMO], 1u); break; } }
    }
    nloc = mine > 0u ? mine : 1u; nx = cnt > 0u ? cnt : 1u;
}
__device__ __forceinline__ void xcd_barrier(const XcdBarrier& b) {
    asm volatile("s_waitcnt vmcnt(0)" ::: "memory");
    __syncthreads();
    if (threadIdx.x == 0) {
        unsigned* bar = b.bar;
        __builtin_amdgcn_s_waitcnt(0);
        unsigned nloc = b.st[0], nx = b.st[1];
        if (nloc == 0u) { xcd_barrier_complete(bar, b.x, nloc, nx); b.st[0] = nloc; b.st[1] = nx; }
        const unsigned old = xb_add(&bar[XB_XSUB(b.x)], 1u);
        const unsigned gen = old / nloc;
        if (old + 1u == (gen + 1u) * nloc) {
            __builtin_amdgcn_fence(__ATOMIC_RELEASE, "agent");
            asm volatile("s_waitcnt vmcnt(0)" ::: "memory");
            const unsigned og = xb_add(&bar[XB_TOP], 1u);
            const unsigned tg = og / nx;
            if (og + 1u == (tg + 1u) * nx) xb_add(&bar[XB_TOPGEN], 1u);
            else XB_SPIN(xb_ld(&bar[XB_TOPGEN]) == tg, bar);
            __builtin_amdgcn_fence(__ATOMIC_ACQUIRE, "agent");
            xb_add(&bar[XB_XGEN(b.x)], 1u);
            asm volatile("s_waitcnt vmcnt(0)" ::: "memory");
        } else {
            XB_SPIN(xb_ld(&bar[XB_XGEN(b.x)]) == gen, bar);
            __builtin_amdgcn_fence(__ATOMIC_ACQUIRE, "agent");
            asm volatile("s_waitcnt vmcnt(0)" ::: "memory");
        }
    }
    __syncthreads();
}

namespace attn_body {
using bf16=__hip_bfloat16;
using bf16x8=__attribute__((ext_vector_type(8)))short;
using s16x4=__attribute__((ext_vector_type(4)))short;
using f32x16=__attribute__((ext_vector_type(16)))float;
using u32x4=__attribute__((ext_vector_type(4)))unsigned;
using u32x2v=__attribute__((ext_vector_type(2)))unsigned;
constexpr float AO_PRESCALE=128.0f;
constexpr int BATCH=4,NHEAD=8,SEQ=4096,D=64,DM=NHEAD*D;
constexpr int NW=8,QBLK=32,QB=QBLK*NW,KVBLK=64,NQB=SEQ/QB;
constexpr int ATTN_PITCH=DM, ATTN_UNIT_ROWS=QB;
__device__ __forceinline__ int crow(int r,int hi){return (r&3)+8*(r>>2)+4*hi;}
#define SBAR() __builtin_amdgcn_sched_barrier(0)
__device__ __forceinline__ void amask(f32x16&p0,f32x16&p1,const u32x2v mk,int hi){
  const unsigned a=mk.x>>(2*hi), b=mk.y>>(2*hi); const unsigned NEGI=0xff800000u;
  #define AM1(r,src) { int m0_,m1_; asm("v_bfe_i32 %0, %1, %2, 1":"=v"(m0_):"v"(src),"n"((((r)&3)>>1)+4*((r)>>2))); asm("v_bfe_i32 %0, %1, %2, 1":"=v"(m1_):"v"(src),"n"((((r)&3)>>1)+4*((r)>>2)+16)); \
      float x0_=p0[r],x1_=p1[r]; asm("v_bfi_b32 %0, %1, %2, %3":"=v"(x0_):"v"(m0_),"v"(x0_),"s"(NEGI)); asm("v_bfi_b32 %0, %1, %2, %3":"=v"(x1_):"v"(m1_),"v"(x1_),"s"(NEGI)); p0[r]=x0_; p1[r]=x1_; }
  AM1(0,a) AM1(1,b) AM1(2,a) AM1(3,b) AM1(4,a) AM1(5,b) AM1(6,a) AM1(7,b) AM1(8,a) AM1(9,b) AM1(10,a) AM1(11,b) AM1(12,a) AM1(13,b) AM1(14,a) AM1(15,b)
  #undef AM1
}
__device__ __forceinline__ void abias(f32x16&p0,f32x16&p1,int jb,int qrel,int hi,const __attribute__((address_space(3))) float*lut){
  const int d00=qrel+128-64*jb-4*hi;
  #pragma unroll
  for(int r=0;r<16;++r){ const int d0=d00-((r&3)+8*(r>>2)); const unsigned i0=(unsigned)d0<127u?(unsigned)d0:127u; const unsigned i1=(unsigned)(d0-32)<127u?(unsigned)(d0-32):127u;
    p0[r]+=lut[i0]; p1[r]+=lut[i1]; }
}

constexpr int NSLOT=3, SLOTB=8192;
constexpr int LDS_K=0, LDS_V=NSLOT*SLOTB, LDS_WS=2*NSLOT*SLOTB, LDS_OST=LDS_WS+NW*64*4, LDS_MK=LDS_OST+NW*4096, LDS_BYTES=LDS_MK+NW*512;
constexpr float C2=0.125f*1.4426950408889634f;
__device__ __forceinline__ void glds16(const void*gsrc,unsigned lds_dst){unsigned keep;
  asm volatile("s_mov_b32 %0, m0\n\ts_mov_b32 m0, %2\n\ts_nop 0\n\tglobal_load_lds_dwordx4 %1, off\n\ts_mov_b32 m0, %0":"=&s"(keep):"v"(gsrc),"s"(lds_dst):"memory");}
__device__ __forceinline__ void glds4(const void*gsrc,unsigned lds_dst){unsigned keep;
  asm volatile("s_mov_b32 %0, m0\n\ts_mov_b32 m0, %2\n\ts_nop 0\n\tglobal_load_lds_dword %1, off\n\ts_mov_b32 m0, %0":"=&s"(keep):"v"(gsrc),"s"(lds_dst):"memory");}
__device__ __forceinline__ float max3f(float a,float b,float c){float r;asm("v_max3_f32 %0, %1, %2, %3":"=v"(r):"v"(a),"v"(b),"v"(c));return r;}
__device__ __forceinline__ float max2f(float a,float b){float r;asm("v_max_f32_e32 %0, %1, %2":"=v"(r):"v"(a),"v"(b));return r;}
__device__ __forceinline__ float fadd_s(float a,float b){float r;asm("v_add_f32_e32 %0, %1, %2":"=v"(r):"v"(a),"v"(b));return r;}
__device__ __forceinline__ float fsub_s(float a,float b){float r;asm("v_sub_f32_e32 %0, %1, %2":"=v"(r):"v"(a),"v"(b));return r;}
typedef float f32x2_t __attribute__((ext_vector_type(2))); typedef __bf16 bf16x2_t __attribute__((ext_vector_type(2)));
__device__ __forceinline__ unsigned cvtpk_s(float lo,float hi){f32x2_t v={lo,hi};bf16x2_t b=__builtin_convertvector(v,bf16x2_t);return __builtin_bit_cast(unsigned,b);}
#define WAIT_BAR(N) asm volatile("s_waitcnt vmcnt(" #N ") lgkmcnt(0)\n\ts_barrier":::"memory")

__device__ __forceinline__ void qkt(f32x16&p0,f32x16&p1,const char*Kslot,const bf16x8*qr,const f32x16&negm,int r32,int hi){
  const char*kb=Kslot+hi*1024+r32*16;
  #pragma unroll
  for(int d0=0;d0<4;++d0){
    const bf16x8 b0=*reinterpret_cast<const bf16x8*>(kb+d0*2048);
    const bf16x8 b1=*reinterpret_cast<const bf16x8*>(kb+d0*2048+512);
    if(d0==0){p0=__builtin_amdgcn_mfma_f32_32x32x16_bf16(b0,qr[0],negm,0,0,0);p1=__builtin_amdgcn_mfma_f32_32x32x16_bf16(b1,qr[0],negm,0,0,0);}
    else{p0=__builtin_amdgcn_mfma_f32_32x32x16_bf16(b0,qr[d0],p0,0,0,0);p1=__builtin_amdgcn_mfma_f32_32x32x16_bf16(b1,qr[d0],p1,0,0,0);}}
}
typedef __attribute__((address_space(3))) const char* lds_cptr;
typedef short v4i16_t __attribute__((ext_vector_type(4)));
__device__ __forceinline__ void kload8(bf16x8*kf,lds_cptr kp){
  kf[0]=*(const __attribute__((address_space(3))) bf16x8*)(kp);      kf[1]=*(const __attribute__((address_space(3))) bf16x8*)(kp+512);
  kf[2]=*(const __attribute__((address_space(3))) bf16x8*)(kp+2048); kf[3]=*(const __attribute__((address_space(3))) bf16x8*)(kp+2560);
  kf[4]=*(const __attribute__((address_space(3))) bf16x8*)(kp+4096); kf[5]=*(const __attribute__((address_space(3))) bf16x8*)(kp+4608);
  kf[6]=*(const __attribute__((address_space(3))) bf16x8*)(kp+6144); kf[7]=*(const __attribute__((address_space(3))) bf16x8*)(kp+6656);
}
__device__ __forceinline__ void kload2(bf16x8*kf,lds_cptr kp,int j){ kf[2*j]=*(const __attribute__((address_space(3))) bf16x8*)(kp+j*2048); kf[2*j+1]=*(const __attribute__((address_space(3))) bf16x8*)(kp+j*2048+512); }
__device__ __forceinline__ s16x4 vtr(lds_cptr p){ return __builtin_bit_cast(s16x4,__builtin_amdgcn_ds_read_tr16_b64_v4i16((__attribute__((address_space(3))) v4i16_t*)p)); }
__device__ __forceinline__ float rowmax(const f32x16&p0,const f32x16&p1){
  float a=max3f(p0[0],p0[1],p1[0]),b=max3f(p0[2],p0[3],p1[1]);a=max3f(a,p1[2],p1[3]);
  #pragma unroll
  for(int r=4;r<16;r+=4){a=max3f(a,p0[r],p0[r+1]);b=max3f(b,p0[r+2],p0[r+3]);a=max3f(a,p1[r],p1[r+1]);b=max3f(b,p1[r+2],p1[r+3]);}
  const float m=max2f(a,b);
  auto rr=__builtin_amdgcn_permlane32_swap(__float_as_uint(m),__float_as_uint(m),false,false);
  return max2f(__uint_as_float(rr[0]),__uint_as_float(rr[1]));
}
__device__ __forceinline__ void pv(f32x16*o,int vb,bf16x8 pa0,bf16x8 pa1,bf16x8 pa2,bf16x8 pa3){
  #pragma unroll
  for(int d0=0;d0<2;++d0){s16x4 lo[4],hi[4];
    #pragma unroll
    for(int ks=0;ks<4;++ks){
      asm volatile("ds_read_b64_tr_b16 %0,%1 offset:%c2":"=&v"(lo[ks]):"v"(vb),"i"(d0*4096+ks*1024):"memory");
      asm volatile("ds_read_b64_tr_b16 %0,%1 offset:%c2":"=&v"(hi[ks]):"v"(vb),"i"(d0*4096+ks*1024+512):"memory");}
    asm volatile("s_waitcnt lgkmcnt(0)":::"memory");SBAR();
    #define PK(k) (bf16x8){lo[k][0],lo[k][1],lo[k][2],lo[k][3],hi[k][0],hi[k][1],hi[k][2],hi[k][3]}
    o[d0]=__builtin_amdgcn_mfma_f32_32x32x16_bf16(pa0,PK(0),o[d0],0,0,0);
    o[d0]=__builtin_amdgcn_mfma_f32_32x32x16_bf16(pa1,PK(1),o[d0],0,0,0);
    o[d0]=__builtin_amdgcn_mfma_f32_32x32x16_bf16(pa2,PK(2),o[d0],0,0,0);
    o[d0]=__builtin_amdgcn_mfma_f32_32x32x16_bf16(pa3,PK(3),o[d0],0,0,0);
    #undef PK
  }
}

#ifndef ATTN_STORE16
#define ATTN_STORE16(p,v) (*(u32x4*)(p)=(v))
#endif
template<int THRL> __device__ __forceinline__ void attn_unit(int b,int h,int qb,const bf16*Q,const bf16*__restrict__ K,const bf16*__restrict__ V,bf16*O,const unsigned long long*MK,const __attribute__((address_space(3))) float*lut,char*shm){
  int tid_=threadIdx.x; asm volatile("":"+v"(tid_)); const int tid=tid_,lane=tid&63,r32=lane&31,hi=lane>>5; const int wid=__builtin_amdgcn_readfirstlane(tid>>6);
  const long rowbase=(long)b*SEQ; const int q0=qb*QB;
  const bf16*Qw=Q+(rowbase+q0+wid*QBLK)*DM+h*D;
  const bf16*Kh=K+rowbase*DM+h*D,*Vh=V+rowbase*DM+h*D;
  const unsigned lds0=(unsigned)(uintptr_t)shm;
  float*wsf=(float*)(shm+LDS_WS)+wid*64;
  const bf16*ksrc=Kh+(long)lane*DM+wid*8;
  const bf16*vsrc=Vh+(long)(16*(wid&3)+(lane>>2))*DM+(wid>>2)*32+(lane&3)*8;
  const unsigned kdst=lds0+LDS_K+wid*1024, vdst=lds0+LDS_V+wid*1024;
  #define DMA_K(t,slot) glds16(ksrc+(long)(t)*KVBLK*DM,(unsigned)__builtin_amdgcn_readfirstlane(kdst+(slot)))
  #define DMA_V(t,slot) glds16(vsrc+(long)(t)*KVBLK*DM,(unsigned)__builtin_amdgcn_readfirstlane(vdst+(slot)))
  const int vb0=(int)(lds0+LDS_V)+((lane>>4)&1)*32+(lane&3)*8+(4*hi+((lane&15)>>2))*64;
  const char*Kbase=shm+LDS_K; bf16x8 kf[8];
  const lds_cptr shm3=(lds_cptr)shm; const lds_cptr kp0=shm3+LDS_K+hi*1024+r32*16; const lds_cptr vp0=shm3+LDS_V+((lane>>4)&1)*32+(lane&3)*8+(4*hi+((lane&15)>>2))*64; const lds_cptr mkp=shm3+LDS_MK+wid*512+r32*4;
  const int NT=(q0+QB)/KVBLK;
  const char*msrc=(const char*)(MK+(rowbase+q0+wid*QBLK+r32)*(SEQ/64))+hi*4; const unsigned mdst=lds0+LDS_MK+wid*512;
  #define DMA_M(t) glds4(msrc+(long)(t)*8,(unsigned)__builtin_amdgcn_readfirstlane(mdst+(((t)&1)<<8)))
  DMA_M(0);DMA_M(1);
  DMA_K(0,0);DMA_V(0,0);DMA_K(1,SLOTB);
  bf16x8 qr[4];
  #pragma unroll
  for(int d0=0;d0<4;++d0)qr[d0]=*reinterpret_cast<const bf16x8*>(&Qw[(long)r32*DM+d0*16+hi*8]);
  float mhat=0.f,l_reg=0.f;f32x16 o[2];o[0]=f32x16{};o[1]=f32x16{};const f32x16 negm=f32x16{};
  const int qrel=wid*QBLK+r32;
  #define MREAD(t) (u32x2v){*(const __attribute__((address_space(3))) unsigned*)(mkp+(((t)&1)<<8)),*(const __attribute__((address_space(3))) unsigned*)(mkp+(((t)&1)<<8)+128)}
  #define CMASK(P0,P1,t,MC) do{int jb_=(t)-(NT-6); if(jb_>=0 && 32*wid+65-64*jb_<113 && 64*jb_-128<=32*wid+31)abias(P0,P1,jb_,qrel,hi,lut); const u32x2v mk_=MREAD(t); amask(P0,P1,mk_,hi);}while(0)
  bool resc=false;
  #define START(P0,P1) do{ const float rm=rowmax(P0,P1); resc=false; \
    { const float dl=__builtin_fmaxf(rm,-1000.f); mhat=fadd_s(mhat,dl); \
      _Pragma("unroll") for(int r=0;r<16;++r){P0[r]=fsub_s(P0[r],dl);P1[r]=fsub_s(P1[r],dl);} \
      } \
    _Pragma("unroll") for(int r=0;r<16;++r)P0[r]=__builtin_amdgcn_exp2f(P0[r]); }while(0)
  #define RESC() do{ if(resc){ asm volatile("s_waitcnt lgkmcnt(0)":::"memory"); \
      _Pragma("unroll") for(int d_=0;d_<2;++d_) _Pragma("unroll") for(int r=0;r<16;++r)o[d_][r]*=wsf[crow(r,hi)]; } }while(0)
  f32x16 pA0,pA1,pB0,pB1;
  int sl_prev=0,sl_cur=0,sl_next=SLOTB;
  #define ROT() do{sl_prev=sl_cur;sl_cur=sl_next;sl_next=(sl_next==(NSLOT-1)*SLOTB)?0:sl_next+SLOTB;}while(0)
  DMA_K(2,2*SLOTB);
  WAIT_BAR(3);
  qkt(pA0,pA1,Kbase,qr,negm,r32,hi);asm volatile("s_nop 15\n\ts_nop 7":"+v"(pA0),"+v"(pA1));CMASK(pA0,pA1,0,0);
  START(pA0,pA1);
  _Pragma("unroll") for(int r=0;r<16;++r)pA1[r]=__builtin_amdgcn_exp2f(pA1[r]);
  WAIT_BAR(0);
  DMA_K(3,0);DMA_V(1,SLOTB);
  ROT();
  kload8(kf,kp0+sl_cur);
  WAIT_BAR(2);
  s16x4 vlo[8],vhi[8]; u32x4 pw0,pw1,pw2,pw3;
  #define PKW(P,B) cvtpk_s(P[B],P[B+1])
  #define PAF(k) __builtin_bit_cast(bf16x8,pw##k)
  #define VFR(i) (bf16x8){vlo[i][0],vlo[i][1],vlo[i][2],vlo[i][3],vhi[i][0],vhi[i][1],vhi[i][2],vhi[i][3]}
  #define PIN(x) asm volatile("":"+v"(x))
  #define MX3(a,b,c) __builtin_fmaxf(__builtin_fmaxf((a),(b)),(c))
  #define GAPA(MF,A0,A1,A2,A3,W0,W1,PW) do{ MF; sacc+=A0; sacc+=A1; sacc+=A2; sacc+=A3; PIN(sacc); W0; W1; PIN(PW); SBAR(); }while(0)
  #define EX(v) __builtin_amdgcn_exp2f(v)
  #define GAPB(MF,X,B) do{ MF; X[B]=EX(X[B]); X[B+1]=EX(X[B+1]); X[B+2]=EX(X[B+2]); X[B+3]=EX(X[B+3]); PIN(X); SBAR(); }while(0)
  #define VRD(i) do{ vlo[i]=vtr(vp_+(((i)>>2)*4096+((i)&3)*1024)); vhi[i]=vtr(vp_+(((i)>>2)*4096+((i)&3)*1024+512)); }while(0)
  #define KRD(G,j) do{ if(G){ kload2(kf,kp0+sl_next,j); SBAR(); } }while(0)
  #define STEP(C0,C1,P0,P1,t,GK,GV,GL,MC,MN,GM) do{ SBAR(); if(GM){DMA_M((t)+1);} \
    const lds_cptr vp_=vp0+sl_prev; \
    VRD(0); SBAR(); float sacc=(P0[0]+P0[1]); \
    GAPA(C0=__builtin_amdgcn_mfma_f32_32x32x16_bf16(kf[0],qr[0],negm,0,0,0), P0[2],P0[3],P0[4],P0[5],     pw0[0]=PKW(P0,0), pw0[1]=PKW(P0,2), pw0); \
    VRD(4); SBAR(); GAPA(C1=__builtin_amdgcn_mfma_f32_32x32x16_bf16(kf[1],qr[0],negm,0,0,0), P0[6],P0[7],P0[8],P0[9],     pw0[2]=PKW(P0,4), pw0[3]=PKW(P0,6), pw0); \
    VRD(1); SBAR(); GAPA(C0=__builtin_amdgcn_mfma_f32_32x32x16_bf16(kf[2],qr[1],C0,0,0,0),   P0[10],P0[11],P0[12],P0[13], pw1[0]=PKW(P0,8), pw1[1]=PKW(P0,10), pw1); \
    VRD(5); SBAR(); GAPA(C1=__builtin_amdgcn_mfma_f32_32x32x16_bf16(kf[3],qr[1],C1,0,0,0),   P0[14],P0[15],P1[0],P1[1],   pw1[2]=PKW(P0,12),pw1[3]=PKW(P0,14), pw1); \
    VRD(2); SBAR(); GAPA(C0=__builtin_amdgcn_mfma_f32_32x32x16_bf16(kf[4],qr[2],C0,0,0,0),   P1[2],P1[3],P1[4],P1[5],     pw2[0]=PKW(P1,0), pw2[1]=PKW(P1,2), pw2); \
    VRD(6); SBAR(); GAPA(C1=__builtin_amdgcn_mfma_f32_32x32x16_bf16(kf[5],qr[2],C1,0,0,0),   P1[6],P1[7],P1[8],P1[9],     pw2[2]=PKW(P1,4), pw2[3]=PKW(P1,6), pw2); \
    VRD(3); SBAR(); GAPA(C0=__builtin_amdgcn_mfma_f32_32x32x16_bf16(kf[6],qr[3],C0,0,0,0),   P1[10],P1[11],P1[12],P1[13], pw3[0]=PKW(P1,8), pw3[1]=PKW(P1,10), pw3); \
    VRD(7); SBAR(); GAPA(C1=__builtin_amdgcn_mfma_f32_32x32x16_bf16(kf[7],qr[3],C1,0,0,0),   P1[14],P1[15],0.f,0.f,       pw3[2]=PKW(P1,12),pw3[3]=PKW(P1,14), pw3); \
    l_reg+=sacc; \
    if(GK){DMA_K((t)+3,sl_cur);} if(GV){DMA_V((t)+1,sl_next);} \
    _Pragma("unroll") for(int r=0;r<16;++r){C0[r]-=mhat;C1[r]-=mhat;} \
    CMASK(C0,C1,t,MC); \
    { float a=MX3(C0[0],C0[1],C1[0]),b=MX3(C0[2],C0[3],C1[1]); a=MX3(a,C1[2],C1[3]); \
      _Pragma("unroll") for(int r=4;r<16;r+=4){a=MX3(a,C0[r],C0[r+1]);b=MX3(b,C0[r+2],C0[r+3]);a=MX3(a,C1[r],C1[r+1]);b=MX3(b,C1[r+2],C1[r+3]);} \
      float rm=__builtin_fmaxf(a,b); { auto rr=__builtin_amdgcn_permlane32_swap(__float_as_uint(rm),__float_as_uint(rm),false,false); rm=__builtin_fmaxf(__uint_as_float(rr[0]),__uint_as_float(rr[1])); } \
      resc=false; \
      if(__builtin_expect(__any(rm>(float)THRL),0)){ const float dl=__builtin_fmaxf(rm,0.f); mhat+=dl; \
        _Pragma("unroll") for(int r=0;r<16;++r){C0[r]-=dl;C1[r]-=dl;} \
        const float f=__builtin_amdgcn_exp2f(-dl); l_reg*=f; if(hi==0)wsf[r32]=f; resc=true; } } \
    SBAR(); \
    GAPB(o[0]=__builtin_amdgcn_mfma_f32_32x32x16_bf16(PAF(0),VFR(0),o[0],0,0,0), C0,0); \
    GAPB(o[1]=__builtin_amdgcn_mfma_f32_32x32x16_bf16(PAF(0),VFR(4),o[1],0,0,0), C0,4); \
    KRD(GL,0); GAPB(o[0]=__builtin_amdgcn_mfma_f32_32x32x16_bf16(PAF(1),VFR(1),o[0],0,0,0), C0,8); \
    KRD(GL,1); GAPB(o[1]=__builtin_amdgcn_mfma_f32_32x32x16_bf16(PAF(1),VFR(5),o[1],0,0,0), C0,12); \
    KRD(GL,2); GAPB(o[0]=__builtin_amdgcn_mfma_f32_32x32x16_bf16(PAF(2),VFR(2),o[0],0,0,0), C1,0); \
    KRD(GL,3); GAPB(o[1]=__builtin_amdgcn_mfma_f32_32x32x16_bf16(PAF(2),VFR(6),o[1],0,0,0), C1,4); \
    GAPB(o[0]=__builtin_amdgcn_mfma_f32_32x32x16_bf16(PAF(3),VFR(3),o[0],0,0,0), C1,8); \
    GAPB(o[1]=__builtin_amdgcn_mfma_f32_32x32x16_bf16(PAF(3),VFR(7),o[1],0,0,0), C1,12); \
    }while(0)
  int t=1;
  #undef CMASK
  #define CMASK(P0,P1,t,MC) do{ const u32x2v mk_=MREAD(t); amask(P0,P1,mk_,hi);}while(0)
  for(;t+7<NT;t+=2){
    STEP(pB0,pB1,pA0,pA1,t,true,true,true,0,0,true);     WAIT_BAR(2); RESC(); ROT();
    STEP(pA0,pA1,pB0,pB1,t+1,true,true,true,0,0,true);   WAIT_BAR(2); RESC(); ROT();
  }
  #undef CMASK
  #define CMASK(P0,P1,t,MC) do{int jb_=(t)-(NT-6); if(jb_>=0 && 32*wid+65-64*jb_<113 && 64*jb_-128<=32*wid+31)abias(P0,P1,jb_,qrel,hi,lut); const u32x2v mk_=MREAD(t); amask(P0,P1,mk_,hi);}while(0)
  #define ENDW(tt,M) do{ if((tt)+3<NT){WAIT_BAR(2);} else if((tt)+2<NT){WAIT_BAR(1);} else {WAIT_BAR(0);} }while(0)
  for(;t+1<NT;t+=2){
    STEP(pB0,pB1,pA0,pA1,t,(t+3<NT),(t+1<NT),(t+1<NT),0,0,(t+1<NT));       ENDW(t,0);   RESC(); ROT();
    STEP(pA0,pA1,pB0,pB1,t+1,(t+4<NT),(t+2<NT),(t+2<NT),0,0,(t+2<NT));     ENDW(t+1,0); RESC(); ROT();
  }
  STEP(pB0,pB1,pA0,pA1,NT-1,false,false,false,0,0,false); RESC();
  { float sacc=pB0[0]+pB0[1]; _Pragma("unroll") for(int r=2;r<16;++r)sacc+=pB0[r]; _Pragma("unroll") for(int r=0;r<16;++r)sacc+=pB1[r]; l_reg+=sacc;
    pw0=(u32x4){PKW(pB0,0),PKW(pB0,2),PKW(pB0,4),PKW(pB0,6)};pw1=(u32x4){PKW(pB0,8),PKW(pB0,10),PKW(pB0,12),PKW(pB0,14)};pw2=(u32x4){PKW(pB1,0),PKW(pB1,2),PKW(pB1,4),PKW(pB1,6)};pw3=(u32x4){PKW(pB1,8),PKW(pB1,10),PKW(pB1,12),PKW(pB1,14)};
    SBAR(); pv(o,vb0+sl_cur,PAF(0),PAF(1),PAF(2),PAF(3)); }
  #undef PKW
  #undef PAF
  #undef VFR
  #undef PIN
  #undef MX3
  #undef GAPA
  #undef GAPB
  #undef EX
  #undef VRD
  #undef KRD
  #undef STEP
  #undef ENDW
  {auto rr=__builtin_amdgcn_permlane32_swap(__float_as_uint(l_reg),__float_as_uint(l_reg),false,false);l_reg=__uint_as_float(rr[0])+__uint_as_float(rr[1]);}
  if(hi==0)wsf[32+r32]=l_reg;asm volatile("s_waitcnt lgkmcnt(0)":::"memory");
  float rli[16];
  #pragma unroll
  for(int r=0;r<16;++r)rli[r]=__builtin_amdgcn_rcpf(wsf[32+crow(r,hi)]);
  unsigned char*Ow=(unsigned char*)O+(rowbase+q0+wid*QBLK)*(long)DM+h*D;
  { unsigned char*stg=(unsigned char*)(shm+LDS_OST)+wid*4096;
    #pragma unroll
    for(int r=0;r<16;++r){const int orow=crow(r,hi); const float sc=rli[r]*AO_PRESCALE;
      #pragma unroll
      for(int d0=0;d0<2;++d0){const float x=__builtin_amdgcn_fmed3f(o[d0][r]*sc,-448.f,448.f); stg[orow*64+d0*32+r32]=(unsigned char)(__builtin_amdgcn_cvt_pk_fp8_f32(x,x,0,false)&0xff);}}
    asm volatile("s_waitcnt lgkmcnt(0)":::"memory");
    #pragma unroll
    for(int i=0;i<2;++i){const int row=i*16+(lane>>2),ch=lane&3; const u32x4 v=*(const u32x4*)(stg+row*64+ch*16); ATTN_STORE16(Ow+(long)row*DM+ch*16,v);} }
  asm volatile("s_waitcnt lgkmcnt(0)\n\ts_barrier":::"memory");
  #undef DMA_K
  #undef DMA_V
  #undef DMA_M
  #undef MREAD
  #undef CMASK
  #undef START
  #undef RESC
  #undef ROT
}
constexpr int ATTN_LDS_BYTES=LDS_BYTES;
struct AttnTensors { const bf16* Q; const bf16* K; const bf16* V; bf16* O; const unsigned long long* MK; };
struct AttnUnit { int bh; int qb; };
struct StaticOrder {
  int vcu;
  __device__ __forceinline__ explicit StaticOrder(int grid,int block):vcu((block%8)*(grid/8)+block/8){}
  __device__ __forceinline__ bool next(int i,AttnUnit&u)const{ if(i>=2)return false; const int s=vcu&7; u.bh=vcu>>3; u.qb=(i==0)?s:15-s; return true; }
  __device__ __forceinline__ void a_ready(const AttnUnit&)const{}
  __device__ __forceinline__ void done(const AttnUnit&)const{}
};
template<class Sched,int THRL=8> __device__ __forceinline__ void attn_phase(char*lds,const AttnTensors&T,const __attribute__((address_space(3))) float*lut8,const Sched&S){
  AttnUnit u;
  for(int i=0;S.next(i,u);++i){ S.a_ready(u); attn_unit<THRL>(u.bh/NHEAD,u.bh%NHEAD,u.qb,T.Q,T.K,T.V,T.O,T.MK,lut8+(u.bh%NHEAD)*128,lds); S.done(u); }
}
#undef SBAR
#undef WAIT_BAR
}

struct Args { const float* in[17]; float* out; unsigned char* ws; };
enum { IN_X = 0, IN_MIXN, IN_WIN, IN_POOLW, IN_POOLS, IN_WBP, IN_WBA, IN_RELB, IN_WOUT, IN_FFNN, IN_WR, IN_BR, IN_W1, IN_B1, IN_W2, IN_B2, IN_FINN, IN_OUT = 17 };
struct Frame {
    LAS unsigned char* lds;
    unsigned char* ws;
    int tid, lane, wave, G, gw, ngw;
    __device__ __forceinline__ const float* in(int i) const {
        auto kp = __builtin_amdgcn_kernarg_segment_ptr(); u64 p;
        asm volatile("s_load_dwordx2 %0, %1, %2\n\ts_waitcnt lgkmcnt(0)" : "=s"(p) : "s"(kp), "s"(i * 8) : "memory");
        return (const float*)(const GAS float*)p; }
    __device__ __forceinline__ float* outp() const { return (float*)in(IN_OUT); }
    template <class T> __device__ __forceinline__ T* w(size_t off) const { return (T*)(ws + off); }
    __device__ __forceinline__ unsigned* ctl() const { return (unsigned*)(ws + WS_CTL); }
};

__device__ __forceinline__ void refresh(Frame& F) { int t = threadIdx.x; asm volatile("" : "+v"(t)); F.tid = t; F.lane = t & 63; }

template <bool INDEXER> struct EpiInProj {
    static constexpr bool PERM = true;
    bf16 *zpool, *q, *k, *v, *qi, *ki, *gate; float* wi;
    __device__ __forceinline__ void operator()(const f32x4 (&acc)[2][2][4][2], const pg8::Unit& u, int wr, int wc, int fr, int fq) const {
        const int pn = u.pn, row0 = u.row0 + wr * 64 + fr;
        if (INDEXER && pn == 1) {
#pragma unroll
            for (int ai = 0; ai < 2; ++ai)
#pragma unroll
                for (int m = 0; m < 4; ++m) { const int row = row0 + ai * 128 + m * 16;
                    const f32x4 v0 = acc[ai][0][m][0], v1 = acc[ai][0][m][1];
                    if (wc < 2) { u32x4 w; w.x = cvt_pk_bf16(v0[0], v0[1]); w.y = cvt_pk_bf16(v0[2], v0[3]); w.z = cvt_pk_bf16(v1[0], v1[1]); w.w = cvt_pk_bf16(v1[2], v1[3]);
                        *(u32x4*)(ki + (size_t)row * 64 + wc * 32 + 8 * fq) = w; }
                    else if (wc == 2 && fq == 0) { *(f32x4*)(wi + (size_t)row * 4) = v0; } }
            return;
        }
        bf16* base; int ldc, colt, mode = 0; float sc = 1.f;
        if (INDEXER) { if (pn == 0) { base = qi; ldc = 256; colt = 0; } else { base = zpool; ldc = 512; colt = (pn - 2) * 256; } }
        else if (pn < 2) { base = q; ldc = 512; colt = pn * 256; sc = QSCALE; }
        else if (pn < 4) { base = k; ldc = 512; colt = (pn - 2) * 256; }
        else if (pn < 6) { base = v; ldc = 512; colt = (pn - 4) * 256; }
        else { base = gate; ldc = 2048; colt = (pn - 6) * 256; mode = 1; }
        const int col0 = colt + wc * 32 + 8 * fq;
#pragma unroll
        for (int ai = 0; ai < 2; ++ai)
#pragma unroll
            for (int m = 0; m < 4; ++m) { bf16* rowp = base + (size_t)(row0 + ai * 128 + m * 16) * ldc + col0;
#pragma unroll
                for (int bj = 0; bj < 2; ++bj) { f32x4 v0 = acc[ai][bj][m][0], v1 = acc[ai][bj][m][1];
                    if (mode == 1) {
#pragma unroll
                        for (int j = 0; j < 4; ++j) { v0[j] = sigmoidf_(v0[j]); v1[j] = sigmoidf_(v1[j]); } }
                    else { v0 = v0 * sc; v1 = v1 * sc; }
                    u32x4 w; w.x = cvt_pk_bf16(v0[0], v0[1]); w.y = cvt_pk_bf16(v0[2], v0[3]); w.z = cvt_pk_bf16(v1[0], v1[1]); w.w = cvt_pk_bf16(v1[2], v1[3]);
                    *(u32x4*)(rowp + bj * 128) = w; } }
    }
};
template <bool ADD> struct EpiGate {
    static constexpr bool PERM = true;
    bf16* merged; const bf16* gate; int goff;
    __device__ __forceinline__ void operator()(const f32x4 (&acc)[2][2][4][2], const pg8::Unit& u, int wr, int wc, int fr, int fq) const {
        const int row0 = u.row0 + wr * 64 + fr, col0 = u.pn * 256 + wc * 32 + 8 * fq;
#pragma unroll
        for (int ai = 0; ai < 2; ++ai)
#pragma unroll
            for (int m = 0; m < 4; ++m) { const size_t row = (size_t)(row0 + ai * 128 + m * 16);
#pragma unroll
                for (int bj = 0; bj < 2; ++bj) { const int col = col0 + bj * 128;
                    const u32x4 g = *(const u32x4*)(gate + row * 2048 + goff + col);
                    f32x4 v0 = acc[ai][bj][m][0], v1 = acc[ai][bj][m][1];
                    v0[0] *= bflo(g.x); v0[1] *= bfhi(g.x); v0[2] *= bflo(g.y); v0[3] *= bfhi(g.y); v1[0] *= bflo(g.z); v1[1] *= bfhi(g.z); v1[2] *= bflo(g.w); v1[3] *= bfhi(g.w);
                    if (ADD) { const u32x4 p = *(const u32x4*)(merged + row * 1024 + col);
                        v0[0] += bflo(p.x); v0[1] += bfhi(p.x); v0[2] += bflo(p.y); v0[3] += bfhi(p.y); v1[0] += bflo(p.z); v1[1] += bfhi(p.z); v1[2] += bflo(p.w); v1[3] += bfhi(p.w); }
                    u32x4 w; w.x = cvt_pk_bf16(v0[0], v0[1]); w.y = cvt_pk_bf16(v0[2], v0[3]); w.z = cvt_pk_bf16(v1[0], v1[1]); w.w = cvt_pk_bf16(v1[2], v1[3]);
                    *(u32x4*)(merged + row * 1024 + col) = w; } }
    }
};
struct EpiResidual {
    static constexpr bool PERM = true;
    const float* x; bf16* x1;
    __device__ __forceinline__ void operator()(const f32x4 (&acc)[2][2][4][2], const pg8::Unit& u, int wr, int wc, int fr, int fq) const {
        const int row0 = u.row0 + wr * 64 + fr, col0 = u.pn * 256 + wc * 32 + 8 * fq;
#pragma unroll
        for (int ai = 0; ai < 2; ++ai)
#pragma unroll
            for (int m = 0; m < 4; ++m) { const size_t off = (size_t)(row0 + ai * 128 + m * 16) * D + col0;
#pragma unroll
                for (int bj = 0; bj < 2; ++bj) { const f32x4 b0 = *(const f32x4*)(x + off + bj * 128), b1 = *(const f32x4*)(x + off + bj * 128 + 4);
                    const f32x4 v0 = b0 + acc[ai][bj][m][0], v1 = b1 + acc[ai][bj][m][1];
                    u32x4 w; w.x = cvt_pk_bf16(v0[0], v0[1]); w.y = cvt_pk_bf16(v0[2], v0[3]); w.z = cvt_pk_bf16(v1[0], v1[1]); w.w = cvt_pk_bf16(v1[2], v1[3]);
                    *(u32x4*)(x1 + off + bj * 128) = w; } }
    }
};
__device__ __forceinline__ float clamp448(float x) { return __builtin_amdgcn_fmed3f(x, -448.0f, 448.0f); }
__device__ __forceinline__ unsigned pk4_fp8(float a, float b, float c, float d) { int w = 0; w = __builtin_amdgcn_cvt_pk_fp8_f32(a, b, w, false); w = __builtin_amdgcn_cvt_pk_fp8_f32(c, d, w, true); return (unsigned)w; }
constexpr float ACT_PRESCALE = 4.0f, H_PRESCALE = 8.0f, W_PRESCALE = 128.0f, YS_PRESCALE = 64.0f;
struct EpiSwiGLU {
    static constexpr bool PERM = true;
    unsigned char* act; const LAS float* bias;
    __device__ __forceinline__ void operator()(const f32x4 (&acc)[2][2][4][2], const pg8::Unit& u, int wr, int wc, int fr, int fq) const {
        const int row0 = u.row0 + wr * 64 + fr, colr = u.pn * 128 + wc * 32 + 8 * fq;
        const LAS float* bg = bias + u.raw * 256 + wc * 32 + 8 * fq; const LAS float* bu = bg + 128;
        const f32x4 bg0 = *(const LAS f32x4*)bg, bg1 = *(const LAS f32x4*)(bg + 4), bu0 = *(const LAS f32x4*)bu, bu1 = *(const LAS f32x4*)(bu + 4);
#pragma unroll
        for (int ai = 0; ai < 2; ++ai)
#pragma unroll
            for (int m = 0; m < 4; ++m) { const size_t row = (size_t)(row0 + ai * 128 + m * 16);
                f32x4 g0 = acc[ai][0][m][0] + bg0, g1 = acc[ai][0][m][1] + bg1, u0 = acc[ai][1][m][0] + bu0, u1 = acc[ai][1][m][1] + bu1, r0, r1;
#pragma unroll
                for (int j = 0; j < 4; ++j) {
                    { const float g = fminf(g0[j], 7.0f), uu = fminf(fmaxf(u0[j], -7.0f), 7.0f); r0[j] = g * sigmoidf_(1.702f * g) * (uu + 1.0f) * ACT_PRESCALE; }
                    { const float g = fminf(g1[j], 7.0f), uu = fminf(fmaxf(u1[j], -7.0f), 7.0f); r1[j] = g * sigmoidf_(1.702f * g) * (uu + 1.0f) * ACT_PRESCALE; } }
                u32x2 w; w.x = pk4_fp8(r0[0], r0[1], r0[2], r0[3]); w.y = pk4_fp8(r1[0], r1[1], r1[2], r1[3]);
                *(u32x2*)(act + row * 1024 + colr) = w; }
    }
};
struct EpiMoeOut {
    static constexpr bool PERM = true;
    unsigned char* ys; const LAS float* bias; const LAS int* rows;
    __device__ __forceinline__ void operator()(const f32x4 (&acc)[2][2][4][2], const pg8::Unit& u, int wr, int wc, int fr, int fq) const {
        const int nvalid = u.aux2, slot = u.raw;
        const int col0 = u.pn * 256 + wc * 32 + 8 * fq;
#pragma unroll
        for (int bj = 0; bj < 2; ++bj) {
            const f32x4 bv0 = *(const LAS f32x4*)(bias + slot * 256 + wc * 32 + 8 * fq + bj * 128), bv1 = *(const LAS f32x4*)(bias + slot * 256 + wc * 32 + 8 * fq + bj * 128 + 4);
#pragma unroll
            for (int ai = 0; ai < 2; ++ai)
#pragma unroll
                for (int m = 0; m < 4; ++m) { const int r = ai * 128 + wr * 64 + m * 16 + fr;
                    if (r < nvalid) { const int ts = rows[(slot * 256 + r) * 2]; const float gt = __int_as_float(rows[(slot * 256 + r) * 2 + 1]) * YS_PRESCALE; unsigned char* rowp = ys + (size_t)ts * 1024 + col0;
                        const f32x4 v0 = (acc[ai][bj][m][0] + bv0) * gt, v1 = (acc[ai][bj][m][1] + bv1) * gt;
                        u32x2 w; w.x = pk4_fp8(clamp448(v0[0]), clamp448(v0[1]), clamp448(v0[2]), clamp448(v0[3])); w.y = pk4_fp8(clamp448(v1[0]), clamp448(v1[1]), clamp448(v1[2]), clamp448(v1[3]));
                        *(u32x2*)(rowp + bj * 128) = w; } }
            asm volatile("" ::: "memory");
        }
    }
};

struct MoeSched1 {
    const LAS int* tab; const LAS int* gath; const char* W1T; int G, c;
    __device__ __forceinline__ bool next(int i, pg8::Unit& u, const pg8::LaneRC& rc) const {
        const int T = tab[64], nwg = T * 8; const long L = (long)i * G + c; if (L >= nwg) return false;
        const int wgid = pg8::xcd_remap((int)L, nwg), mt = wgid >> 3, pn = wgid & 7;
        const int te = tab[128 + mt], e = te >> 16, lt = te & 0xffff, cnt = tab[e], pos0 = lt * 256;
#pragma unroll
        for (int h = 0; h < 2; ++h)
#pragma unroll
            for (int i2 = 0; i2 < 2; ++i2) u.aoff[h][i2] = (unsigned)(gath[i * 256 + h * 128 + rc.R[i2]] * 512 + rc.C[i2]) * 2u;
        u.b0 = W1T + ((size_t)e * 2048 + (size_t)pn * 128) * 1024; u.b1 = u.b0 + (size_t)1024 * 1024;
        u.row0 = tab[32 + e] + pos0; u.pn = pn; u.aux = e; u.aux2 = (cnt - pos0 < 256) ? (cnt - pos0) : 256; u.aux3 = pos0; u.raw = i; return true;
    }
    __device__ __forceinline__ void finish(pg8::Unit&, const pg8::LaneRC&) const {}
};
__device__ __forceinline__ void moe_gather_fill(Frame& F, const int* list, const float* b1) {
    const LAS int* tab = (const LAS int*)(F.lds + TAB_OFF); LAS int* gath = (LAS int*)(F.lds + TAB_OFF + 4096); LAS float* bias = (LAS float*)(F.lds + BIAS_OFF);
    const int T = tab[64], nwg = T * 8;
    for (int q = F.tid; q < 9 * 256; q += 512) { const int i = q >> 8, r = q & 255; const long L = (long)i * F.G + (int)blockIdx.x; int tok = 0; float bv = 0.f;
        if (L < nwg) { const int wgid = pg8::xcd_remap((int)L, nwg), mt = wgid >> 3, pn = wgid & 7; const int te = tab[128 + mt], e = te >> 16, lt = te & 0xffff, cnt = tab[e], pos = lt * 256 + r;
            if (pos < cnt) tok = list[(size_t)e * NTOK + pos] >> 2;
            bv = b1[(size_t)e * 2048 + (r < 128 ? 0 : 1024) + pn * 128 + (r & 127)]; }
        gath[q] = tok; bias[q] = bv; }
    __syncthreads();
}
struct MoeSched2 {
    const LAS int* tab; const char* W2T; int G, c;
    __device__ __forceinline__ bool next(int i, pg8::Unit& u, const pg8::LaneRC& rc) const {
        const int T = tab[64], nwg = T * 4; const long L = (long)i * G + c; if (L >= nwg) return false;
        const int wgid = pg8::xcd_remap((int)L, nwg), mt = wgid >> 2, pn = wgid & 3;
        const int te = tab[128 + mt], e = te >> 16, lt = te & 0xffff, cnt = tab[e], pos0 = lt * 256, row0 = tab[32 + e] + pos0;
#pragma unroll
        for (int h = 0; h < 2; ++h)
#pragma unroll
            for (int i2 = 0; i2 < 2; ++i2) u.aoff[h][i2] = (unsigned)((row0 + h * 128 + rc.R[i2]) * 512 + rc.C[i2]) * 2u;
        u.b0 = W2T + ((size_t)e * 1024 + (size_t)pn * 256) * 1024; u.b1 = u.b0 + (size_t)128 * 1024;
        u.row0 = row0; u.pn = pn; u.aux = e; u.aux2 = (cnt - pos0 < 256) ? (cnt - pos0) : 256; u.aux3 = pos0; u.raw = i; return true;
    }
    __device__ __forceinline__ void finish(pg8::Unit&, const pg8::LaneRC&) const {}
};

struct TItem { const float* src; unsigned char* dst; size_t rowpitch; int ldw, k0, col0, nvalid, row0, kbyte0, fp8; };
__device__ __forceinline__ TItem p0_item(int it, const float* w_in, const float* w_ba, const float* w_out, const float* w1, const float* w2, unsigned char* ws) {
    TItem t; constexpr int I_INI = 16 * 4, I_BA = 4 * 4, I_OUT = 16 * 4, I_IN8 = 8 * 14, I_W1 = 32 * 8 * 8;
    int r = it; t.fp8 = 0; t.nvalid = 256;
    if (r < I_INI) { const int kb = r >> 2, nb = r & 3; t.src = w_in; t.dst = ws + WS_WINI; t.ldw = DIN; t.rowpitch = 2048; t.k0 = kb * 64; t.kbyte0 = kb * 128; t.row0 = nb * 256;
        if (nb == 0) { t.col0 = 2048; } else if (nb == 1) { t.col0 = 2304; t.nvalid = 68; } else { t.col0 = (nb - 2) * 256; } return t; } r -= I_INI;
    if (r < I_OUT) { const int kb = r / 4, nb = r % 4; t.src = w_out; t.dst = ws + WS_WOUT; t.ldw = 1024; t.rowpitch = 2048; t.k0 = kb * 64; t.kbyte0 = kb * 128; t.col0 = nb * 256; t.row0 = nb * 256; return t; } r -= I_OUT;
    t.fp8 = 1; t.rowpitch = 1024;
    if (r < I_IN8) { const int kb = r / 14, nb = r % 14; t.src = w_in; t.dst = ws + WS_WIN; t.ldw = DIN; t.k0 = kb * 128; t.kbyte0 = kb * 128; t.row0 = nb * 256;
        t.col0 = (nb < 6) ? 512 + nb * 256 : 2372 + (nb - 6) * 256; return t; } r -= I_IN8;
    if (r < I_BA) { const int kb = r / 4, nb = r % 4; t.src = w_ba; t.dst = ws + WS_WBA; t.ldw = 1024; t.rowpitch = 512; t.k0 = kb * 128; t.kbyte0 = kb * 128; t.col0 = nb * 256; t.row0 = nb * 256; return t; } r -= I_BA;
    if (r < I_W1) { const int e = r >> 6, q = r & 63, kb = q >> 3, nb = q & 7; t.src = w1 + (size_t)e * 1024 * 2048; t.dst = ws + WS_W1 + (size_t)e * 2048 * 1024; t.ldw = 2048; t.k0 = kb * 128; t.kbyte0 = kb * 128; t.col0 = nb * 256; t.row0 = nb * 256; return t; } r -= I_W1;
    { const int e = r >> 5, q = r & 31, kb = q >> 2, nb = q & 3; t.src = w2 + (size_t)e * 1024 * 1024; t.dst = ws + WS_W2 + (size_t)e * 1024 * 1024; t.ldw = 1024; t.k0 = kb * 128; t.kbyte0 = kb * 128; t.col0 = nb * 256; t.row0 = nb * 256; return t; }
}
template <bool ONLY8> __device__ __forceinline__ void p0_load(const TItem& t, int wave, int lane, float (&v)[16][4]) {
    const int rpw = (ONLY8 || t.fp8) ? 16 : 8;
#pragma unroll
    for (int r = 0; r < 16; ++r) if (r < rpw) { const float* row = t.src + (size_t)(t.k0 + wave * rpw + r) * t.ldw + t.col0;
#pragma unroll
        for (int j = 0; j < 4; ++j) { const int n = lane + 64 * j; v[r][j] = (n < t.nvalid) ? __builtin_nontemporal_load(row + n) : 0.f; } }
}
constexpr int IT_W1_BEG = 256, IT_W1_END = 256 + 2048, IT_END = IT_W1_END + 1024, NW1T = 512, NW2T = 512, TAIL_PER = 12;
constexpr int MINI_W1_ITEMS = 2048 - NW1T, MINI_ITEMS = MINI_W1_ITEMS + (1024 - NW2T);
template <bool ONLY8> __device__ __forceinline__ void p0_copy(Frame& F, int j, const int j_end, const int stride, const int skip_at, const int skip_n) {
    refresh(F);
    const float* w_in = F.in(IN_WIN); const float* w_ba = F.in(IN_WBA); const float* w_out = F.in(IN_WOUT); const float* w1 = F.in(IN_W1); const float* w2 = F.in(IN_W2);
    constexpr int TPITCH = 144, TBYTES = 256 * TPITCH;
    const int wave = F.wave, lane = F.lane, tid = F.tid;
    __syncthreads();
    float v[16][4];
    int buf = 0;
    TItem cur; if (j < j_end) { cur = p0_item(j + (j >= skip_at ? skip_n : 0), w_in, w_ba, w_out, w1, w2, F.ws); p0_load<ONLY8>(cur, wave, lane, v); }
    while (j < j_end) {
        LAS unsigned char* T = F.lds + buf * TBYTES;
        if (ONLY8 || cur.fp8) {
#pragma unroll
            for (int jj = 0; jj < 4; ++jj) { u32x4 o; o.x = pk4_fp8(clamp448(v[0][jj] * W_PRESCALE), clamp448(v[1][jj] * W_PRESCALE), clamp448(v[2][jj] * W_PRESCALE), clamp448(v[3][jj] * W_PRESCALE)); o.y = pk4_fp8(clamp448(v[4][jj] * W_PRESCALE), clamp448(v[5][jj] * W_PRESCALE), clamp448(v[6][jj] * W_PRESCALE), clamp448(v[7][jj] * W_PRESCALE));
                o.z = pk4_fp8(clamp448(v[8][jj] * W_PRESCALE), clamp448(v[9][jj] * W_PRESCALE), clamp448(v[10][jj] * W_PRESCALE), clamp448(v[11][jj] * W_PRESCALE)); o.w = pk4_fp8(clamp448(v[12][jj] * W_PRESCALE), clamp448(v[13][jj] * W_PRESCALE), clamp448(v[14][jj] * W_PRESCALE), clamp448(v[15][jj] * W_PRESCALE));
                *(LAS u32x4*)(T + (lane + 64 * jj) * TPITCH + wave * 16) = o; }
        } else {
#pragma unroll
            for (int jj = 0; jj < 4; ++jj) { u32x4 o; o.x = pk2(v[0][jj], v[1][jj]); o.y = pk2(v[2][jj], v[3][jj]); o.z = pk2(v[4][jj], v[5][jj]); o.w = pk2(v[6][jj], v[7][jj]);
                *(LAS u32x4*)(T + (lane + 64 * jj) * TPITCH + wave * 16) = o; }
        }
        const int nj = j + stride; TItem nxt = cur;
        if (nj < j_end) { nxt = p0_item(nj + (nj >= skip_at ? skip_n : 0), w_in, w_ba, w_out, w1, w2, F.ws); p0_load<ONLY8>(nxt, wave, lane, v); }
        __syncthreads();
#pragma unroll
        for (int i = 0; i < 4; ++i) { const int p = tid + 512 * i, row = p >> 3, c = p & 7; const u32x4 o = *(const LAS u32x4*)(T + row * TPITCH + c * 16);
            *(u32x4*)(cur.dst + (size_t)(cur.row0 + row) * cur.rowpitch + cur.kbyte0 + c * 16) = o; }
        cur = nxt; j = nj; buf ^= 1;
    }
    __syncthreads();
}
__device__ __forceinline__ void p0_prologue(Frame& F) {
    refresh(F);
    const float* pool_w = F.in(IN_POOLW); const float* pool_scale = F.in(IN_POOLS); const float* w_bp = F.in(IN_WBP); const float* x = F.in(IN_X); const float* mix_norm = F.in(IN_MIXN);
    p0_copy<false>(F, (int)blockIdx.x, IT_W1_BEG, (int)gridDim.x, 1 << 30, 0);
    {
        const int gt = F.gw * 64 + F.lane, ngt = F.ngw * 64;
        for (int idx = gt; idx < 4 * 32 * 1024; idx += ngt) { const int d = idx & 1023, cq = (idx >> 10) & 31, g = idx >> 15;
            const float* pw = pool_w + ((size_t)g * 128 + cq * 4) * 128; const float* ps = pool_scale + g * 128; const float* wb = w_bp + (size_t)(g * 128) * 1024 + d;
            float a0 = 0.f, a1 = 0.f, a2 = 0.f, a3 = 0.f;
#pragma unroll 16
            for (int j = 0; j < 128; ++j) { const float wv = wb[(size_t)j * 1024] * ps[j]; a0 += pw[j] * wv; a1 += pw[128 + j] * wv; a2 += pw[256 + j] * wv; a3 += pw[384 + j] * wv; }
            u32x2 o; o.x = pk2(a0, a1); o.y = pk2(a2, a3);
            *(u32x2*)(F.w<bf16>(WS_WPC) + (size_t)d * 512 + g * 128 + cq * 4) = o; }
    }
    {
        const int lane = F.lane, st = F.ngw; bf16* Hh = F.w<bf16>(WS_H); unsigned* H8 = F.w<unsigned>(WS_H8X);
        f32x4 va[4], vb[4]; int m = F.gw;
        auto ld = [&](f32x4 (&v)[4], int mm) { const f32x4* xr = (const f32x4*)(x + (size_t)mm * D) + lane;
#pragma unroll
            for (int j = 0; j < 4; ++j) v[j] = __builtin_nontemporal_load(xr + 64 * j); };
        auto row = [&](const f32x4 (&v)[4], int mm) { float ss = 0.f;
#pragma unroll
            for (int j = 0; j < 4; ++j) ss += (v[j].x * v[j].x + v[j].y * v[j].y) + (v[j].z * v[j].z + v[j].w * v[j].w);
            const float rstd = 1.0f / sqrtf(wave_sum(ss) * (1.f / D) + RMS_EPS);
            const f32x4* gr = (const f32x4*)mix_norm + lane; u32x2* o8 = (u32x2*)(Hh + (size_t)mm * D) + lane;
#pragma unroll
            for (int j = 0; j < 4; ++j) { const f32x4 g = gr[64 * j]; const float h0 = v[j].x * rstd * g.x, h1 = v[j].y * rstd * g.y, h2 = v[j].z * rstd * g.z, h3 = v[j].w * rstd * g.w;
                u32x2 w; w.x = pk2(h0, h1); w.y = pk2(h2, h3); o8[64 * j] = w;
                H8[(size_t)mm * 256 + lane + 64 * j] = pk4_fp8(clamp448(h0 * H_PRESCALE), clamp448(h1 * H_PRESCALE), clamp448(h2 * H_PRESCALE), clamp448(h3 * H_PRESCALE)); } };
        if (m < NTOK) ld(va, m);
        while (m < NTOK) { const int m2 = m + st, m3 = m2 + st;
            if (m2 < NTOK) ld(vb, m2);
            row(va, m);
            if (m3 < NTOK) ld(va, m3);
            if (m2 < NTOK) row(vb, m2);
            m = m3; }
    }
}

__device__ __forceinline__ unsigned pk_f16(float a, float b) { const unsigned short x = __builtin_bit_cast(unsigned short, (_Float16)a), y = __builtin_bit_cast(unsigned short, (_Float16)b); return (unsigned)x | ((unsigned)y << 16); }
typedef _Float16 f16x2 __attribute__((ext_vector_type(2)));
__device__ __forceinline__ unsigned pk_f16v(f32x2 v) { return __builtin_bit_cast(unsigned, __builtin_convertvector(v, f16x2)); }
__device__ __forceinline__ void score_seg(int b, int qb, int kb0, int nkb, const bf16* QI, const bf16* KI, const float* WI, unsigned short* SC, LAS unsigned char* stile, int lane) {
    const int r32 = lane & 31, hi = lane >> 5;
    const size_t qrow = (size_t)b * SEQ + 32 * qb + r32;
    bf16x8 qf[4][4];
#pragma unroll
    for (int h = 0; h < 4; ++h)
#pragma unroll
        for (int kk = 0; kk < 4; ++kk) qf[h][kk] = *(const bf16x8*)(QI + qrow * 256 + h * 64 + kk * 16 + hi * 8);
    const f32x4 wv = *(const f32x4*)(WI + qrow * 4);
    const bf16* kip = KI + ((size_t)b * SEQ + r32) * 64 + hi * 8;
    const int kb1 = kb0 + nkb - 1;
    auto body = [&](const bf16x8 (&kf)[4], int kc) {
        f32x2 s2[8];
#pragma unroll
        for (int h = 0; h < 4; ++h) { f32x16 a;
#pragma unroll
            for (int i = 0; i < 16; ++i) a[i] = 0.f;
#pragma unroll
            for (int kk = 0; kk < 4; ++kk) a = __builtin_amdgcn_mfma_f32_32x32x16_bf16(kf[kk], qf[h][kk], a, 0, 0, 0);
            const f32x2 w2 = {wv[h], wv[h]};
#pragma unroll
            for (int j = 0; j < 8; ++j) { f32x2 r; r.x = __int_as_float(max(__float_as_int(a[2 * j]), 0)); r.y = __int_as_float(max(__float_as_int(a[2 * j + 1]), 0));
                s2[j] = (h == 0) ? (w2 * r + (f32x2){0.f, 0.f}) : (w2 * r + s2[j]); } }
#pragma unroll
        for (int g = 0; g < 4; ++g) { u32x2 o; o.x = pk_f16v(s2[2 * g]); o.y = pk_f16v(s2[2 * g + 1]); *(LAS u32x2*)(stile + r32 * 80 + (8 * g + 4 * hi) * 2) = o; }
        LDS_WAIT(); asm volatile("" ::: "memory");
#pragma unroll
        for (int i = 0; i < 2; ++i) { const int rr = i * 16 + (lane >> 2), cc = lane & 3; const u32x4 o = *(const LAS u32x4*)(stile + rr * 80 + cc * 16);
            *(u32x4*)(SC + ((size_t)b * SEQ + 32 * qb + rr) * SEQ + 32 * kc + cc * 8) = o; }
        LDS_WAIT(); asm volatile("" ::: "memory");
    };
    bf16x8 kA[4], kB[4];
#pragma unroll
    for (int kk = 0; kk < 4; ++kk) kA[kk] = *(const bf16x8*)(kip + (size_t)(32 * kb0) * 64 + kk * 16);
    asm volatile("" :: "v"(kA[0]), "v"(kA[1]), "v"(kA[2]), "v"(kA[3]), "v"(wv), "v"(qf[0][0]), "v"(qf[0][1]), "v"(qf[0][2]), "v"(qf[0][3]), "v"(qf[1][0]), "v"(qf[1][1]), "v"(qf[1][2]), "v"(qf[1][3]), "v"(qf[2][0]), "v"(qf[2][1]), "v"(qf[2][2]), "v"(qf[2][3]), "v"(qf[3][0]), "v"(qf[3][1]), "v"(qf[3][2]), "v"(qf[3][3]));
#pragma unroll 1
    for (int kc = kb0; kc <= kb1; kc += 2) {
        { const int kn = (kc + 1 <= kb1) ? kc + 1 : kb1;
#pragma unroll
          for (int kk = 0; kk < 4; ++kk) kB[kk] = *(const bf16x8*)(kip + (size_t)(32 * kn) * 64 + kk * 16); }
        __builtin_amdgcn_sched_barrier(0);
        body(kA, kc);
        if (kc + 1 > kb1) break;
        { const int kn = (kc + 2 <= kb1) ? kc + 2 : kb1;
#pragma unroll
          for (int kk = 0; kk < 4; ++kk) kA[kk] = *(const bf16x8*)(kip + (size_t)(32 * kn) * 64 + kk * 16); }
        __builtin_amdgcn_sched_barrier(0);
        body(kB, kc + 1);
    }
}
template <int W> __device__ __forceinline__ void pooled_group(const bf16* zp, bf16* po, int tok0, int ch) {
    const int t0 = tok0 & (SEQ - 1);
    u32x4 v[7 + W];
#pragma unroll
    for (int r = 0; r < 7 + W; ++r) { const int rel = r - (W - 1); v[r] = (u32x4){0u, 0u, 0u, 0u}; if (t0 + rel >= 0) v[r] = *(const u32x4*)(zp + (size_t)(tok0 + rel) * 512 + ch * 8); }
    float s[8];
#pragma unroll
    for (int j = 0; j < 8; ++j) s[j] = 0.f;
#pragma unroll
    for (int r = 0; r < W; ++r) { s[0] += bflo(v[r].x); s[1] += bfhi(v[r].x); s[2] += bflo(v[r].y); s[3] += bfhi(v[r].y); s[4] += bflo(v[r].z); s[5] += bfhi(v[r].z); s[6] += bflo(v[r].w); s[7] += bfhi(v[r].w); }
#pragma unroll
    for (int j = 0; j < 8; ++j) {
        if (j > 0) { const u32x4 a = v[W - 1 + j], b = v[j - 1];
            s[0] += bflo(a.x) - bflo(b.x); s[1] += bfhi(a.x) - bfhi(b.x); s[2] += bflo(a.y) - bflo(b.y); s[3] += bfhi(a.y) - bfhi(b.y); s[4] += bflo(a.z) - bflo(b.z); s[5] += bfhi(a.z) - bfhi(b.z); s[6] += bflo(a.w) - bflo(b.w); s[7] += bfhi(a.w) - bfhi(b.w); }
        const int n = (t0 + j + 1 < W) ? t0 + j + 1 : W; const float inv = 1.0f / (float)n; const u32x4 cur = v[W - 1 + j];
        u32x4 o; o.x = pk2(s[0] * inv - bflo(cur.x), s[1] * inv - bfhi(cur.x)); o.y = pk2(s[2] * inv - bflo(cur.y), s[3] * inv - bfhi(cur.y));
        o.z = pk2(s[4] * inv - bflo(cur.z), s[5] * inv - bfhi(cur.z)); o.w = pk2(s[6] * inv - bflo(cur.w), s[7] * inv - bfhi(cur.w));
        *(u32x4*)(po + (size_t)(tok0 + j) * 512 + ch * 8) = o; }
}
__device__ __forceinline__ void p2_pooled(Frame& F) {
    refresh(F);
    const bf16* zp = F.w<bf16>(WS_ZPOOL); bf16* po = F.w<bf16>(WS_POOLED);
    for (int wv = F.gw; wv < NTOK / 8 * 64 / 64; wv += F.ngw) {
        const int g = wv & 3, tg = (wv >> 2) * 4 + (F.lane >> 4), ch = g * 16 + (F.lane & 15), tok0 = tg * 8;
        if (g == 0) pooled_group<2>(zp, po, tok0, ch); else if (g == 1) pooled_group<4>(zp, po, tok0, ch); else if (g == 2) pooled_group<8>(zp, po, tok0, ch); else pooled_group<16>(zp, po, tok0, ch);
    }
}

__device__ __forceinline__ unsigned sortable(float v) { const unsigned u = __float_as_uint(v); return u ^ ((u >> 31) ? 0xFFFFFFFFu : 0x80000000u); }
__device__ __forceinline__ unsigned dpp_scan64(unsigned v) {
    v += (unsigned)__builtin_amdgcn_update_dpp(0, (int)v, 0x111, 0xf, 0xf, false);
    v += (unsigned)__builtin_amdgcn_update_dpp(0, (int)v, 0x112, 0xf, 0xf, false);
    v += (unsigned)__builtin_amdgcn_update_dpp(0, (int)v, 0x114, 0xf, 0xf, false);
    v += (unsigned)__builtin_amdgcn_update_dpp(0, (int)v, 0x118, 0xf, 0xf, false);
    v += (unsigned)__builtin_amdgcn_update_dpp(0, (int)v, 0x142, 0xa, 0xf, false);
    v += (unsigned)__builtin_amdgcn_update_dpp(0, (int)v, 0x143, 0xc, 0xf, false);
    return v;
}
__device__ __forceinline__ unsigned umed3(unsigned a, unsigned b, unsigned c) { unsigned r; asm("v_med3_u32 %0, %1, %2, %3" : "=v"(r) : "v"(a), "v"(b), "v"(c)); return r; }
__device__ __forceinline__ void find_bin256(LAS unsigned* hist, int lane, int& k, int& bin, int& bincnt) {
    u32x4 h = *(const LAS u32x4*)(hist + 4 * lane);
#pragma unroll
    for (int c_ = 1; c_ < 8; ++c_) { const u32x4 hc = *(const LAS u32x4*)(hist + c_ * 256 + 4 * lane); h.x += hc.x; h.y += hc.y; h.z += hc.z; h.w += hc.w; }
    const unsigned ls = (h.x + h.y) + (h.z + h.w);
    const unsigned pre = dpp_scan64(ls);
    const unsigned tot = (unsigned)__builtin_amdgcn_readlane((int)pre, 63);
    const unsigned above = tot - pre;
    const bool mine = (above < (unsigned)k) && (above + ls >= (unsigned)k);
    unsigned c = above; int sub; unsigned cnt;
    if (c + h.w >= (unsigned)k) { sub = 3; cnt = h.w; } else { c += h.w; if (c + h.z >= (unsigned)k) { sub = 2; cnt = h.z; } else { c += h.z; if (c + h.y >= (unsigned)k) { sub = 1; cnt = h.y; } else { c += h.y; sub = 0; cnt = h.x; } } }
    const u64 bm = __ballot(mine);
    const int L = (int)__builtin_ctzll(bm | (1ull << 63));
    bin = 4 * L + __builtin_amdgcn_readlane(sub, L); const int ab = __builtin_amdgcn_readlane((int)c, L); bincnt = __builtin_amdgcn_readlane((int)cnt, L);
    k -= ab;
}
__device__ __forceinline__ void p3_load_row(const unsigned short* sc, int row, unsigned (&v)[32], int lane) {
    const int t = row & (SEQ - 1), n = t + 1;
    const int ngrp = (n <= TOPK) ? 0 : ((n + 1023) >> 10); const unsigned* srow = (const unsigned*)(sc + (size_t)row * SEQ) + lane;
#pragma unroll
    for (int g = 0; g < 4; ++g) if (g < ngrp) {
#pragma unroll
        for (int i = 0; i < 8; ++i) v[g * 8 + i] = srow[(g * 8 + i) * 64]; }
}
__device__ __forceinline__ unsigned p3_keys(unsigned w, int e0, int t) {
    unsigned x = w ^ 0x80008000u ^ (((w >> 15) & 0x00010001u) * 0x7fffu);
    if (e0 > t) x = 0u; else if (e0 + 1 > t) x &= 0xffffu;
    return x;
}
struct NoStage { __device__ __forceinline__ void operator()(int) const {} };
template <class LD = NoStage> __device__ __forceinline__ void p3_select_row(Frame& F, int row, LAS unsigned* hist, const unsigned (&key)[32], const LD& ld = LD()) {
    const int lane = F.lane, t = row & (SEQ - 1), n = t + 1;
    u64* mrow = (F.w<u64>(WS_MASK)) + (size_t)row * 64;
    if (n <= TOPK) {
        const int lo = lane * 64; unsigned we, wo;
        if (t >= lo + 63) { we = ~0u; wo = ~0u; } else if (t >= lo) { const int ce = ((t - lo) >> 1) + 1, co = (t - lo + 1) >> 1; we = (ce >= 32) ? ~0u : ((1u << ce) - 1u); wo = (co >= 32) ? ~0u : ((1u << co) - 1u); } else { we = 0u; wo = 0u; }
        mrow[lane] = ((u64)wo << 32) | (u64)we;
        ld(0); ld(1); ld(2); ld(3);
        return;
    }
    const int ngrp = (n + 1023) >> 10;
#define HZERO() do { _Pragma("unroll") for (int j_ = 0; j_ < 9; ++j_) { if (j_ < 8 || lane < 16) *(LAS u32x4*)(hist + 4 * lane + 256 * j_) = (u32x4){0u, 0u, 0u, 0u}; } LDS_WAIT(); } while (0)
    int k = TOPK, bin, bincnt; unsigned T; LAS unsigned* hmine = hist + (lane & 7) * 256;
    ld(0);
    unsigned m0 = 0u, m1 = 0u, m2 = 0u, m3 = 0u;
#pragma unroll
    for (int g = 0; g < 4; ++g) if (g < ngrp) {
#pragma unroll
        for (int i = 0; i < 8; ++i) { const unsigned kv = key[g * 8 + i], kA = kv & 0xffffu, kB = kv >> 16;
            m3 = umed3(m2, m3, kA); m2 = umed3(m1, m2, kA); m1 = umed3(m0, m1, kA); m0 = max(m0, kA);
            m3 = umed3(m2, m3, kB); m2 = umed3(m1, m2, kB); m1 = umed3(m0, m1, kB); m0 = max(m0, kB); } }
    const unsigned Lc = 0xffffu - wave_max_u32(0xffffu - m3);
    ld(1);
    HZERO();
#pragma unroll
    for (int g = 0; g < 4; ++g) if (g < ngrp) {
#pragma unroll
        for (int i = 0; i < 8; ++i) { const unsigned kv = key[g * 8 + i], kA = kv & 0xffffu, kB = kv >> 16;
            if (kA >= Lc) __hip_atomic_fetch_add(hmine + (kA >> 8), 1u, __ATOMIC_RELAXED, __HIP_MEMORY_SCOPE_WORKGROUP);
            if (kB >= Lc) __hip_atomic_fetch_add(hmine + (kB >> 8), 1u, __ATOMIC_RELAXED, __HIP_MEMORY_SCOPE_WORKGROUP); } }
    LDS_WAIT(); asm volatile("" ::: "memory");
    find_bin256(hist, lane, k, bin, bincnt); T = (unsigned)bin << 8;
    LDS_WAIT(); asm volatile("" ::: "memory");
    ld(2);
    if (bincnt != k) {
        const unsigned b0 = (unsigned)bin;
        HZERO();
#pragma unroll
        for (int g = 0; g < 4; ++g) if (g < ngrp) {
#pragma unroll
            for (int i = 0; i < 8; ++i) { const unsigned kv = key[g * 8 + i];
                if (((kv >> 8) & 0xffu) == b0 && (kv & 0xffffu) >= Lc) __hip_atomic_fetch_add(hmine + (kv & 0xffu), 1u, __ATOMIC_RELAXED, __HIP_MEMORY_SCOPE_WORKGROUP);
                if ((kv >> 24) == b0 && (kv >> 16) >= Lc) __hip_atomic_fetch_add(hmine + ((kv >> 16) & 0xffu), 1u, __ATOMIC_RELAXED, __HIP_MEMORY_SCOPE_WORKGROUP); } }
        LDS_WAIT(); asm volatile("" ::: "memory");
        find_bin256(hist, lane, k, bin, bincnt); T |= (unsigned)bin;
        LDS_WAIT(); asm volatile("" ::: "memory");
    }
#undef HZERO
    ld(3);
    T = max(T, Lc);
    const bool exact = (bincnt == k); const int krem = k;
    LAS u32x2* mw = (LAS u32x2*)(hist + 2112);
    mw[lane] = (u32x2){0u, 0u};
    if (exact) {
#pragma unroll
        for (int g = 0; g < 4; ++g) if (g < ngrp) {
#pragma unroll
            for (int i8 = 0; i8 < 8; ++i8) { const int i = g * 8 + i8; const unsigned kv = key[i]; const u64 bA = __ballot((kv & 0xffffu) >= T), bB = __ballot((kv >> 16) >= T);
                if (lane == 0) *(LAS u32x4*)(mw + 2 * i) = (u32x4){(unsigned)bA, (unsigned)bB, (unsigned)(bA >> 32), (unsigned)(bB >> 32)}; } }
    } else {
        const u64 lt_mask = (1ull << lane) - 1ull; int base_eq = 0;
#pragma unroll
        for (int g = 0; g < 4; ++g) if (g < ngrp) {
#pragma unroll
            for (int i8 = 0; i8 < 8; ++i8) { const int i = g * 8 + i8; const unsigned kv = key[i], kA = kv & 0xffffu, kB = kv >> 16;
                const bool eqA = kA == T, eqB = kB == T;
                const u64 beA = __ballot(eqA), beB = __ballot(eqB);
                const int rA = base_eq + __popcll(beA & lt_mask) + __popcll(beB & lt_mask), rB = rA + (eqA ? 1 : 0);
                const u64 bA = __ballot(kA > T || (eqA && rA < krem)), bB = __ballot(kB > T || (eqB && rB < krem));
                if (lane == 0) { mw[2 * i] = (u32x2){(unsigned)bA, (unsigned)bB}; mw[2 * i + 1] = (u32x2){(unsigned)(bA >> 32), (unsigned)(bB >> 32)}; }
                base_eq += __popcll(beA) + __popcll(beB); } }
    }
    LDS_WAIT(); asm volatile("" ::: "memory");
    { const u32x2 w = mw[lane]; mrow[lane] = ((u64)w.y << 32) | (u64)w.x; }
    LDS_WAIT(); asm volatile("" ::: "memory");
}
__device__ __forceinline__ void p3_select(Frame& F) {
    refresh(F);
    LAS unsigned* hist = (LAS unsigned*)(F.lds + F.wave * 9216);
    const unsigned short* sc = F.w<unsigned short>(WS_SC);
    for (int j = F.gw; j < 2048; j += F.ngw) {
        unsigned v[32], key[32];
        p3_load_row(sc, j, v, F.lane);
#pragma unroll 1
        for (int q = 0; q < 8; ++q) { const int b = q >> 1, t = (q & 1) ? (SEQ - 1 - j) : j, row = b * SEQ + t;
            const int n = t + 1;
            if (n > TOPK) {
                const int ngrp = (n + 1023) >> 10;
#pragma unroll
                for (int g = 0; g < 4; ++g) {
                    if (g < ngrp) {
#pragma unroll
                        for (int i = 0; i < 8; ++i) key[g * 8 + i] = p3_keys(v[g * 8 + i], (g * 8 + i) * 128 + 2 * F.lane, t);
                    } else {
#pragma unroll
                        for (int i = 0; i < 8; ++i) key[g * 8 + i] = 0u;
                    } }
            }
            if (q < 7) { const int q2 = q + 1, b2 = q2 >> 1, t2 = (q2 & 1) ? (SEQ - 1 - j) : j; p3_load_row(sc, b2 * SEQ + t2, v, F.lane); }
            p3_select_row(F, row, hist, key);
        }
    }
}

struct MiniJob { const float* src; unsigned char* dst; int ldw; };
__device__ __forceinline__ MiniJob mini_job(int mi, const float* w1, const float* w2, unsigned char* ws) {
    MiniJob j; const int it = mi >> 3, cg = mi & 7;
    if (it < MINI_W1_ITEMS) { const int e = it >> 6, q = it & 63, kb = q >> 3, nb = q & 7; j.ldw = 2048;
        j.src = w1 + (size_t)e * 1024 * 2048 + (size_t)(kb * 128) * 2048 + nb * 256 + cg * 32; j.dst = ws + WS_W1 + ((size_t)e * 2048 + nb * 256 + cg * 32) * 1024 + kb * 128; }
    else { const int r = it - MINI_W1_ITEMS, e = r >> 5, q = r & 31, kb = q >> 2, nb = q & 3; j.ldw = 1024;
        j.src = w2 + (size_t)e * 1024 * 1024 + (size_t)(kb * 128) * 1024 + nb * 256 + cg * 32; j.dst = ws + WS_W2 + ((size_t)e * 1024 + nb * 256 + cg * 32) * 1024 + kb * 128; }
    return j;
}
__device__ __forceinline__ void mini_load(const MiniJob& j, int lane, f32x4 (&cv)[16], int jj) {
    const float* p = j.src + (size_t)(4 * (lane >> 3)) * j.ldw + 4 * (lane & 7);
#pragma unroll
    for (int r = 0; r < 4; ++r) cv[jj * 4 + r] = __builtin_nontemporal_load((const f32x4*)(p + (size_t)(32 * jj + r) * j.ldw));
}
__device__ __forceinline__ void mini_finish(const MiniJob& j, int lane, const f32x4 (&cv)[16], LAS unsigned char* tile) {
    const int k4 = lane >> 3, p = lane & 7;
#pragma unroll
    for (int jj = 0; jj < 4; ++jj) { unsigned d[4];
#pragma unroll
        for (int r = 0; r < 4; ++r) { const f32x4 v = cv[jj * 4 + r]; d[r] = pk4_fp8(clamp448(v.x * W_PRESCALE), clamp448(v.y * W_PRESCALE), clamp448(v.z * W_PRESCALE), clamp448(v.w * W_PRESCALE)); }
        const unsigned a01l = __builtin_amdgcn_perm(d[1], d[0], 0x05010400u), a01h = __builtin_amdgcn_perm(d[1], d[0], 0x07030602u), a23l = __builtin_amdgcn_perm(d[3], d[2], 0x05010400u), a23h = __builtin_amdgcn_perm(d[3], d[2], 0x07030602u);
        const unsigned t0 = __builtin_amdgcn_perm(a23l, a01l, 0x05040100u), t1 = __builtin_amdgcn_perm(a23l, a01l, 0x07060302u), t2 = __builtin_amdgcn_perm(a23h, a01h, 0x05040100u), t3 = __builtin_amdgcn_perm(a23h, a01h, 0x07060302u);
        LAS unsigned char* tp = tile + (4 * p) * 144 + 32 * jj + 4 * k4;
        *(LAS unsigned*)tp = t0; *(LAS unsigned*)(tp + 144) = t1; *(LAS unsigned*)(tp + 288) = t2; *(LAS unsigned*)(tp + 432) = t3; }
    LDS_WAIT(); asm volatile("" ::: "memory");
    { const int n = lane >> 1, h = lane & 1;
#pragma unroll
      for (int i = 0; i < 4; ++i) { const u32x4 o = *(const LAS u32x4*)(tile + n * 144 + h * 64 + i * 16); *(u32x4*)(j.dst + (size_t)n * 1024 + h * 64 + i * 16) = o; } }
    LDS_WAIT(); asm volatile("" ::: "memory");
}
__device__ __forceinline__ void p2_scores_select(Frame& F) {
    refresh(F);
    const int lane = F.lane, wave = F.wave;
    const bf16* QI = F.w<bf16>(WS_QI); const bf16* KI = F.w<bf16>(WS_KI); const float* WI = F.w<float>(WS_WI); unsigned short* SC = F.w<unsigned short>(WS_SC);
    const float* w1 = F.in(IN_W1); const float* w2 = F.in(IN_W2);
    for (int unit = blockIdx.x; unit < 256; unit += F.G) {
        const int b = unit >> 6, p = unit & 63, na = p + 1;
        { LAS unsigned char* stile = F.lds + wave * 2560;
          int idx = (wave * 129) >> 3; const int end = ((wave + 1) * 129) >> 3;
          while (idx < end) { int qb, kb, len;
              if (idx < na) { qb = p; kb = idx; len = (na - idx < end - idx) ? (na - idx) : (end - idx); } else { qb = 127 - p; kb = idx - na; len = end - idx; }
              score_seg(b, qb, kb, len, QI, KI, WI, SC, stile, lane); idx += len; } }
        VM_WAIT(); __syncthreads();
        { refresh(F); const int lane = F.lane; int b_ = b, p_ = p, w_ = wave; asm volatile("" : "+s"(b_), "+s"(p_), "+s"(w_));
          LAS unsigned* hist = (LAS unsigned*)(F.lds + w_ * 9216);
          unsigned v[32], key[32];
#pragma unroll
          for (int i = 0; i < 32; ++i) { v[i] = 0u; key[i] = 0u; }
          auto rowof = [&](int q) { return b_ * SEQ + ((q & 1) ? 32 * (127 - p_) : 32 * p_) + 4 * w_ + (q >> 1); };
          p3_load_row(SC, rowof(0), v, lane);
#pragma unroll 1
          for (int q = 0; q < 8; ++q) { const int row = rowof(q), t = row & (SEQ - 1), n = t + 1;
              const MiniJob mj = mini_job(__builtin_amdgcn_readfirstlane((unit * 8 + w_) * 8 + q), w1, w2, F.ws); f32x4 cv[16];
              if (n > TOPK) {
                  const int ngrp = (n + 1023) >> 10;
#pragma unroll
                  for (int g = 0; g < 4; ++g) {
                      if (g < ngrp) {
#pragma unroll
                          for (int i = 0; i < 8; ++i) key[g * 8 + i] = p3_keys(v[g * 8 + i], (g * 8 + i) * 128 + 2 * lane, t);
                      } else {
#pragma unroll
                          for (int i = 0; i < 8; ++i) key[g * 8 + i] = 0u;
                      } }
              }
              if (q < 7) p3_load_row(SC, rowof(q + 1), v, lane);
              auto stage = [&](int part) { if (part == 0) mini_load(mj, lane, cv, 0); else if (part == 1) mini_load(mj, lane, cv, 1); else if (part == 2) mini_load(mj, lane, cv, 2); else mini_load(mj, lane, cv, 3); };
              p3_select_row(F, row, hist, key, stage);
              mini_finish(mj, lane, cv, F.lds + 73728 + w_ * 4608);
          } }
        VM_WAIT(); __syncthreads();
    }
}

__device__ __forceinline__ int t5_bucket(int n) {
    if (n < 16) return n;
    const int th[16] = {16, 19, 21, 24, 27, 31, 35, 40, 46, 52, 59, 67, 77, 87, 99, 113};
    int b = 16;
#pragma unroll
    for (int i = 1; i < 16; ++i) if (n >= th[i]) b = 16 + i;
    return b;
}
__device__ __forceinline__ void p4_attn_gather(Frame& F) {
    refresh(F);
    const float* rel_bias = F.in(IN_RELB);
    LAS float* biasl = (LAS float*)(F.lds);
    for (int i = F.tid; i < 1024; i += 512) { const int h = i >> 7, d = i & 127; biasl[i] = rel_bias[t5_bucket(d) * 8 + h] * LOG2E; }
    __syncthreads();
    const int lane = F.lane, h = lane >> 3;
    const float bias_far = rel_bias[31 * 8 + h] * LOG2E;
    for (int row = F.gw; row < NTOK; row += F.ngw) {
        const int t = row & (SEQ - 1), b0 = row - t, cnt = (t + 1 < TOPK) ? t + 1 : TOPK;
        const int* irow = (F.w<int>(WS_SELIDX)) + (size_t)row * 256;
        int myidx[4];
        { const u32x4 v = *(const u32x4*)(irow + lane * 4); myidx[0] = (int)v.x; myidx[1] = (int)v.y; myidx[2] = (int)v.z; myidx[3] = (int)v.w; }
        float q[8];
        { const u32x4 v = *(const u32x4*)((F.w<bf16>(WS_Q)) + (size_t)row * 512 + lane * 8); q[0] = bflo(v.x); q[1] = bfhi(v.x); q[2] = bflo(v.y); q[3] = bfhi(v.y); q[4] = bflo(v.z); q[5] = bfhi(v.z); q[6] = bflo(v.w); q[7] = bfhi(v.w); }
        float m = -1e30f, lsum = 0.f, o[8];
#pragma unroll
        for (int j = 0; j < 8; ++j) o[j] = 0.f;
        for (int c0 = 0; c0 < cnt; c0 += 8) {
            u32x4 kv[8], vv[8]; int kid[8]; float lg[8];
#pragma unroll
            for (int j = 0; j < 8; ++j) { const int kk = c0 + j; int id = __shfl(myidx[j & 3], kk >> 2); if (kk >= cnt) id = 0; kid[j] = id;
                kv[j] = *(const u32x4*)((F.w<bf16>(WS_K)) + (size_t)(b0 + id) * 512 + lane * 8); vv[j] = *(const u32x4*)((F.w<bf16>(WS_V)) + (size_t)(b0 + id) * 512 + lane * 8); }
            float cm = -1e30f;
#pragma unroll
            for (int j = 0; j < 8; ++j) { const u32x4 kx = kv[j];
                float d = q[0] * bflo(kx.x) + q[1] * bfhi(kx.x) + q[2] * bflo(kx.y) + q[3] * bfhi(kx.y) + q[4] * bflo(kx.z) + q[5] * bfhi(kx.z) + q[6] * bflo(kx.w) + q[7] * bfhi(kx.w);
                d += __shfl_xor(d, 1); d += __shfl_xor(d, 2); d += __shfl_xor(d, 4);
                const int dist = t - kid[j];
                const float bs = (dist < 128) ? biasl[h * 128 + (dist < 0 ? 0 : dist)] : bias_far;
                lg[j] = (c0 + j < cnt) ? d + bs : -INFINITY;
                cm = fmaxf(cm, lg[j]); }
            const float mn = fmaxf(m, cm), f = __builtin_amdgcn_exp2f(m - mn);
            lsum *= f;
#pragma unroll
            for (int i = 0; i < 8; ++i) o[i] *= f;
            m = mn;
#pragma unroll
            for (int j = 0; j < 8; ++j) { const float p = __builtin_amdgcn_exp2f(lg[j] - m); lsum += p; const u32x4 vx = vv[j];
                o[0] += p * bflo(vx.x); o[1] += p * bfhi(vx.x); o[2] += p * bflo(vx.y); o[3] += p * bfhi(vx.y); o[4] += p * bflo(vx.z); o[5] += p * bfhi(vx.z); o[6] += p * bflo(vx.w); o[7] += p * bfhi(vx.w); }
        }
        const float inv = 1.0f / lsum;
        u32x4 w; w.x = pk2(o[0] * inv, o[1] * inv); w.y = pk2(o[2] * inv, o[3] * inv); w.z = pk2(o[4] * inv, o[5] * inv); w.w = pk2(o[6] * inv, o[7] * inv);
        *(u32x4*)((F.w<bf16>(WS_AO)) + (size_t)row * 512 + lane * 8) = w;
    }
}

__device__ __forceinline__ void p4_attn_dense(Frame& F, char* lds_generic) {
    refresh(F);
    const float* rel_bias = F.in(IN_RELB);
    LAS float* lut8 = (LAS float*)(F.lds + TAB_OFF);
    for (int i = F.tid; i < 1024; i += 512) { const int h = i >> 7, d = i & 127; lut8[i] = (d < 113) ? (rel_bias[t5_bucket(d) * 8 + h] - rel_bias[31 * 8 + h]) * LOG2E : 0.f; }
    __syncthreads();
    const attn_body::AttnTensors AT{(const attn_body::bf16*)F.w<bf16>(WS_Q), (const attn_body::bf16*)F.w<bf16>(WS_K), (const attn_body::bf16*)F.w<bf16>(WS_V), (attn_body::bf16*)F.w<bf16>(WS_AO), (const unsigned long long*)F.w<u64>(WS_MASK)};
    const attn_body::StaticOrder S(F.G, (int)blockIdx.x);
    attn_body::attn_phase<attn_body::StaticOrder>(lds_generic, AT, lut8, S);
}
__device__ __forceinline__ void p7_router(Frame& F) {
    refresh(F);
    const float* w_router = F.in(IN_WR); const float* b_router = F.in(IN_BR); const float* ffn_norm = F.in(IN_FFNN);
    LAS float* X = (LAS float*)F.lds; LAS int* rt = (LAS int*)(F.lds + TAB_OFF); LAS float* LG = (LAS float*)(F.lds + TAB_OFF + 4096); LAS float* RS = (LAS float*)(F.lds + TAB_OFF + 8192);
    const int lane = F.lane, wave = F.wave, n = lane & 31, hi = lane >> 5;
    float bw[64];
#pragma unroll
    for (int q = 0; q < 16; ++q) { const int k0 = 128 * wave + 8 * q + 4 * hi; const f32x4 g = *(const f32x4*)(ffn_norm + k0);
        bw[4 * q] = w_router[(size_t)k0 * 32 + n] * g.x; bw[4 * q + 1] = w_router[(size_t)(k0 + 1) * 32 + n] * g.y; bw[4 * q + 2] = w_router[(size_t)(k0 + 2) * 32 + n] * g.z; bw[4 * q + 3] = w_router[(size_t)(k0 + 3) * 32 + n] * g.w; }
    const f32x4 g0 = *(const f32x4*)(ffn_norm + 8 * lane), g1 = *(const f32x4*)(ffn_norm + 8 * lane + 4), g2 = *(const f32x4*)(ffn_norm + 512 + 8 * lane), g3 = *(const f32x4*)(ffn_norm + 512 + 8 * lane + 4);
    if (F.tid < 32) rt[F.tid] = 0;
    const float brt = b_router[F.tid & 31];
    __syncthreads();
    for (int tg = blockIdx.x; tg < NTOK / 64; tg += F.G) {
#pragma unroll 1
        for (int grp = 0; grp < 2; ++grp) {
            const int tokg = tg * 64 + grp * 32;
            { u32x4 xa[4], xb[4];
#pragma unroll
              for (int i = 0; i < 4; ++i) { const bf16* xr = F.w<bf16>(WS_X1) + (size_t)(tokg + 4 * wave + i) * D + 8 * lane; xa[i] = *(const u32x4*)xr; xb[i] = *(const u32x4*)(xr + 512); }
#pragma unroll
              for (int i = 0; i < 4; ++i) { const int t = 4 * wave + i;
                const f32x4 a0 = {bflo(xa[i].x), bfhi(xa[i].x), bflo(xa[i].y), bfhi(xa[i].y)}, a1 = {bflo(xa[i].z), bfhi(xa[i].z), bflo(xa[i].w), bfhi(xa[i].w)};
                const f32x4 b0 = {bflo(xb[i].x), bfhi(xb[i].x), bflo(xb[i].y), bfhi(xb[i].y)}, b1 = {bflo(xb[i].z), bfhi(xb[i].z), bflo(xb[i].w), bfhi(xb[i].w)};
                float ss = (a0.x * a0.x + a0.y * a0.y) + (a0.z * a0.z + a0.w * a0.w); ss += (a1.x * a1.x + a1.y * a1.y) + (a1.z * a1.z + a1.w * a1.w);
                ss += (b0.x * b0.x + b0.y * b0.y) + (b0.z * b0.z + b0.w * b0.w); ss += (b1.x * b1.x + b1.y * b1.y) + (b1.z * b1.z + b1.w * b1.w);
                LAS float* xrow = X + t * 1024; const int sw = t & 15;
                *(LAS f32x4*)(xrow + (((2 * lane) ^ sw) << 2)) = a0; *(LAS f32x4*)(xrow + (((2 * lane + 1) ^ sw) << 2)) = a1;
                *(LAS f32x4*)(xrow + (((128 + 2 * lane) ^ sw) << 2)) = b0; *(LAS f32x4*)(xrow + (((129 + 2 * lane) ^ sw) << 2)) = b1;
                const float rstd = 1.0f / sqrtf(wave_sum(ss) * (1.f / D) + RMS_EPS), rp = rstd * H_PRESCALE;
                if (lane == 0) RS[t] = rstd;
                unsigned char* hr = F.w<unsigned char>(WS_H) + (size_t)(tokg + t) * D + 8 * lane;
                u32x2 o;
                o.x = pk4_fp8(a0.x * rp * g0.x, a0.y * rp * g0.y, a0.z * rp * g0.z, a0.w * rp * g0.w); o.y = pk4_fp8(a1.x * rp * g1.x, a1.y * rp * g1.y, a1.z * rp * g1.z, a1.w * rp * g1.w); *(u32x2*)hr = o;
                o.x = pk4_fp8(b0.x * rp * g2.x, b0.y * rp * g2.y, b0.z * rp * g2.z, b0.w * rp * g2.w); o.y = pk4_fp8(b1.x * rp * g3.x, b1.y * rp * g3.y, b1.z * rp * g3.z, b1.w * rp * g3.w); *(u32x2*)(hr + 512) = o; } }
            __syncthreads();
            f32x16 acc;
#pragma unroll
            for (int i = 0; i < 16; ++i) acc[i] = 0.f;
            { const LAS float* xrow = X + n * 1024; const int sw = n & 15;
#pragma unroll
              for (int q = 0; q < 16; ++q) { const f32x4 a = *(const LAS f32x4*)(xrow + (((32 * wave + 2 * q + hi) ^ sw) << 2));
                acc = __builtin_amdgcn_mfma_f32_32x32x2f32(a.x, bw[4 * q], acc, 0, 0, 0); acc = __builtin_amdgcn_mfma_f32_32x32x2f32(a.y, bw[4 * q + 1], acc, 0, 0, 0);
                acc = __builtin_amdgcn_mfma_f32_32x32x2f32(a.z, bw[4 * q + 2], acc, 0, 0, 0); acc = __builtin_amdgcn_mfma_f32_32x32x2f32(a.w, bw[4 * q + 3], acc, 0, 0, 0); } }
            __syncthreads();
            { LAS float* P = X + wave * 1024;
#pragma unroll
              for (int i = 0; i < 16; ++i) P[((i & 3) + 8 * (i >> 2) + 4 * hi) * 32 + n] = acc[i]; }
            __syncthreads();
#pragma unroll
            for (int o = 0; o < 2; ++o) { const int idx = F.tid + 512 * o; float s = X[idx];
#pragma unroll
                for (int w = 1; w < 8; ++w) s += X[w * 1024 + idx];
                LG[idx] = s * RS[idx >> 5] + brt; }
            __syncthreads();
#pragma unroll 1
            for (int pass = 0; pass < 2; ++pass) {
                const int t0 = 4 * wave + 2 * pass, tok0 = tokg + t0;
                f32x2 lg; lg.x = LG[t0 * 32 + (lane >> 1)]; lg.y = LG[(t0 + 1) * 32 + (lane >> 1)];
#pragma unroll
                for (int tk = 0; tk < 2; ++tk) {
                    const float v = (tk ? lg.y : lg.x) + 0.f;
                    unsigned sk = sortable(v);
                    float tv[4]; int te[4];
#pragma unroll
                    for (int r = 0; r < 4; ++r) { const unsigned mk = wave_max_u32(sk); const u64 bal = __ballot(sk == mk); const int ln = (int)__builtin_ctzll(bal | (1ull << 63)); const int bi = ln >> 1;
                        tv[r] = __int_as_float(__builtin_amdgcn_readlane(__float_as_int(v), ln)); te[r] = bi; sk = ((lane >> 1) == bi) ? 0u : sk; }
                    const float e1 = __expf(tv[1] - tv[0]), e2 = __expf(tv[2] - tv[0]), e3 = __expf(tv[3] - tv[0]), inv = 1.0f / (1.0f + e1 + e2 + e3);
                    const float gt[4] = {inv, e1 * inv, e2 * inv, e3 * inv};
                    if (lane == 0) { const int tok = tok0 + tk, sl = (tok - tg * 64) * 4;
#pragma unroll
                        for (int r = 0; r < 4; ++r) { const int lp = __hip_atomic_fetch_add(rt + te[r], 1, __ATOMIC_RELAXED, __HIP_MEMORY_SCOPE_WORKGROUP); rt[64 + sl + r] = te[r]; rt[320 + sl + r] = lp; (F.w<float>(WS_TOKGATE))[(size_t)tok * 4 + r] = gt[r]; } }
                }
            }
        }
        __syncthreads();
        if (F.tid < 32) { const int c = rt[F.tid]; int base = 0; if (c) base = (int)__hip_atomic_fetch_add(F.ctl() + CW_ECNT + 64 * F.tid, (unsigned)c, RLX_AGENT); rt[32 + F.tid] = base; }
        __syncthreads();
        if (F.tid < 256) { const int e = rt[64 + F.tid], pos = rt[32 + e] + rt[320 + F.tid]; (F.w<int>(WS_LIST))[(size_t)e * NTOK + pos] = (tg * 64 + (F.tid >> 2)) * 4 + (F.tid & 3); }
        __syncthreads();
        if (F.tid < 32) rt[F.tid] = 0;
        __syncthreads();
    }
}
__device__ __forceinline__ void moe_rows_fill(Frame& F, const int* list, const float* tokgate, const float* b2) {
    const LAS int* tab = (const LAS int*)(F.lds + TAB_OFF); LAS int* rows = (LAS int*)(F.lds + TAB_OFF + 4096); LAS float* bias = (LAS float*)(F.lds + BIAS_OFF);
    const int T = tab[64], nwg = T * 4;
    for (int q = F.tid; q < 5 * 256; q += 512) { const int i = q >> 8, r = q & 255; const long L = (long)i * F.G + (int)blockIdx.x; int ts = 0; float g = 0.f;
        float bv = 0.f;
        if (L < nwg) { const int wgid = pg8::xcd_remap((int)L, nwg), mt = wgid >> 2, pn = wgid & 3; const int te = tab[128 + mt], e = te >> 16, lt = te & 0xffff, cnt = tab[e], pos = lt * 256 + r;
            if (pos < cnt) { ts = list[(size_t)e * NTOK + pos]; g = tokgate[ts]; }
            bv = b2[(size_t)e * 1024 + pn * 256 + r]; }
        rows[2 * q] = ts; rows[2 * q + 1] = __float_as_int(g); bias[q] = bv; }
    __syncthreads();
}
__device__ __forceinline__ void build_moe_tab(Frame& F) {
    refresh(F);
    LAS int* tab = (LAS int*)(F.lds + TAB_OFF);
    if (F.tid < 32) tab[F.tid] = (int)__hip_atomic_load(F.ctl() + CW_ECNT + 64 * F.tid, RLX_AGENT);
    __syncthreads();
    if (F.tid == 0) { int off = 0, T = 0;
        for (int e = 0; e < 32; ++e) { const int c = tab[e], nt = (c + 255) >> 8; tab[32 + e] = off; for (int lt = 0; lt < nt; ++lt) tab[128 + T++] = (e << 16) | lt; off += nt * 256; }
        tab[64] = T; }
    __syncthreads();
}
struct FinRow { u32x2 x[4]; unsigned y[4][4]; };
__device__ __forceinline__ void p10_load(FinRow& r, const bf16* x1, const unsigned char* ys, int m, int lane) {
    const u32x2* xr = (const u32x2*)(x1 + (size_t)m * D) + lane;
#pragma unroll
    for (int j = 0; j < 4; ++j) r.x[j] = __builtin_nontemporal_load(xr + 64 * j);
#pragma unroll
    for (int kq = 0; kq < 4; ++kq) { const unsigned* yr = (const unsigned*)(ys + ((size_t)m * 4 + kq) * D) + lane;
#pragma unroll
        for (int j = 0; j < 4; ++j) r.y[kq][j] = __builtin_nontemporal_load(yr + 64 * j); }
}
__device__ __forceinline__ void p10_row(const FinRow& r, const float* final_norm, float* out, int m, int lane) {
    f32x4 v[4]; float s = 0.f;
#pragma unroll
    for (int j = 0; j < 4; ++j) { f32x4 ysum = {0.f, 0.f, 0.f, 0.f};
#pragma unroll
        for (int kq = 0; kq < 4; ++kq) { const int y = (int)r.y[kq][j]; const auto lo = __builtin_amdgcn_cvt_pk_f32_fp8(y, false), hi2 = __builtin_amdgcn_cvt_pk_f32_fp8(y, true); ysum.x += lo[0]; ysum.y += lo[1]; ysum.z += hi2[0]; ysum.w += hi2[1]; }
        v[j] = (f32x4){bflo(r.x[j].x), bfhi(r.x[j].x), bflo(r.x[j].y), bfhi(r.x[j].y)} + ysum * (1.0f / YS_PRESCALE);
        s += (v[j].x * v[j].x + v[j].y * v[j].y) + (v[j].z * v[j].z + v[j].w * v[j].w); }
    const float rstd = 1.0f / sqrtf(wave_sum(s) * (1.f / D) + RMS_EPS);
    const f32x4* gr = (const f32x4*)final_norm + lane; f32x4* o = (f32x4*)(out + (size_t)m * D) + lane;
#pragma unroll
    for (int j = 0; j < 4; ++j) { const f32x4 g = gr[64 * j]; __builtin_nontemporal_store(v[j] * rstd * g, o + 64 * j); }
}
__device__ __forceinline__ void p10_final(Frame& F) {
    refresh(F);
    const float* final_norm = F.in(IN_FINN); float* out = F.outp();
    const bf16* x1 = F.w<bf16>(WS_X1); const unsigned char* ys = F.w<unsigned char>(WS_YS);
    const int lane = F.lane, st = F.ngw;
    FinRow A, B; int m = F.gw;
    if (m < NTOK) p10_load(A, x1, ys, m, lane);
    while (m < NTOK) {
        const int m2 = m + st, m3 = m2 + st;
        if (m2 < NTOK) p10_load(B, x1, ys, m2, lane);
        p10_row(A, final_norm, out, m, lane);
        if (m3 < NTOK) p10_load(A, x1, ys, m3, lane);
        if (m2 < NTOK) p10_row(B, final_norm, out, m2, lane);
        m = m3;
    }
}

__global__ void __launch_bounds__(NWAVES * 64, 2) fwd_kernel(Args args) {
    extern __shared__ __attribute__((aligned(16))) unsigned char lds[];
    Frame F;
    F.lds = (LAS unsigned char*)lds;
    F.tid = threadIdx.x; F.lane = F.tid & 63; F.wave = __builtin_amdgcn_readfirstlane(F.tid >> 6);
    F.G = gridDim.x; F.gw = blockIdx.x * NWAVES + F.wave; F.ngw = F.G * NWAVES;
    F.ws = args.ws;
    for (int u = F.tid; u < (LDS_BYTES - LDSCTL_OFF) / 4; u += NWAVES * 64) ((LAS unsigned*)(F.lds + LDSCTL_OFF))[u] = 0u;
    __syncthreads();
    XcdBarrier bar = xcd_barrier_post(F.ctl() + CW_BAR, (volatile LAS unsigned*)(F.lds + MISC_OFF) + 8);
    const int bx = (int)blockIdx.x;

    REP(0) p0_prologue(F);
    xcd_barrier(bar);
    {
      { pg8::DenseSched S; S.init(NTOK, 1024, 1024, F.w<bf16>(WS_WINI), F.G, bx);
        EpiInProj<true> E{F.w<bf16>(WS_ZPOOL), F.w<bf16>(WS_Q), F.w<bf16>(WS_K), F.w<bf16>(WS_V), F.w<bf16>(WS_QI), F.w<bf16>(WS_KI), F.w<bf16>(WS_GATE), F.w<float>(WS_WI)};
        pg8::gemm_phase<EpiInProj<true>, pg8::DenseSched, true>(F.lds, (const char*)F.w<bf16>(WS_H), 1024, S, E); }
      { pg8::DenseSched S; S.init(NTOK, 3584, 512, F.w<bf16>(WS_WIN), F.G, bx, 1);
        EpiInProj<false> E{F.w<bf16>(WS_ZPOOL), F.w<bf16>(WS_Q), F.w<bf16>(WS_K), F.w<bf16>(WS_V), F.w<bf16>(WS_QI), F.w<bf16>(WS_KI), F.w<bf16>(WS_GATE), F.w<float>(WS_WI)};
        pg8::gemm_phase<EpiInProj<false>, pg8::DenseSched, true, true, 0x78787878, 0x7c7c7c7c>(F.lds, (const char*)F.w<bf16>(WS_H8X), 512, S, E);
        { const int nidle = S.split ? 128 : F.G; if (bx < nidle) p0_copy<true>(F, IT_W1_END - NW1T + bx, IT_W1_END, nidle, 1 << 30, 0); } } }
    xcd_barrier(bar);
    REP(2) { p2_pooled(F); p2_scores_select(F); }
    xcd_barrier(bar);
    { pg8::DenseSched S; S.init(NTOK, 1024, 512, (F.w<bf16>(WS_WPC)), F.G, bx);
      EpiGate<false> E{(F.w<bf16>(WS_MERGED)), (F.w<bf16>(WS_GATE)), 0};
      pg8::gemm_phase<EpiGate<false>, pg8::DenseSched, true>(F.lds, (const char*)(F.w<bf16>(WS_POOLED)), 512, S, E); }
    REP(4) p4_attn_dense(F, (char*)lds);
    xcd_barrier(bar);
    { pg8::DenseSched S; S.init(NTOK, 1024, 256, (F.w<bf16>(WS_WBA)), F.G, bx);
      EpiGate<true> E{(F.w<bf16>(WS_MERGED)), (F.w<bf16>(WS_GATE)), 1024};
      pg8::gemm_phase<EpiGate<true>, pg8::DenseSched, true, true, 0x78787878, 0x78787878>(F.lds, (const char*)(F.w<bf16>(WS_AO)), 256, S, E); }
    xcd_barrier(bar);
    REP(6) { pg8::DenseSched S; S.init(NTOK, 1024, 1024, (F.w<bf16>(WS_WOUT)), F.G, bx);
      EpiResidual E{F.in(IN_X), F.w<bf16>(WS_X1)};
      pg8::gemm_phase<EpiResidual, pg8::DenseSched, true>(F.lds, (const char*)(F.w<bf16>(WS_MERGED)), 1024, S, E); }
    xcd_barrier(bar);
    p7_router(F);
    xcd_barrier(bar);
    build_moe_tab(F); moe_gather_fill(F, F.w<int>(WS_LIST), F.in(IN_B1));
    REP(8) { MoeSched1 S{(const LAS int*)(F.lds + TAB_OFF), (const LAS int*)(F.lds + TAB_OFF + 4096), (const char*)(F.w<bf16>(WS_W1)), F.G, bx};
      EpiSwiGLU E{F.w<unsigned char>(WS_ACT), (const LAS float*)(F.lds + BIAS_OFF)};
      pg8::gemm_phase<EpiSwiGLU, MoeSched1, true, true, 0x78787878, 0x7c7c7c7c>(F.lds, (const char*)(F.w<bf16>(WS_H)), 512, S, E); }
    { const int T = ((const LAS int*)(F.lds + TAB_OFF))[64], rem = (T * 8) % F.G, nid = F.G - rem, base = IT_END - NW2T; int cover = nid * TAIL_PER; if (cover > NW2T) cover = NW2T;
      if (bx >= rem) p0_copy<true>(F, base + (bx - rem), base + cover, nid, 1 << 30, 0);
      if (cover < NW2T) p0_copy<true>(F, base + cover + bx, IT_END, F.G, 1 << 30, 0); }
    xcd_barrier(bar);
    moe_rows_fill(F, F.w<int>(WS_LIST), F.w<float>(WS_TOKGATE), F.in(IN_B2));
    REP(9) { MoeSched2 S{(const LAS int*)(F.lds + TAB_OFF), (const char*)(F.w<bf16>(WS_W2)), F.G, bx};
      EpiMoeOut E{F.w<unsigned char>(WS_YS), (const LAS float*)(F.lds + BIAS_OFF), (const LAS int*)(F.lds + TAB_OFF + 4096)};
      pg8::gemm_phase<EpiMoeOut, MoeSched2, true, true, 0x78787878, 0x7d7d7d7d>(F.lds, (const char*)(F.w<bf16>(WS_ACT)), 512, S, E); }
    xcd_barrier(bar);
    REP(10) p10_final(F);
}

#ifndef PROBE_PH
#define PROBE_PH -1
#endif
#if PROBE_PH >= 0
__global__ void __launch_bounds__(NWAVES * 64, 2) probe_kernel(Args args) {
    extern __shared__ __attribute__((aligned(16))) unsigned char lds[];
    Frame F; F.lds = (LAS unsigned char*)lds; F.tid = threadIdx.x; F.lane = F.tid & 63; F.wave = __builtin_amdgcn_readfirstlane(F.tid >> 6);
    F.G = gridDim.x; F.gw = blockIdx.x * NWAVES + F.wave; F.ngw = F.G * NWAVES; F.ws = args.ws;
    if (PROBE_PH == 0) p0_prologue(F);
    if (PROBE_PH == 2) { p2_pooled(F); p2_scores_select(F); }
    if (PROBE_PH == 3) p3_select(F);
    if (PROBE_PH == 4) p4_attn_gather(F);
    if (PROBE_PH == 10) p10_final(F);
    if (PROBE_PH == 20) p2_scores_select(F);
    if (PROBE_PH == 21) p2_pooled(F);
    const int bx = (int)blockIdx.x;
    if (PROBE_PH == 1) {
      { pg8::DenseSched S; S.init(NTOK, 1024, 1024, F.w<bf16>(WS_WINI), F.G, bx);
        EpiInProj<true> E{F.w<bf16>(WS_ZPOOL), F.w<bf16>(WS_Q), F.w<bf16>(WS_K), F.w<bf16>(WS_V), F.w<bf16>(WS_QI), F.w<bf16>(WS_KI), F.w<bf16>(WS_GATE), F.w<float>(WS_WI)};
        pg8::gemm_phase<EpiInProj<true>, pg8::DenseSched, true>(F.lds, (const char*)F.w<bf16>(WS_H), 1024, S, E); }
      { pg8::DenseSched S; S.init(NTOK, 3584, 512, F.w<bf16>(WS_WIN), F.G, bx, 1);
        EpiInProj<false> E{F.w<bf16>(WS_ZPOOL), F.w<bf16>(WS_Q), F.w<bf16>(WS_K), F.w<bf16>(WS_V), F.w<bf16>(WS_QI), F.w<bf16>(WS_KI), F.w<bf16>(WS_GATE), F.w<float>(WS_WI)};
        pg8::gemm_phase<EpiInProj<false>, pg8::DenseSched, true, true, 0x78787878, 0x7c7c7c7c>(F.lds, (const char*)F.w<bf16>(WS_H8X), 512, S, E); } }
    if (PROBE_PH == 6) { pg8::DenseSched S; S.init(NTOK, 1024, 1024, F.w<bf16>(WS_WOUT), F.G, bx);
      EpiResidual E{F.in(IN_X), F.w<bf16>(WS_X1)};
      pg8::gemm_phase<EpiResidual, pg8::DenseSched, true>(F.lds, (const char*)F.w<bf16>(WS_MERGED), 1024, S, E); }
    if (PROBE_PH == 7) p7_router(F);
    if (PROBE_PH == 8) { build_moe_tab(F); moe_gather_fill(F, F.w<int>(WS_LIST), F.in(IN_B1)); MoeSched1 S{(const LAS int*)(F.lds + TAB_OFF), (const LAS int*)(F.lds + TAB_OFF + 4096), (const char*)F.w<bf16>(WS_W1), F.G, bx};
      EpiSwiGLU E{F.w<unsigned char>(WS_ACT), (const LAS float*)(F.lds + BIAS_OFF)};
      pg8::gemm_phase<EpiSwiGLU, MoeSched1, true, true, 0x78787878, 0x7c7c7c7c>(F.lds, (const char*)F.w<bf16>(WS_H), 512, S, E); }
    if (PROBE_PH == 9) { build_moe_tab(F); moe_rows_fill(F, F.w<int>(WS_LIST), F.w<float>(WS_TOKGATE), F.in(IN_B2)); MoeSched2 S{(const LAS int*)(F.lds + TAB_OFF), (const char*)F.w<bf16>(WS_W2), F.G, bx};
      EpiMoeOut E{F.w<unsigned char>(WS_YS), (const LAS float*)(F.lds + BIAS_OFF), (const LAS int*)(F.lds + TAB_OFF + 4096)};
      pg8::gemm_phase<EpiMoeOut, MoeSched2, true, true, 0x78787878, 0x7d7d7d7d>(F.lds, (const char*)F.w<bf16>(WS_ACT), 512, S, E); }
    if (PROBE_PH == 40) p4_attn_dense(F, (char*)lds);
    if (PROBE_PH == 99) { }
}
#endif

extern "C" void kernel_launch(void* const* d_in, const int* in_sizes, int n_in, void* d_out, int out_size, void* d_ws, size_t ws_size, hipStream_t stream) {
    static int grid = 0;
    if (grid == 0) {
        if (n_in != 17 || in_sizes[0] != NTOK * D || out_size != NTOK * D || ws_size < WS_END) { fprintf(stderr, "kernel_launch: unexpected problem shape (n_in %d, in0 %d, out %d, ws %zu)\n", n_in, n_in > 0 ? in_sizes[0] : -1, out_size, ws_size); grid = -1; return; }
        int dev = 0, cus = 0, per_cu = 0;
        if (hipGetDevice(&dev) != hipSuccess || hipDeviceGetAttribute(&cus, hipDeviceAttributeMultiprocessorCount, dev) != hipSuccess) { grid = -1; return; }
        if (hipFuncSetAttribute((const void*)fwd_kernel, hipFuncAttributeMaxDynamicSharedMemorySize, LDS_BYTES) != hipSuccess) { fprintf(stderr, "kernel_launch: hipFuncSetAttribute failed\n"); grid = -1; return; }
        if (hipOccupancyMaxActiveBlocksPerMultiprocessor(&per_cu, (const void*)fwd_kernel, NWAVES * 64, LDS_BYTES) != hipSuccess || per_cu < 1) fprintf(stderr, "kernel_launch: occupancy query reports %d\n", per_cu);
#if PROBE_PH >= 0
        (void)hipFuncSetAttribute((const void*)probe_kernel, hipFuncAttributeMaxDynamicSharedMemorySize, LDS_BYTES);
#endif
        (void)hipGetLastError();
        grid = cus;
    }
    if (grid < 0) return;
    if (hipMemsetAsync((char*)d_ws + WS_CTL, 0, CTL_ZERO_BYTES, stream) != hipSuccess) return;
    Args a{};
    for (int i = 0; i < 17; ++i) a.in[i] = (const float*)d_in[i];
    a.out = (float*)d_out; a.ws = (unsigned char*)d_ws;
    hipLaunchKernelGGL(fwd_kernel, dim3(grid), dim3(NWAVES * 64), LDS_BYTES, stream, a);
#if PROBE_PH >= 0
    hipLaunchKernelGGL(probe_kernel, dim3(grid), dim3(NWAVES * 64), LDS_BYTES, stream, a);
#endif
}
```

```cpp
#include <hip/hip_runtime.h>
#include <cstdio>
#include <cstdint>
#include <hip/hip_bf16.h>
#include <cmath>
#ifndef DUP
#define DUP 0
#endif
#define REP(k) for (int rep_ = 0; rep_ < 1 + ((DUP >> (k)) & 1); ++rep_)

#define LAS __attribute__((address_space(3)))
#define GAS __attribute__((address_space(1)))
typedef unsigned short bf16;
typedef short bf16x8 __attribute__((ext_vector_type(8)));
typedef float f32x4 __attribute__((ext_vector_type(4)));
typedef float f32x2 __attribute__((ext_vector_type(2)));
typedef float f32x16 __attribute__((ext_vector_type(16)));
typedef unsigned u32x4 __attribute__((ext_vector_type(4)));
typedef unsigned u32x2 __attribute__((ext_vector_type(2)));
typedef unsigned long long u64;

constexpr int NB = 4, SEQ = 4096, NTOK = NB * SEQ, D = 1024;
constexpr int DIN = 4420, DINP = 4608;
constexpr int NE = 32, DFF = 1024, TOPK = 256;
constexpr float RMS_EPS = 1e-5f;
constexpr float LOG2E = 1.4426950408889634f;
constexpr float QSCALE = 0.125f * LOG2E;
constexpr int ACT_ROWS = 73728;
constexpr int NWAVES = 8;

constexpr size_t MiB = 1u << 20;
constexpr size_t WS_CTL = 0, CTL_ZERO_BYTES = 96 * 1024;
constexpr size_t WS_WIN = 2 * MiB;
constexpr size_t WS_WINI = 6 * MiB;
constexpr size_t WS_H8X = 80 * MiB;
constexpr size_t WS_WPC = 11 * MiB;
constexpr size_t WS_WBA = 12 * MiB;
constexpr size_t WS_WOUT = 13 * MiB;
constexpr size_t WS_W1 = 16 * MiB;
constexpr size_t WS_W2 = 144 * MiB;
constexpr size_t WS_H = 208 * MiB;
constexpr size_t WS_ZPOOL = 240 * MiB;
constexpr size_t WS_Q = 256 * MiB, WS_K = 272 * MiB, WS_V = 288 * MiB;
constexpr size_t WS_QI = 304 * MiB;
constexpr size_t WS_KI = 312 * MiB;
constexpr size_t WS_WI = 314 * MiB;
constexpr size_t WS_GATE = 316 * MiB;
constexpr size_t WS_POOLED = 380 * MiB;
constexpr size_t WS_AO = 396 * MiB;
constexpr size_t WS_MERGED = 412 * MiB;
constexpr size_t WS_X1 = 444 * MiB;
constexpr size_t WS_SC = 508 * MiB;
constexpr size_t WS_YS = 508 * MiB;
constexpr size_t WS_MASK = 764 * MiB;
constexpr size_t WS_SELIDX = 772 * MiB;
constexpr size_t WS_TOKGATE = 788 * MiB;
constexpr size_t WS_LIST = 790 * MiB;
constexpr size_t WS_ACT = 792 * MiB;
constexpr size_t WS_END = 936 * MiB;
constexpr int CW_BAR = 4096;
constexpr int CW_ECNT = 16384;
constexpr int CW_PANA = 18432, CW_PANB = 20480;

constexpr int RING_BYTES = 131072;
constexpr int LDSCTL_OFF = RING_BYTES, MISC_OFF = LDSCTL_OFF + 320;
constexpr int TAB_OFF = RING_BYTES + 1024;
constexpr int LDS_BYTES = 163840;
constexpr int BIAS_OFF = TAB_OFF + 14336;

#define RLX_AGENT __ATOMIC_RELAXED, __HIP_MEMORY_SCOPE_AGENT
#define LDS_WAIT() asm volatile("s_waitcnt lgkmcnt(0)" ::: "memory")
#define VM_WAIT() asm volatile("s_waitcnt vmcnt(0)" ::: "memory")
__device__ __forceinline__ unsigned f2bf(float f) { unsigned u = __builtin_bit_cast(unsigned, f); return (u + 0x7fffu + ((u >> 16) & 1u)) >> 16; }
__device__ __forceinline__ unsigned pk2(float lo, float hi) { return f2bf(lo) | (f2bf(hi) << 16); }
__device__ __forceinline__ float bflo(unsigned w) { return __uint_as_float(w << 16); }
__device__ __forceinline__ float bfhi(unsigned w) { return __uint_as_float(w & 0xffff0000u); }
__device__ __forceinline__ unsigned cvt_pk_bf16(float lo, float hi) { unsigned r; asm volatile("v_cvt_pk_bf16_f32 %0, %1, %2" : "=v"(r) : "v"(lo), "v"(hi)); return r; }
#define DPPF(v, ctrl, rmask) __int_as_float(__builtin_amdgcn_update_dpp(0, __float_as_int(v), ctrl, rmask, 0xf, false))
#define DPPU(v, ctrl, rmask) ((unsigned)__builtin_amdgcn_update_dpp(0, (int)(v), ctrl, rmask, 0xf, false))
__device__ __forceinline__ float wave_sum(float v) {
    v += DPPF(v, 0x111, 0xf); v += DPPF(v, 0x112, 0xf); v += DPPF(v, 0x114, 0xf); v += DPPF(v, 0x118, 0xf); v += DPPF(v, 0x142, 0xa); v += DPPF(v, 0x143, 0xc);
    return __int_as_float(__builtin_amdgcn_readlane(__float_as_int(v), 63));
}
__device__ __forceinline__ unsigned wave_max_u32(unsigned v) {
    v = max(v, DPPU(v, 0x111, 0xf)); v = max(v, DPPU(v, 0x112, 0xf)); v = max(v, DPPU(v, 0x114, 0xf)); v = max(v, DPPU(v, 0x118, 0xf)); v = max(v, DPPU(v, 0x142, 0xa)); v = max(v, DPPU(v, 0x143, 0xc));
    return (unsigned)__builtin_amdgcn_readlane((int)v, 63);
}
__device__ __forceinline__ float sigmoidf_(float x) { return __builtin_amdgcn_rcpf(1.0f + __builtin_amdgcn_exp2f(x * -1.4426950408889634f)); }

namespace pg8 {
constexpr int BM = 256, BK = 64, HALF = 128, HTB = HALF * BK * 2, STAGE_BYTES = 8 * HTB, NXCD = 8, WGM = 8;
__host__ __device__ __forceinline__ int lds_byte(int r, int c) { const int st = (r >> 4) * 2 + (c >> 5), rr = r & 15, cc = c & 31, ob = rr * 64 + cc * 2; return st * 1024 + (ob ^ (((ob >> 9) & 1) << 5)); }
__host__ __device__ __forceinline__ void stage_rc(int b, int& R, int& C) { const int st = b / 1024, sb = b % 1024, swz = sb ^ (((sb >> 9) & 1) << 5); R = (st >> 1) * 16 + swz / 64; C = (st & 1) * 32 + (swz % 64) / 2; }
__host__ __device__ __forceinline__ int perm32(int rho) { const int n = rho >> 4, i = rho & 15; return 8 * (i >> 2) + 4 * n + (i & 3); }

struct LaneRC { int R[2], C[2]; };
struct Unit { unsigned aoff[2][2]; const char* b0; const char* b1; int row0; int pn; int aux; int aux2; int aux3; int raw; };

__device__ __forceinline__ int xcd_remap(int L, int nwg) { const int q = nwg / NXCD, r = nwg % NXCD, xcd = L % NXCD, off = L / NXCD; return (xcd < r ? xcd * (q + 1) : r * (q + 1) + (xcd - r) * q) + off; }

struct DenseSched {
    int nM, nN, nwg, G, c, K; const char* Bt;
    __device__ __forceinline__ void init(int M, int N, int K_, const void* Bt_, int G_, int c_, int split_ = 0) { nM = M / BM; nN = N / BM; nwg = nM * nN; G = G_; c = c_; K = K_; Bt = (const char*)Bt_; split = (split_ && G_ == 256 && nwg == 896) ? 1 : 0; }
    int split;
    __device__ __forceinline__ bool next(int i, Unit& u, const LaneRC& rc) const {
        long L = (long)i * G + c;
        if (split) { if (i >= 3) { if (c < 128 || i >= 4) return false; L = 768 + (c - 128); } }
        if (L >= nwg) return false;
        const int wgid = xcd_remap((int)L, nwg);
        const int nig = WGM * nN, gid = wgid / nig, fm = gid * WGM, gsz = (nM - fm) < WGM ? (nM - fm) : WGM;
        const int pm = fm + ((wgid % nig) % gsz), pn = (wgid % nig) / gsz;
#pragma unroll
        for (int h = 0; h < 2; ++h)
#pragma unroll
            for (int i2 = 0; i2 < 2; ++i2) u.aoff[h][i2] = (unsigned)((pm * BM + h * HALF + rc.R[i2]) * K + rc.C[i2]) * 2u;
        u.b0 = Bt + (size_t)pn * BM * K * 2; u.b1 = u.b0 + (size_t)HALF * K * 2; u.row0 = pm * BM; u.pn = pn; u.aux = 0; u.aux2 = 0; u.aux3 = 0; u.raw = 0; return true;
    }
    __device__ __forceinline__ void finish(Unit&, const LaneRC&) const {}
    __device__ __forceinline__ bool unit_pm(int i, int& pm) const {
        long L = (long)i * G + c;
        if (split) { if (i >= 3) { if (c < 128 || i >= 4) return false; L = 768 + (c - 128); } }
        if (L >= nwg) return false;
        const int wgid = xcd_remap((int)L, nwg);
        const int nig = WGM * nN, gid = wgid / nig, fm = gid * WGM, gsz = (nM - fm) < WGM ? (nM - fm) : WGM;
        pm = fm + ((wgid % nig) % gsz); return true;
    }
};

typedef int i32x8 __attribute__((ext_vector_type(8))); typedef int i32x4 __attribute__((ext_vector_type(4)));
template <bool FP8> struct FragT;
template <> struct FragT<false> { struct type { bf16x8 k[2]; };
    static __device__ __forceinline__ void load(type& d, const LAS unsigned char* p) { d.k[0] = *(const LAS bf16x8*)p; d.k[1] = *(const LAS bf16x8*)(p + 1024); }
    static __device__ __forceinline__ f32x4 mma16(const type& b, const type& a, f32x4 c, int k) { return __builtin_amdgcn_mfma_f32_16x16x32_bf16(b.k[k], a.k[k], c, 0, 0, 0); }
    static __device__ __forceinline__ f32x4 mma8(const type&, const type&, f32x4 c, int, int) { return c; } };
template <> struct FragT<true> { typedef i32x8 type;
    static __device__ __forceinline__ void load(type& d, const LAS unsigned char* p) { const i32x4 lo = *(const LAS i32x4*)p, hi = *(const LAS i32x4*)(p + 1024); d = __builtin_shufflevector(lo, hi, 0, 1, 2, 3, 4, 5, 6, 7); }
    static __device__ __forceinline__ f32x4 mma16(const type&, const type&, f32x4 c, int) { return c; }
    static __device__ __forceinline__ f32x4 mma8(const type& b, const type& a, f32x4 c, int scw, int sca) { asm volatile("v_mfma_scale_f32_16x16x128_f8f6f4 %0, %1, %2, %0, %3, %4 op_sel_hi:[0,0,0]" : "+v"(c) : "v"(b), "v"(a), "v"(scw), "v"(sca)); return c; } };
template <class Epi, class Sched, bool ALIGN_EPI, bool FP8 = false, int SCW = 0x7f7f7f7f, int SCA = 0x7f7f7f7f>
__device__ __forceinline__ void gemm_phase(LAS unsigned char* lds, const char* gA, const int K, const Sched& S, const Epi& E) {
    int tid_ = threadIdx.x; asm volatile("" : "+v"(tid_));
    const int tid = tid_, wid = __builtin_amdgcn_readfirstlane(tid >> 6), lane = tid & 63, wr = wid >> 2, wc = wid & 3, fr = lane & 15, fq = lane >> 4;
    const int nt = K / BK;
    LaneRC rc; unsigned voffB[2];
#pragma unroll
    for (int i = 0; i < 2; ++i) { int R, C; stage_rc(tid * 16 + i * 8192, R, C); rc.R[i] = R; rc.C[i] = C; const int Rb = Epi::PERM ? ((R & ~31) + perm32(R & 31)) : R; voffB[i] = (unsigned)(Rb * K + C) * 2u; }
    const size_t kstep = (size_t)(BK * 2);
    const unsigned ldsw = (unsigned)wid * 1024u;
    const int aoff = lds_byte(wr * 64 + fr, fq * 8), boff = lds_byte(wc * 32 + fr, fq * 8);
#define PG8_SA(b, h) (((b) * 2 + (h)) * HTB)
#define PG8_SB(b, h) ((4 + (b) * 2 + (h)) * HTB)
#define PG8_STAGE(bufoff, gbase, voff) do { _Pragma("unroll") for (int _i = 0; _i < 2; ++_i) \
        __builtin_amdgcn_global_load_lds((const unsigned*)((const char*)(gbase) + (voff)[_i]), (LAS unsigned*)(lds + (bufoff) + ldsw + _i * 8192), 16, 0, 0); } while (0)
#define PG8_LDA(dst, b, h) do { _Pragma("unroll") for (int m = 0; m < 4; ++m) FragT<FP8>::load(dst[m], lds + PG8_SA(b, h) + aoff + m * 2048); } while (0)
#define PG8_LDB(dst, b, h) do { _Pragma("unroll") for (int n = 0; n < 2; ++n) FragT<FP8>::load(dst[n], lds + PG8_SB(b, h) + boff + n * 2048); } while (0)
#define PG8_MMA(ai, bj, At, Bt) do { __builtin_amdgcn_s_setprio(1); \
        if constexpr (FP8) { _Pragma("unroll") for (int m = 0; m < 4; ++m) _Pragma("unroll") for (int n = 0; n < 2; ++n) \
            acc[ai][bj][m][n] = FragT<FP8>::mma8(Bt[n], At[m], acc[ai][bj][m][n], SCW, SCA); } \
        else { _Pragma("unroll") for (int m = 0; m < 4; ++m) _Pragma("unroll") for (int n = 0; n < 2; ++n) _Pragma("unroll") for (int k = 0; k < 2; ++k) \
            acc[ai][bj][m][n] = FragT<FP8>::mma16(Bt[n], At[m], acc[ai][bj][m][n], k); } \
        __builtin_amdgcn_s_setprio(0); } while (0)
#define PG8_WAIT_V(n) asm volatile("s_waitcnt vmcnt(" #n ")" ::: "memory")
#define PG8_WAIT_L(n) asm volatile("s_waitcnt lgkmcnt(" #n ")" ::: "memory")
#define PG8_BAR __builtin_amdgcn_s_barrier()
#define PG8_SCHED __builtin_amdgcn_sched_barrier(0)
    Unit cur, nxt; int ui = 0;
    if (!S.next(0, cur, rc)) return;
    S.finish(cur, rc);
    f32x4 acc[2][2][4][2];
#pragma unroll
    for (int a = 0; a < 2; ++a)
#pragma unroll
        for (int b = 0; b < 2; ++b)
#pragma unroll
            for (int m = 0; m < 4; ++m)
#pragma unroll
                for (int n = 0; n < 2; ++n) acc[a][b][m][n] = (f32x4){0.f, 0.f, 0.f, 0.f};
    typedef typename FragT<FP8>::type frag_t;
    frag_t At[4], B0[2], B1[2];
    PG8_STAGE(PG8_SB(0, 0), cur.b0, voffB); PG8_STAGE(PG8_SB(0, 1), cur.b1, voffB); PG8_STAGE(PG8_SA(0, 0), gA, cur.aoff[0]); PG8_STAGE(PG8_SA(0, 1), gA, cur.aoff[1]);
    if (wr == 1) PG8_BAR;
    PG8_WAIT_V(2); PG8_BAR;
    PG8_STAGE(PG8_SB(1, 0), cur.b0 + kstep, voffB); PG8_STAGE(PG8_SA(1, 0), gA + kstep, cur.aoff[0]); PG8_STAGE(PG8_SB(1, 1), cur.b1 + kstep, voffB);
    PG8_WAIT_V(6); PG8_BAR;
    for (;;) {
        const bool has_next = S.next(ui + 1, nxt, rc);
        if (!has_next) nxt = cur;
#define PG8_TRIP(A1, A2, AO2, B2_0, B2_1) do { \
            const char* a1 = (A1); const char* a2 = (A2); const char* b2_0 = (B2_0); const char* b2_1 = (B2_1); const char* a3 = a2 + kstep; const char* b3_0 = b2_0 + kstep; const char* b3_1 = b2_1 + kstep; \
              \
            PG8_LDB(B0, 0, 0); PG8_LDB(B1, 0, 1); PG8_SCHED; PG8_LDA(At, 0, 0); PG8_STAGE(PG8_SA(1, 1), a1, cur.aoff[1]); \
            PG8_WAIT_V(8); PG8_WAIT_L(0); PG8_BAR; PG8_MMA(0, 0, At, B0); PG8_MMA(0, 1, At, B1); PG8_BAR; PG8_SCHED; \
              \
            PG8_LDA(At, 0, 1); PG8_STAGE(PG8_SB(0, 0), b2_0, voffB); PG8_STAGE(PG8_SB(0, 1), b2_1, voffB); PG8_STAGE(PG8_SA(0, 0), a2, (AO2)[0]); \
            PG8_WAIT_V(8); PG8_WAIT_L(0); PG8_BAR; PG8_MMA(1, 0, At, B0); PG8_MMA(1, 1, At, B1); PG8_BAR; PG8_SCHED; \
              \
            PG8_LDB(B0, 1, 0); PG8_LDB(B1, 1, 1); PG8_SCHED; PG8_LDA(At, 1, 0); PG8_STAGE(PG8_SA(0, 1), a2, (AO2)[1]); \
            PG8_WAIT_V(8); PG8_WAIT_L(0); PG8_BAR; PG8_MMA(0, 0, At, B0); PG8_MMA(0, 1, At, B1); PG8_BAR; PG8_SCHED; \
              \
            PG8_LDA(At, 1, 1); PG8_STAGE(PG8_SB(1, 0), b3_0, voffB); PG8_STAGE(PG8_SB(1, 1), b3_1, voffB); PG8_STAGE(PG8_SA(1, 0), a3, (AO2)[0]); \
            PG8_WAIT_V(8); PG8_WAIT_L(0); PG8_BAR; PG8_MMA(1, 0, At, B0); PG8_MMA(1, 1, At, B1); PG8_BAR; PG8_SCHED; } while (0)
#pragma unroll 1
        for (int t = 0; t < nt; t += 2) {
            const bool last = (t == nt - 2);
            unsigned ao2[2][2];
#pragma unroll
            for (int h = 0; h < 2; ++h)
#pragma unroll
                for (int i2 = 0; i2 < 2; ++i2) ao2[h][i2] = last ? nxt.aoff[h][i2] : cur.aoff[h][i2];
            PG8_TRIP(gA + (size_t)(t + 1) * kstep, last ? gA : gA + (size_t)(t + 2) * kstep, ao2, last ? nxt.b0 : cur.b0 + (size_t)(t + 2) * kstep, last ? nxt.b1 : cur.b1 + (size_t)(t + 2) * kstep);
        }
        if constexpr (ALIGN_EPI) { if (wr == 0) PG8_BAR; }
        if constexpr (FP8) asm volatile("s_nop 15\n\ts_nop 7" ::: "memory");
        E(acc, cur, wr, wc, fr, fq);
        if (!has_next) break;
#pragma unroll
        for (int a = 0; a < 2; ++a)
#pragma unroll
            for (int b = 0; b < 2; ++b)
#pragma unroll
                for (int m = 0; m < 4; ++m)
#pragma unroll
                    for (int n = 0; n < 2; ++n) acc[a][b][m][n] = (f32x4){0.f, 0.f, 0.f, 0.f};
        cur = nxt; ++ui;
        if constexpr (ALIGN_EPI) { if (wr == 1) PG8_BAR; }
    }
    PG8_WAIT_V(0);
    if constexpr (!ALIGN_EPI) { if (wr == 0) PG8_BAR; }
    PG8_BAR;
#undef PG8_SA
#undef PG8_SB
#undef PG8_STAGE
#undef PG8_LDA
#undef PG8_LDB
#undef PG8_MMA
#undef PG8_TRIP
#undef PG8_WAIT_V
#undef PG8_WAIT_L
#undef PG8_BAR
#undef PG8_SCHED
}
}

#define XB_TMO      128
#define XB_XCNT(j)  (256  + 64 * (j))
#define XB_XSUB(j)  (1280 + 64 * (j))
#define XB_XGEN(j)  (2304 + 64 * (j))
#define XB_TOP      3328
#define XB_TOPGEN   3392
#define XCD_BAR_WORDS 3456
#define XB_SPIN_CAP (1u << 18)
__device__ __forceinline__ unsigned xb_ld(unsigned* p)              { return __hip_atomic_load(p, __ATOMIC_RELAXED, __HIP_MEMORY_SCOPE_AGENT); }
__device__ __forceinline__ unsigned xb_add(unsigned* p, unsigned v) { return __hip_atomic_fetch_add(p, v, __ATOMIC_RELAXED, __HIP_MEMORY_SCOPE_AGENT); }
__device__ __forceinline__ unsigned xb_xcc_id() { return (unsigned)__builtin_amdgcn_s_getreg((3 << 11) | 20) & 0xFu; }
#define XB_SPIN(cond, bar) do { unsigned _sp = 0; while (cond) { __builtin_amdgcn_s_sleep(1); \
    if ((++_sp & 255u) == 0u) { if (xb_ld(&(bar)[XB_TMO])) break; if (_sp > XB_SPIN_CAP) { atomicAdd(&(bar)[XB_TMO], 1u); break; } } } } while (0)
struct XcdBarrier { unsigned* bar; unsigned x; volatile LAS unsigned* st; };
__device__ __forceinline__ XcdBarrier xcd_barrier_post(unsigned* bar, volatile LAS unsigned* st) {
    XcdBarrier b; b.bar = bar; b.x = xb_xcc_id(); b.st = st;
    if (threadIdx.x == 0) (void)xb_add(&bar[XB_XCNT(b.x)], 1u);
    return b;
}
__device__ __forceinline__ void xcd_barrier_complete(unsigned* bar, unsigned x, unsigned& nloc, unsigned& nx) {
    const unsigned G = gridDim.x * gridDim.y * gridDim.z;
    unsigned sum, cnt, mine, sp = 0u;
    for (;;) {
        sum = 0u; cnt = 0u; mine = 0u;
#pragma unroll
        for (unsigned j = 0; j < 16; ++j) { const unsigned c = xb_ld(&bar[XB_XCNT(j)]); sum += c; cnt += (c > 0u) ? 1u : 0u; mine = (j == x) ? c : mine; }
        if (sum == G) break;
        __builtin_amdgcn_s_sleep(1);
        if ((++sp & 255u) == 0u) { if (xb_ld(&bar[XB_TMO])) break; if (sp > XB_SPIN_CAP) { atomicAdd(&bar[XB_TMO], 1u); break; } }
    }
    nloc = mine > 0u ? mine : 1u; nx = cnt > 0u ? cnt : 1u;
}
__device__ __forceinline__ void xcd_barrier(const XcdBarrier& b) {
    asm volatile("s_waitcnt vmcnt(0)" ::: "memory");
    __syncthreads();
    if (threadIdx.x == 0) {
        unsigned* bar = b.bar;
        __builtin_amdgcn_s_waitcnt(0);
        unsigned nloc = b.st[0], nx = b.st[1];
        if (nloc == 0u) { xcd_barrier_complete(bar, b.x, nloc, nx); b.st[0] = nloc; b.st[1] = nx; }
        const unsigned old = xb_add(&bar[XB_XSUB(b.x)], 1u);
        const unsigned gen = old / nloc;
        if (old + 1u == (gen + 1u) * nloc) {
            __builtin_amdgcn_fence(__ATOMIC_RELEASE, "agent");
            asm volatile("s_waitcnt vmcnt(0)" ::: "memory");
            const unsigned og = xb_add(&bar[XB_TOP], 1u);
            const unsigned tg = og / nx;
            if (og + 1u == (tg + 1u) * nx) xb_add(&bar[XB_TOPGEN], 1u);
            else XB_SPIN(xb_ld(&bar[XB_TOPGEN]) == tg, bar);
            __builtin_amdgcn_fence(__ATOMIC_ACQUIRE, "agent");
            xb_add(&bar[XB_XGEN(b.x)], 1u);
            asm volatile("s_waitcnt vmcnt(0)" ::: "memory");
        } else {
            XB_SPIN(xb_ld(&bar[XB_XGEN(b.x)]) == gen, bar);
            __builtin_amdgcn_fence(__ATOMIC_ACQUIRE, "agent");
            asm volatile("s_waitcnt vmcnt(0)" ::: "memory");
        }
    }
    __syncthreads();
}

namespace attn_body {
using bf16=__hip_bfloat16;
using bf16x8=__attribute__((ext_vector_type(8)))short;
using s16x4=__attribute__((ext_vector_type(4)))short;
using f32x16=__attribute__((ext_vector_type(16)))float;
using u32x4=__attribute__((ext_vector_type(4)))unsigned;
using u32x2v=__attribute__((ext_vector_type(2)))unsigned;
constexpr float AO_PRESCALE=128.0f;
constexpr int BATCH=4,NHEAD=8,SEQ=4096,D=64,DM=NHEAD*D;
constexpr int NW=8,QBLK=32,QB=QBLK*NW,KVBLK=64,NQB=SEQ/QB;
constexpr int ATTN_PITCH=DM, ATTN_UNIT_ROWS=QB;
__device__ __forceinline__ int crow(int r,int hi){return (r&3)+8*(r>>2)+4*hi;}
#define SBAR() __builtin_amdgcn_sched_barrier(0)
__device__ __forceinline__ void amask(f32x16&p0,f32x16&p1,const u32x2v mk,int hi){
  const unsigned a=mk.x>>(2*hi), b=mk.y>>(2*hi); const unsigned NEGI=0xff800000u;
  #define AM1(r,src) { int m0_,m1_; asm("v_bfe_i32 %0, %1, %2, 1":"=v"(m0_):"v"(src),"n"((((r)&3)>>1)+4*((r)>>2))); asm("v_bfe_i32 %0, %1, %2, 1":"=v"(m1_):"v"(src),"n"((((r)&3)>>1)+4*((r)>>2)+16)); \
      float x0_=p0[r],x1_=p1[r]; asm("v_bfi_b32 %0, %1, %2, %3":"=v"(x0_):"v"(m0_),"v"(x0_),"s"(NEGI)); asm("v_bfi_b32 %0, %1, %2, %3":"=v"(x1_):"v"(m1_),"v"(x1_),"s"(NEGI)); p0[r]=x0_; p1[r]=x1_; }
  AM1(0,a) AM1(1,b) AM1(2,a) AM1(3,b) AM1(4,a) AM1(5,b) AM1(6,a) AM1(7,b) AM1(8,a) AM1(9,b) AM1(10,a) AM1(11,b) AM1(12,a) AM1(13,b) AM1(14,a) AM1(15,b)
  #undef AM1
}
__device__ __forceinline__ void abias(f32x16&p0,f32x16&p1,int jb,int qrel,int hi,const __attribute__((address_space(3))) float*lut){
  const int d00=qrel+128-64*jb-4*hi;
  #pragma unroll
  for(int r=0;r<16;++r){ const int d0=d00-((r&3)+8*(r>>2)); const unsigned i0=(unsigned)d0<127u?(unsigned)d0:127u; const unsigned i1=(unsigned)(d0-32)<127u?(unsigned)(d0-32):127u;
    p0[r]+=lut[i0]; p1[r]+=lut[i1]; }
}

constexpr int NSLOT=3, SLOTB=8192;
constexpr int LDS_K=0, LDS_V=NSLOT*SLOTB, LDS_WS=2*NSLOT*SLOTB, LDS_OST=LDS_WS+NW*64*4, LDS_MK=LDS_OST+NW*4096, LDS_BYTES=LDS_MK+NW*512;
constexpr float C2=0.125f*1.4426950408889634f;
__device__ __forceinline__ void glds16(const void*gsrc,unsigned lds_dst){unsigned keep;
  asm volatile("s_mov_b32 %0, m0\n\ts_mov_b32 m0, %2\n\ts_nop 0\n\tglobal_load_lds_dwordx4 %1, off\n\ts_mov_b32 m0, %0":"=&s"(keep):"v"(gsrc),"s"(lds_dst):"memory");}
__device__ __forceinline__ void glds4(const void*gsrc,unsigned lds_dst){unsigned keep;
  asm volatile("s_mov_b32 %0, m0\n\ts_mov_b32 m0, %2\n\ts_nop 0\n\tglobal_load_lds_dword %1, off\n\ts_mov_b32 m0, %0":"=&s"(keep):"v"(gsrc),"s"(lds_dst):"memory");}
__device__ __forceinline__ float max3f(float a,float b,float c){float r;asm("v_max3_f32 %0, %1, %2, %3":"=v"(r):"v"(a),"v"(b),"v"(c));return r;}
__device__ __forceinline__ float max2f(float a,float b){float r;asm("v_max_f32_e32 %0, %1, %2":"=v"(r):"v"(a),"v"(b));return r;}
__device__ __forceinline__ float fadd_s(float a,float b){float r;asm("v_add_f32_e32 %0, %1, %2":"=v"(r):"v"(a),"v"(b));return r;}
__device__ __forceinline__ float fsub_s(float a,float b){float r;asm("v_sub_f32_e32 %0, %1, %2":"=v"(r):"v"(a),"v"(b));return r;}
typedef float f32x2_t __attribute__((ext_vector_type(2))); typedef __bf16 bf16x2_t __attribute__((ext_vector_type(2)));
__device__ __forceinline__ unsigned cvtpk_s(float lo,float hi){f32x2_t v={lo,hi};bf16x2_t b=__builtin_convertvector(v,bf16x2_t);return __builtin_bit_cast(unsigned,b);}
#define WAIT_BAR(N) asm volatile("s_waitcnt vmcnt(" #N ") lgkmcnt(0)\n\ts_barrier":::"memory")

__device__ __forceinline__ void qkt(f32x16&p0,f32x16&p1,const char*Kslot,const bf16x8*qr,const f32x16&negm,int r32,int hi){
  const char*kb=Kslot+hi*1024+r32*16;
  #pragma unroll
  for(int d0=0;d0<4;++d0){
    const bf16x8 b0=*reinterpret_cast<const bf16x8*>(kb+d0*2048);
    const bf16x8 b1=*reinterpret_cast<const bf16x8*>(kb+d0*2048+512);
    if(d0==0){p0=__builtin_amdgcn_mfma_f32_32x32x16_bf16(b0,qr[0],negm,0,0,0);p1=__builtin_amdgcn_mfma_f32_32x32x16_bf16(b1,qr[0],negm,0,0,0);}
    else{p0=__builtin_amdgcn_mfma_f32_32x32x16_bf16(b0,qr[d0],p0,0,0,0);p1=__builtin_amdgcn_mfma_f32_32x32x16_bf16(b1,qr[d0],p1,0,0,0);}}
}
typedef __attribute__((address_space(3))) const char* lds_cptr;
typedef short v4i16_t __attribute__((ext_vector_type(4)));
__device__ __forceinline__ void kload8(bf16x8*kf,lds_cptr kp){
  kf[0]=*(const __attribute__((address_space(3))) bf16x8*)(kp);      kf[1]=*(const __attribute__((address_space(3))) bf16x8*)(kp+512);
  kf[2]=*(const __attribute__((address_space(3))) bf16x8*)(kp+2048); kf[3]=*(const __attribute__((address_space(3))) bf16x8*)(kp+2560);
  kf[4]=*(const __attribute__((address_space(3))) bf16x8*)(kp+4096); kf[5]=*(const __attribute__((address_space(3))) bf16x8*)(kp+4608);
  kf[6]=*(const __attribute__((address_space(3))) bf16x8*)(kp+6144); kf[7]=*(const __attribute__((address_space(3))) bf16x8*)(kp+6656);
}
__device__ __forceinline__ void kload2(bf16x8*kf,lds_cptr kp,int j){ kf[2*j]=*(const __attribute__((address_space(3))) bf16x8*)(kp+j*2048); kf[2*j+1]=*(const __attribute__((address_space(3))) bf16x8*)(kp+j*2048+512); }
__device__ __forceinline__ s16x4 vtr(lds_cptr p){ return __builtin_bit_cast(s16x4,__builtin_amdgcn_ds_read_tr16_b64_v4i16((__attribute__((address_space(3))) v4i16_t*)p)); }
__device__ __forceinline__ float rowmax(const f32x16&p0,const f32x16&p1){
  float a=max3f(p0[0],p0[1],p1[0]),b=max3f(p0[2],p0[3],p1[1]);a=max3f(a,p1[2],p1[3]);
  #pragma unroll
  for(int r=4;r<16;r+=4){a=max3f(a,p0[r],p0[r+1]);b=max3f(b,p0[r+2],p0[r+3]);a=max3f(a,p1[r],p1[r+1]);b=max3f(b,p1[r+2],p1[r+3]);}
  const float m=max2f(a,b);
  auto rr=__builtin_amdgcn_permlane32_swap(__float_as_uint(m),__float_as_uint(m),false,false);
  return max2f(__uint_as_float(rr[0]),__uint_as_float(rr[1]));
}
__device__ __forceinline__ void pv(f32x16*o,int vb,bf16x8 pa0,bf16x8 pa1,bf16x8 pa2,bf16x8 pa3){
  #pragma unroll
  for(int d0=0;d0<2;++d0){s16x4 lo[4],hi[4];
    #pragma unroll
    for(int ks=0;ks<4;++ks){
      asm volatile("ds_read_b64_tr_b16 %0,%1 offset:%c2":"=&v"(lo[ks]):"v"(vb),"i"(d0*4096+ks*1024):"memory");
      asm volatile("ds_read_b64_tr_b16 %0,%1 offset:%c2":"=&v"(hi[ks]):"v"(vb),"i"(d0*4096+ks*1024+512):"memory");}
    asm volatile("s_waitcnt lgkmcnt(0)":::"memory");SBAR();
    #define PK(k) (bf16x8){lo[k][0],lo[k][1],lo[k][2],lo[k][3],hi[k][0],hi[k][1],hi[k][2],hi[k][3]}
    o[d0]=__builtin_amdgcn_mfma_f32_32x32x16_bf16(pa0,PK(0),o[d0],0,0,0);
    o[d0]=__builtin_amdgcn_mfma_f32_32x32x16_bf16(pa1,PK(1),o[d0],0,0,0);
    o[d0]=__builtin_amdgcn_mfma_f32_32x32x16_bf16(pa2,PK(2),o[d0],0,0,0);
    o[d0]=__builtin_amdgcn_mfma_f32_32x32x16_bf16(pa3,PK(3),o[d0],0,0,0);
    #undef PK
  }
}

#ifndef ATTN_STORE16
#define ATTN_STORE16(p,v) (*(u32x4*)(p)=(v))
#endif
template<int THRL> __device__ __forceinline__ void attn_unit(int b,int h,int qb,const bf16*Q,const bf16*__restrict__ K,const bf16*__restrict__ V,bf16*O,const unsigned long long*MK,const __attribute__((address_space(3))) float*lut,char*shm){
  int tid_=threadIdx.x; asm volatile("":"+v"(tid_)); const int tid=tid_,lane=tid&63,r32=lane&31,hi=lane>>5; const int wid=__builtin_amdgcn_readfirstlane(tid>>6);
  const long rowbase=(long)b*SEQ; const int q0=qb*QB;
  const bf16*Qw=Q+(rowbase+q0+wid*QBLK)*DM+h*D;
  const bf16*Kh=K+rowbase*DM+h*D,*Vh=V+rowbase*DM+h*D;
  const unsigned lds0=(unsigned)(uintptr_t)shm;
  float*wsf=(float*)(shm+LDS_WS)+wid*64;
  const bf16*ksrc=Kh+(long)lane*DM+wid*8;
  const bf16*vsrc=Vh+(long)(16*(wid&3)+(lane>>2))*DM+(wid>>2)*32+(lane&3)*8;
  const unsigned kdst=lds0+LDS_K+wid*1024, vdst=lds0+LDS_V+wid*1024;
  #define DMA_K(t,slot) glds16(ksrc+(long)(t)*KVBLK*DM,(unsigned)__builtin_amdgcn_readfirstlane(kdst+(slot)))
  #define DMA_V(t,slot) glds16(vsrc+(long)(t)*KVBLK*DM,(unsigned)__builtin_amdgcn_readfirstlane(vdst+(slot)))
  const int vb0=(int)(lds0+LDS_V)+((lane>>4)&1)*32+(lane&3)*8+(4*hi+((lane&15)>>2))*64;
  const char*Kbase=shm+LDS_K; bf16x8 kf[8];
  const lds_cptr shm3=(lds_cptr)shm; const lds_cptr kp0=shm3+LDS_K+hi*1024+r32*16; const lds_cptr vp0=shm3+LDS_V+((lane>>4)&1)*32+(lane&3)*8+(4*hi+((lane&15)>>2))*64; const lds_cptr mkp=shm3+LDS_MK+wid*512+r32*4;
  const int NT=(q0+QB)/KVBLK;
  const char*msrc=(const char*)(MK+(rowbase+q0+wid*QBLK+r32)*(SEQ/64))+hi*4; const unsigned mdst=lds0+LDS_MK+wid*512;
  #define DMA_M(t) glds4(msrc+(long)(t)*8,(unsigned)__builtin_amdgcn_readfirstlane(mdst+(((t)&1)<<8)))
  DMA_M(0);DMA_M(1);
  DMA_K(0,0);DMA_V(0,0);DMA_K(1,SLOTB);
  bf16x8 qr[4];
  #pragma unroll
  for(int d0=0;d0<4;++d0)qr[d0]=*reinterpret_cast<const bf16x8*>(&Qw[(long)r32*DM+d0*16+hi*8]);
  float mhat=0.f,l_reg=0.f;f32x16 o[2];o[0]=f32x16{};o[1]=f32x16{};const f32x16 negm=f32x16{};
  const int qrel=wid*QBLK+r32;
  #define MREAD(t) (u32x2v){*(const __attribute__((address_space(3))) unsigned*)(mkp+(((t)&1)<<8)),*(const __attribute__((address_space(3))) unsigned*)(mkp+(((t)&1)<<8)+128)}
  #define CMASK(P0,P1,t,MC) do{int jb_=(t)-(NT-6); if(jb_>=0 && 32*wid+65-64*jb_<113 && 64*jb_-128<=32*wid+31)abias(P0,P1,jb_,qrel,hi,lut); const u32x2v mk_=MREAD(t); amask(P0,P1,mk_,hi);}while(0)
  bool resc=false;
  #define START(P0,P1) do{ const float rm=rowmax(P0,P1); resc=false; \
    { const float dl=__builtin_fmaxf(rm,-1000.f); mhat=fadd_s(mhat,dl); \
      _Pragma("unroll") for(int r=0;r<16;++r){P0[r]=fsub_s(P0[r],dl);P1[r]=fsub_s(P1[r],dl);} \
      } \
    _Pragma("unroll") for(int r=0;r<16;++r)P0[r]=__builtin_amdgcn_exp2f(P0[r]); }while(0)
  #define RESC() do{ if(resc){ asm volatile("s_waitcnt lgkmcnt(0)":::"memory"); \
      _Pragma("unroll") for(int d_=0;d_<2;++d_) _Pragma("unroll") for(int r=0;r<16;++r)o[d_][r]*=wsf[crow(r,hi)]; } }while(0)
  f32x16 pA0,pA1,pB0,pB1;
  int sl_prev=0,sl_cur=0,sl_next=SLOTB;
  #define ROT() do{sl_prev=sl_cur;sl_cur=sl_next;sl_next=(sl_next==(NSLOT-1)*SLOTB)?0:sl_next+SLOTB;}while(0)
  DMA_K(2,2*SLOTB);
  WAIT_BAR(3);
  qkt(pA0,pA1,Kbase,qr,negm,r32,hi);asm volatile("s_nop 15\n\ts_nop 7":"+v"(pA0),"+v"(pA1));CMASK(pA0,pA1,0,0);
  START(pA0,pA1);
  _Pragma("unroll") for(int r=0;r<16;++r)pA1[r]=__builtin_amdgcn_exp2f(pA1[r]);
  WAIT_BAR(0);
  DMA_K(3,0);DMA_V(1,SLOTB);
  ROT();
  kload8(kf,kp0+sl_cur);
  WAIT_BAR(2);
  s16x4 vlo[8],vhi[8]; u32x4 pw0,pw1,pw2,pw3;
  #define PKW(P,B) cvtpk_s(P[B],P[B+1])
  #define PAF(k) __builtin_bit_cast(bf16x8,pw##k)
  #define VFR(i) (bf16x8){vlo[i][0],vlo[i][1],vlo[i][2],vlo[i][3],vhi[i][0],vhi[i][1],vhi[i][2],vhi[i][3]}
  #define PIN(x) asm volatile("":"+v"(x))
  #define MX3(a,b,c) __builtin_fmaxf(__builtin_fmaxf((a),(b)),(c))
  #define GAPA(MF,A0,A1,A2,A3,W0,W1,PW) do{ MF; sacc+=A0; sacc+=A1; sacc+=A2; sacc+=A3; PIN(sacc); W0; W1; PIN(PW); SBAR(); }while(0)
  #define EX(v) __builtin_amdgcn_exp2f(v)
  #define GAPB(MF,X,B) do{ MF; X[B]=EX(X[B]); X[B+1]=EX(X[B+1]); X[B+2]=EX(X[B+2]); X[B+3]=EX(X[B+3]); PIN(X); SBAR(); }while(0)
  #define VRD(i) do{ vlo[i]=vtr(vp_+(((i)>>2)*4096+((i)&3)*1024)); vhi[i]=vtr(vp_+(((i)>>2)*4096+((i)&3)*1024+512)); }while(0)
  #define KRD(G,j) do{ if(G){ kload2(kf,kp0+sl_next,j); SBAR(); } }while(0)
  #define STEP(C0,C1,P0,P1,t,GK,GV,GL,MC,MN,GM) do{ SBAR(); if(GM){DMA_M((t)+1);} \
    const lds_cptr vp_=vp0+sl_prev; \
    VRD(0); SBAR(); float sacc=(P0[0]+P0[1]); \
    GAPA(C0=__builtin_amdgcn_mfma_f32_32x32x16_bf16(kf[0],qr[0],negm,0,0,0), P0[2],P0[3],P0[4],P0[5],     pw0[0]=PKW(P0,0), pw0[1]=PKW(P0,2), pw0); \
    VRD(4); SBAR(); GAPA(C1=__builtin_amdgcn_mfma_f32_32x32x16_bf16(kf[1],qr[0],negm,0,0,0), P0[6],P0[7],P0[8],P0[9],     pw0[2]=PKW(P0,4), pw0[3]=PKW(P0,6), pw0); \
    VRD(1); SBAR(); GAPA(C0=__builtin_amdgcn_mfma_f32_32x32x16_bf16(kf[2],qr[1],C0,0,0,0),   P0[10],P0[11],P0[12],P0[13], pw1[0]=PKW(P0,8), pw1[1]=PKW(P0,10), pw1); \
    VRD(5); SBAR(); GAPA(C1=__builtin_amdgcn_mfma_f32_32x32x16_bf16(kf[3],qr[1],C1,0,0,0),   P0[14],P0[15],P1[0],P1[1],   pw1[2]=PKW(P0,12),pw1[3]=PKW(P0,14), pw1); \
    VRD(2); SBAR(); GAPA(C0=__builtin_amdgcn_mfma_f32_32x32x16_bf16(kf[4],qr[2],C0,0,0,0),   P1[2],P1[3],P1[4],P1[5],     pw2[0]=PKW(P1,0), pw2[1]=PKW(P1,2), pw2); \
    VRD(6); SBAR(); GAPA(C1=__builtin_amdgcn_mfma_f32_32x32x16_bf16(kf[5],qr[2],C1,0,0,0),   P1[6],P1[7],P1[8],P1[9],     pw2[2]=PKW(P1,4), pw2[3]=PKW(P1,6), pw2); \
    VRD(3); SBAR(); GAPA(C0=__builtin_amdgcn_mfma_f32_32x32x16_bf16(kf[6],qr[3],C0,0,0,0),   P1[10],P1[11],P1[12],P1[13], pw3[0]=PKW(P1,8), pw3[1]=PKW(P1,10), pw3); \
    VRD(7); SBAR(); GAPA(C1=__builtin_amdgcn_mfma_f32_32x32x16_bf16(kf[7],qr[3],C1,0,0,0),   P1[14],P1[15],0.f,0.f,       pw3[2]=PKW(P1,12),pw3[3]=PKW(P1,14), pw3); \
    l_reg+=sacc; \
    if(GK){DMA_K((t)+3,sl_cur);} if(GV){DMA_V((t)+1,sl_next);} \
    _Pragma("unroll") for(int r=0;r<16;++r){C0[r]-=mhat;C1[r]-=mhat;} \
    CMASK(C0,C1,t,MC); \
    { float a=MX3(C0[0],C0[1],C1[0]),b=MX3(C0[2],C0[3],C1[1]); a=MX3(a,C1[2],C1[3]); \
      _Pragma("unroll") for(int r=4;r<16;r+=4){a=MX3(a,C0[r],C0[r+1]);b=MX3(b,C0[r+2],C0[r+3]);a=MX3(a,C1[r],C1[r+1]);b=MX3(b,C1[r+2],C1[r+3]);} \
      float rm=__builtin_fmaxf(a,b); { auto rr=__builtin_amdgcn_permlane32_swap(__float_as_uint(rm),__float_as_uint(rm),false,false); rm=__builtin_fmaxf(__uint_as_float(rr[0]),__uint_as_float(rr[1])); } \
      resc=false; \
      if(__builtin_expect(__any(rm>(float)THRL),0)){ const float dl=__builtin_fmaxf(rm,0.f); mhat+=dl; \
        _Pragma("unroll") for(int r=0;r<16;++r){C0[r]-=dl;C1[r]-=dl;} \
        const float f=__builtin_amdgcn_exp2f(-dl); l_reg*=f; if(hi==0)wsf[r32]=f; resc=true; } } \
    SBAR(); \
    GAPB(o[0]=__builtin_amdgcn_mfma_f32_32x32x16_bf16(PAF(0),VFR(0),o[0],0,0,0), C0,0); \
    GAPB(o[1]=__builtin_amdgcn_mfma_f32_32x32x16_bf16(PAF(0),VFR(4),o[1],0,0,0), C0,4); \
    KRD(GL,0); GAPB(o[0]=__builtin_amdgcn_mfma_f32_32x32x16_bf16(PAF(1),VFR(1),o[0],0,0,0), C0,8); \
    KRD(GL,1); GAPB(o[1]=__builtin_amdgcn_mfma_f32_32x32x16_bf16(PAF(1),VFR(5),o[1],0,0,0), C0,12); \
    KRD(GL,2); GAPB(o[0]=__builtin_amdgcn_mfma_f32_32x32x16_bf16(PAF(2),VFR(2),o[0],0,0,0), C1,0); \
    KRD(GL,3); GAPB(o[1]=__builtin_amdgcn_mfma_f32_32x32x16_bf16(PAF(2),VFR(6),o[1],0,0,0), C1,4); \
    GAPB(o[0]=__builtin_amdgcn_mfma_f32_32x32x16_bf16(PAF(3),VFR(3),o[0],0,0,0), C1,8); \
    GAPB(o[1]=__builtin_amdgcn_mfma_f32_32x32x16_bf16(PAF(3),VFR(7),o[1],0,0,0), C1,12); \
    }while(0)
  int t=1;
  #undef CMASK
  #define CMASK(P0,P1,t,MC) do{ const u32x2v mk_=MREAD(t); amask(P0,P1,mk_,hi);}while(0)
  for(;t+7<NT;t+=2){
    STEP(pB0,pB1,pA0,pA1,t,true,true,true,0,0,true);     WAIT_BAR(2); RESC(); ROT();
    STEP(pA0,pA1,pB0,pB1,t+1,true,true,true,0,0,true);   WAIT_BAR(2); RESC(); ROT();
  }
  #undef CMASK
  #define CMASK(P0,P1,t,MC) do{int jb_=(t)-(NT-6); if(jb_>=0 && 32*wid+65-64*jb_<113 && 64*jb_-128<=32*wid+31)abias(P0,P1,jb_,qrel,hi,lut); const u32x2v mk_=MREAD(t); amask(P0,P1,mk_,hi);}while(0)
  #define ENDW(tt,M) do{ if((tt)+3<NT){WAIT_BAR(2);} else if((tt)+2<NT){WAIT_BAR(1);} else {WAIT_BAR(0);} }while(0)
  for(;t+1<NT;t+=2){
    STEP(pB0,pB1,pA0,pA1,t,(t+3<NT),(t+1<NT),(t+1<NT),0,0,(t+1<NT));       ENDW(t,0);   RESC(); ROT();
    STEP(pA0,pA1,pB0,pB1,t+1,(t+4<NT),(t+2<NT),(t+2<NT),0,0,(t+2<NT));     ENDW(t+1,0); RESC(); ROT();
  }
  STEP(pB0,pB1,pA0,pA1,NT-1,false,false,false,0,0,false); RESC();
  { float sacc=pB0[0]+pB0[1]; _Pragma("unroll") for(int r=2;r<16;++r)sacc+=pB0[r]; _Pragma("unroll") for(int r=0;r<16;++r)sacc+=pB1[r]; l_reg+=sacc;
    pw0=(u32x4){PKW(pB0,0),PKW(pB0,2),PKW(pB0,4),PKW(pB0,6)};pw1=(u32x4){PKW(pB0,8),PKW(pB0,10),PKW(pB0,12),PKW(pB0,14)};pw2=(u32x4){PKW(pB1,0),PKW(pB1,2),PKW(pB1,4),PKW(pB1,6)};pw3=(u32x4){PKW(pB1,8),PKW(pB1,10),PKW(pB1,12),PKW(pB1,14)};
    SBAR(); pv(o,vb0+sl_cur,PAF(0),PAF(1),PAF(2),PAF(3)); }
  #undef PKW
  #undef PAF
  #undef VFR
  #undef PIN
  #undef MX3
  #undef GAPA
  #undef GAPB
  #undef EX
  #undef VRD
  #undef KRD
  #undef STEP
  #undef ENDW
  {auto rr=__builtin_amdgcn_permlane32_swap(__float_as_uint(l_reg),__float_as_uint(l_reg),false,false);l_reg=__uint_as_float(rr[0])+__uint_as_float(rr[1]);}
  if(hi==0)wsf[32+r32]=l_reg;asm volatile("s_waitcnt lgkmcnt(0)":::"memory");
  float rli[16];
  #pragma unroll
  for(int r=0;r<16;++r)rli[r]=__builtin_amdgcn_rcpf(wsf[32+crow(r,hi)]);
  unsigned char*Ow=(unsigned char*)O+(rowbase+q0+wid*QBLK)*(long)DM+h*D;
  { unsigned char*stg=(unsigned char*)(shm+LDS_OST)+wid*4096;
    #pragma unroll
    for(int r=0;r<16;++r){const int orow=crow(r,hi); const float sc=rli[r]*AO_PRESCALE;
      #pragma unroll
      for(int d0=0;d0<2;++d0){const float x=__builtin_amdgcn_fmed3f(o[d0][r]*sc,-448.f,448.f); stg[orow*64+d0*32+r32]=(unsigned char)(__builtin_amdgcn_cvt_pk_fp8_f32(x,x,0,false)&0xff);}}
    asm volatile("s_waitcnt lgkmcnt(0)":::"memory");
    #pragma unroll
    for(int i=0;i<2;++i){const int row=i*16+(lane>>2),ch=lane&3; const u32x4 v=*(const u32x4*)(stg+row*64+ch*16); ATTN_STORE16(Ow+(long)row*DM+ch*16,v);} }
  asm volatile("s_waitcnt lgkmcnt(0)\n\ts_barrier":::"memory");
  #undef DMA_K
  #undef DMA_V
  #undef DMA_M
  #undef MREAD
  #undef CMASK
  #undef START
  #undef RESC
  #undef ROT
}
constexpr int ATTN_LDS_BYTES=LDS_BYTES;
struct AttnTensors { const bf16* Q; const bf16* K; const bf16* V; bf16* O; const unsigned long long* MK; };
struct AttnUnit { int bh; int qb; };
struct StaticOrder {
  int vcu;
  __device__ __forceinline__ explicit StaticOrder(int grid,int block):vcu((block%8)*(grid/8)+block/8){}
  __device__ __forceinline__ bool next(int i,AttnUnit&u)const{ if(i>=2)return false; const int s=vcu&7; u.bh=vcu>>3; u.qb=(i==0)?s:15-s; return true; }
  __device__ __forceinline__ void a_ready(const AttnUnit&)const{}
  __device__ __forceinline__ void done(const AttnUnit&)const{}
};
template<class Sched,int THRL=8> __device__ __forceinline__ void attn_phase(char*lds,const AttnTensors&T,const __attribute__((address_space(3))) float*lut8,const Sched&S){
  AttnUnit u;
  for(int i=0;S.next(i,u);++i){ S.a_ready(u); attn_unit<THRL>(u.bh/NHEAD,u.bh%NHEAD,u.qb,T.Q,T.K,T.V,T.O,T.MK,lut8+(u.bh%NHEAD)*128,lds); S.done(u); }
}
#undef SBAR
#undef WAIT_BAR
}

struct Args { const float* in[17]; float* out; unsigned char* ws; };
enum { IN_X = 0, IN_MIXN, IN_WIN, IN_POOLW, IN_POOLS, IN_WBP, IN_WBA, IN_RELB, IN_WOUT, IN_FFNN, IN_WR, IN_BR, IN_W1, IN_B1, IN_W2, IN_B2, IN_FINN, IN_OUT = 17 };
struct Frame {
    LAS unsigned char* lds;
    unsigned char* ws;
    int tid, lane, wave, G, gw, ngw;
    __device__ __forceinline__ const float* in(int i) const {
        auto kp = __builtin_amdgcn_kernarg_segment_ptr(); u64 p;
        asm volatile("s_load_dwordx2 %0, %1, %2\n\ts_waitcnt lgkmcnt(0)" : "=s"(p) : "s"(kp), "s"(i * 8) : "memory");
        return (const float*)(const GAS float*)p; }
    __device__ __forceinline__ float* outp() const { return (float*)in(IN_OUT); }
    template <class T> __device__ __forceinline__ T* w(size_t off) const { return (T*)(ws + off); }
    __device__ __forceinline__ unsigned* ctl() const { return (unsigned*)(ws + WS_CTL); }
};

__device__ __forceinline__ void refresh(Frame& F) { int t = threadIdx.x; asm volatile("" : "+v"(t)); F.tid = t; F.lane = t & 63; }

__device__ __forceinline__ void panel_signal(Frame& F, int cw) {
    asm volatile("s_waitcnt vmcnt(0)" ::: "memory");
    __syncthreads();
    if (threadIdx.x == 0) { pg8::DenseSched s; s.init(NTOK, 1024, 0, nullptr, (int)gridDim.x, (int)blockIdx.x); for (int i = 0;; ++i) { int pm; if (!s.unit_pm(i, pm)) break; (void)xb_add(F.ctl() + cw + 32 * pm, 1u); } }
}
__device__ __forceinline__ void panel_poll(Frame& F, int cw, int pm, unsigned need) { unsigned* bar = F.ctl() + CW_BAR; unsigned* p = F.ctl() + cw + 32 * pm; XB_SPIN(xb_ld(p) < need, bar); }
__device__ __forceinline__ void panel_wait(Frame& F, int cw, unsigned need) {
    if (threadIdx.x == 0) { pg8::DenseSched s; s.init(NTOK, 1024, 0, nullptr, (int)gridDim.x, (int)blockIdx.x); for (int i = 0;; ++i) { int pm; if (!s.unit_pm(i, pm)) break; panel_poll(F, cw, pm, need); }
        __builtin_amdgcn_fence(__ATOMIC_ACQUIRE, "agent"); asm volatile("s_waitcnt vmcnt(0)" ::: "memory"); }
    __syncthreads();
}

template <bool INDEXER> struct EpiInProj {
    static constexpr bool PERM = true;
    bf16 *zpool, *q, *k, *v, *qi, *ki, *gate; float* wi;
    __device__ __forceinline__ void operator()(const f32x4 (&acc)[2][2][4][2], const pg8::Unit& u, int wr, int wc, int fr, int fq) const {
        const int pn = u.pn, row0 = u.row0 + wr * 64 + fr;
        if (INDEXER && pn == 1) {
#pragma unroll
            for (int ai = 0; ai < 2; ++ai)
#pragma unroll
                for (int m = 0; m < 4; ++m) { const int row = row0 + ai * 128 + m * 16;
                    const f32x4 v0 = acc[ai][0][m][0], v1 = acc[ai][0][m][1];
                    if (wc < 2) { u32x4 w; w.x = cvt_pk_bf16(v0[0], v0[1]); w.y = cvt_pk_bf16(v0[2], v0[3]); w.z = cvt_pk_bf16(v1[0], v1[1]); w.w = cvt_pk_bf16(v1[2], v1[3]);
                        *(u32x4*)(ki + (size_t)row * 64 + wc * 32 + 8 * fq) = w; }
                    else if (wc == 2 && fq == 0) { *(f32x4*)(wi + (size_t)row * 4) = v0; } }
            return;
        }
        bf16* base; int ldc, colt, mode = 0; float sc = 1.f;
        if (INDEXER) { if (pn == 0) { base = qi; ldc = 256; colt = 0; } else { base = zpool; ldc = 512; colt = (pn - 2) * 256; } }
        else if (pn < 2) { base = q; ldc = 512; colt = pn * 256; sc = QSCALE; }
        else if (pn < 4) { base = k; ldc = 512; colt = (pn - 2) * 256; }
        else if (pn < 6) { base = v; ldc = 512; colt = (pn - 4) * 256; }
        else { base = gate; ldc = 2048; colt = (pn - 6) * 256; mode = 1; }
        const int col0 = colt + wc * 32 + 8 * fq;
#pragma unroll
        for (int ai = 0; ai < 2; ++ai)
#pragma unroll
            for (int m = 0; m < 4; ++m) { bf16* rowp = base + (size_t)(row0 + ai * 128 + m * 16) * ldc + col0;
#pragma unroll
                for (int bj = 0; bj < 2; ++bj) { f32x4 v0 = acc[ai][bj][m][0], v1 = acc[ai][bj][m][1];
                    if (mode == 1) {
#pragma unroll
                        for (int j = 0; j < 4; ++j) { v0[j] = sigmoidf_(v0[j]); v1[j] = sigmoidf_(v1[j]); } }
                    else { v0 = v0 * sc; v1 = v1 * sc; }
                    u32x4 w; w.x = cvt_pk_bf16(v0[0], v0[1]); w.y = cvt_pk_bf16(v0[2], v0[3]); w.z = cvt_pk_bf16(v1[0], v1[1]); w.w = cvt_pk_bf16(v1[2], v1[3]);
                    *(u32x4*)(rowp + bj * 128) = w; } }
    }
};
__device__ __forceinline__ void store16_wt(const void* base, unsigned byteoff, u32x4 v) { asm volatile("global_store_dwordx4 %0, %1, %2 sc0 sc1" :: "v"(byteoff), "v"(v), "s"((GAS const void*)base) : "memory"); }
template <bool ADD> struct EpiGate {
    static constexpr bool PERM = true;
    bf16* merged; const bf16* gate; int goff;
    __device__ __forceinline__ void operator()(const f32x4 (&acc)[2][2][4][2], const pg8::Unit& u, int wr, int wc, int fr, int fq) const {
        const int row0 = u.row0 + wr * 64 + fr, col0 = u.pn * 256 + wc * 32 + 8 * fq;
#pragma unroll
        for (int ai = 0; ai < 2; ++ai)
#pragma unroll
            for (int m = 0; m < 4; ++m) { const size_t row = (size_t)(row0 + ai * 128 + m * 16);
#pragma unroll
                for (int bj = 0; bj < 2; ++bj) { const int col = col0 + bj * 128;
                    const u32x4 g = *(const u32x4*)(gate + row * 2048 + goff + col);
                    f32x4 v0 = acc[ai][bj][m][0], v1 = acc[ai][bj][m][1];
                    v0[0] *= bflo(g.x); v0[1] *= bfhi(g.x); v0[2] *= bflo(g.y); v0[3] *= bfhi(g.y); v1[0] *= bflo(g.z); v1[1] *= bfhi(g.z); v1[2] *= bflo(g.w); v1[3] *= bfhi(g.w);
                    if (ADD) { const u32x4 p = *(const u32x4*)(merged + row * 1024 + col);
                        v0[0] += bflo(p.x); v0[1] += bfhi(p.x); v0[2] += bflo(p.y); v0[3] += bfhi(p.y); v1[0] += bflo(p.z); v1[1] += bfhi(p.z); v1[2] += bflo(p.w); v1[3] += bfhi(p.w); }
                    u32x4 w; w.x = cvt_pk_bf16(v0[0], v0[1]); w.y = cvt_pk_bf16(v0[2], v0[3]); w.z = cvt_pk_bf16(v1[0], v1[1]); w.w = cvt_pk_bf16(v1[2], v1[3]);
                    if (ADD) store16_wt((const char*)merged + ((size_t)(ai * 128 + m * 16) * 1024 + bj * 128) * 2, (unsigned)(row0 * 1024 + col0) * 2u, w);
                    else *(u32x4*)(merged + row * 1024 + col) = w; } }
    }
};
struct EpiResidual {
    static constexpr bool PERM = true;
    const float* x; bf16* x1;
    __device__ __forceinline__ void operator()(const f32x4 (&acc)[2][2][4][2], const pg8::Unit& u, int wr, int wc, int fr, int fq) const {
        const int row0 = u.row0 + wr * 64 + fr, col0 = u.pn * 256 + wc * 32 + 8 * fq;
#pragma unroll
        for (int ai = 0; ai < 2; ++ai)
#pragma unroll
            for (int m = 0; m < 4; ++m) { const size_t off = (size_t)(row0 + ai * 128 + m * 16) * D + col0;
#pragma unroll
                for (int bj = 0; bj < 2; ++bj) { const f32x4 b0 = *(const f32x4*)(x + off + bj * 128), b1 = *(const f32x4*)(x + off + bj * 128 + 4);
                    const f32x4 v0 = b0 + acc[ai][bj][m][0], v1 = b1 + acc[ai][bj][m][1];
                    u32x4 w; w.x = cvt_pk_bf16(v0[0], v0[1]); w.y = cvt_pk_bf16(v0[2], v0[3]); w.z = cvt_pk_bf16(v1[0], v1[1]); w.w = cvt_pk_bf16(v1[2], v1[3]);
                    store16_wt((const char*)x1 + ((size_t)(ai * 128 + m * 16) * D + bj * 128) * 2, (unsigned)(row0 * D + col0) * 2u, w); } }
    }
};
__device__ __forceinline__ float clamp448(float x) { return __builtin_amdgcn_fmed3f(x, -448.0f, 448.0f); }
__device__ __forceinline__ unsigned pk4_fp8(float a, float b, float c, float d) { int w = 0; w = __builtin_amdgcn_cvt_pk_fp8_f32(a, b, w, false); w = __builtin_amdgcn_cvt_pk_fp8_f32(c, d, w, true); return (unsigned)w; }
constexpr float ACT_PRESCALE = 4.0f, H_PRESCALE = 8.0f, W_PRESCALE = 128.0f, YS_PRESCALE = 64.0f;
struct EpiSwiGLU {
    static constexpr bool PERM = true;
    unsigned char* act; const LAS float* bias;
    __device__ __forceinline__ void operator()(const f32x4 (&acc)[2][2][4][2], const pg8::Unit& u, int wr, int wc, int fr, int fq) const {
        const int row0 = u.row0 + wr * 64 + fr, colr = u.pn * 128 + wc * 32 + 8 * fq;
        const LAS float* bg = bias + u.raw * 256 + wc * 32 + 8 * fq; const LAS float* bu = bg + 128;
        const f32x4 bg0 = *(const LAS f32x4*)bg, bg1 = *(const LAS f32x4*)(bg + 4), bu0 = *(const LAS f32x4*)bu, bu1 = *(const LAS f32x4*)(bu + 4);
#pragma unroll
        for (int ai = 0; ai < 2; ++ai)
#pragma unroll
            for (int m = 0; m < 4; ++m) { const size_t row = (size_t)(row0 + ai * 128 + m * 16);
                f32x4 g0 = acc[ai][0][m][0] + bg0, g1 = acc[ai][0][m][1] + bg1, u0 = acc[ai][1][m][0] + bu0, u1 = acc[ai][1][m][1] + bu1, r0, r1;
#pragma unroll
                for (int j = 0; j < 4; ++j) {
                    { const float g = fminf(g0[j], 7.0f), uu = fminf(fmaxf(u0[j], -7.0f), 7.0f); r0[j] = g * sigmoidf_(1.702f * g) * (uu + 1.0f) * ACT_PRESCALE; }
                    { const float g = fminf(g1[j], 7.0f), uu = fminf(fmaxf(u1[j], -7.0f), 7.0f); r1[j] = g * sigmoidf_(1.702f * g) * (uu + 1.0f) * ACT_PRESCALE; } }
                u32x2 w; w.x = pk4_fp8(r0[0], r0[1], r0[2], r0[3]); w.y = pk4_fp8(r1[0], r1[1], r1[2], r1[3]);
                *(u32x2*)(act + row * 1024 + colr) = w; }
    }
};
struct EpiMoeOut {
    static constexpr bool PERM = true;
    unsigned char* ys; const LAS float* bias; const LAS int* rows;
    __device__ __forceinline__ void operator()(const f32x4 (&acc)[2][2][4][2], const pg8::Unit& u, int wr, int wc, int fr, int fq) const {
        const int nvalid = u.aux2, slot = u.raw;
        const int col0 = u.pn * 256 + wc * 32 + 8 * fq;
#pragma unroll
        for (int bj = 0; bj < 2; ++bj) {
            const f32x4 bv0 = *(const LAS f32x4*)(bias + slot * 256 + wc * 32 + 8 * fq + bj * 128), bv1 = *(const LAS f32x4*)(bias + slot * 256 + wc * 32 + 8 * fq + bj * 128 + 4);
#pragma unroll
            for (int ai = 0; ai < 2; ++ai)
#pragma unroll
                for (int m = 0; m < 4; ++m) { const int r = ai * 128 + wr * 64 + m * 16 + fr;
                    if (r < nvalid) { const int ts = rows[(slot * 256 + r) * 2]; const float gt = __int_as_float(rows[(slot * 256 + r) * 2 + 1]) * YS_PRESCALE; unsigned char* rowp = ys + (size_t)ts * 1024 + col0;
                        const f32x4 v0 = (acc[ai][bj][m][0] + bv0) * gt, v1 = (acc[ai][bj][m][1] + bv1) * gt;
                        u32x2 w; w.x = pk4_fp8(clamp448(v0[0]), clamp448(v0[1]), clamp448(v0[2]), clamp448(v0[3])); w.y = pk4_fp8(clamp448(v1[0]), clamp448(v1[1]), clamp448(v1[2]), clamp448(v1[3]));
                        *(u32x2*)(rowp + bj * 128) = w; } }
            asm volatile("" ::: "memory");
        }
    }
};

struct MoeSched1 {
    const LAS int* tab; const LAS int* gath; const char* W1T; int G, c;
    __device__ __forceinline__ bool next(int i, pg8::Unit& u, const pg8::LaneRC& rc) const {
        const int T = tab[64], nwg = T * 8; const long L = (long)i * G + c; if (L >= nwg) return false;
        const int wgid = pg8::xcd_remap((int)L, nwg), mt = wgid >> 3, pn = wgid & 7;
        const int te = tab[128 + mt], e = te >> 16, lt = te & 0xffff, cnt = tab[e], pos0 = lt * 256;
#pragma unroll
        for (int h = 0; h < 2; ++h)
#pragma unroll
            for (int i2 = 0; i2 < 2; ++i2) u.aoff[h][i2] = (unsigned)(gath[i * 256 + h * 128 + rc.R[i2]] * 512 + rc.C[i2]) * 2u;
        u.b0 = W1T + ((size_t)e * 2048 + (size_t)pn * 128) * 1024; u.b1 = u.b0 + (size_t)1024 * 1024;
        u.row0 = tab[32 + e] + pos0; u.pn = pn; u.aux = e; u.aux2 = (cnt - pos0 < 256) ? (cnt - pos0) : 256; u.aux3 = pos0; u.raw = i; return true;
    }
    __device__ __forceinline__ void finish(pg8::Unit&, const pg8::LaneRC&) const {}
};
__device__ __forceinline__ void moe_gather_fill(Frame& F, const int* list, const float* b1) {
    const LAS int* tab = (const LAS int*)(F.lds + TAB_OFF); LAS int* gath = (LAS int*)(F.lds + TAB_OFF + 4096); LAS float* bias = (LAS float*)(F.lds + BIAS_OFF);
    const int T = tab[64], nwg = T * 8;
    for (int q = F.tid; q < 9 * 256; q += 512) { const int i = q >> 8, r = q & 255; const long L = (long)i * F.G + (int)blockIdx.x; int tok = 0; float bv = 0.f;
        if (L < nwg) { const int wgid = pg8::xcd_remap((int)L, nwg), mt = wgid >> 3, pn = wgid & 7; const int te = tab[128 + mt], e = te >> 16, lt = te & 0xffff, cnt = tab[e], pos = lt * 256 + r;
            if (pos < cnt) tok = list[(size_t)e * NTOK + pos] >> 2;
            bv = b1[(size_t)e * 2048 + (r < 128 ? 0 : 1024) + pn * 128 + (r & 127)]; }
        gath[q] = tok; bias[q] = bv; }
    __syncthreads();
}
struct MoeSched2 {
    const LAS int* tab; const char* W2T; int G, c;
    __device__ __forceinline__ bool next(int i, pg8::Unit& u, const pg8::LaneRC& rc) const {
        const int T = tab[64], nwg = T * 4; const long L = (long)i * G + c; if (L >= nwg) return false;
        const int wgid = pg8::xcd_remap((int)L, nwg), mt = wgid >> 2, pn = wgid & 3;
        const int te = tab[128 + mt], e = te >> 16, lt = te & 0xffff, cnt = tab[e], pos0 = lt * 256, row0 = tab[32 + e] + pos0;
#pragma unroll
        for (int h = 0; h < 2; ++h)
#pragma unroll
            for (int i2 = 0; i2 < 2; ++i2) u.aoff[h][i2] = (unsigned)((row0 + h * 128 + rc.R[i2]) * 512 + rc.C[i2]) * 2u;
        u.b0 = W2T + ((size_t)e * 1024 + (size_t)pn * 256) * 1024; u.b1 = u.b0 + (size_t)128 * 1024;
        u.row0 = row0; u.pn = pn; u.aux = e; u.aux2 = (cnt - pos0 < 256) ? (cnt - pos0) : 256; u.aux3 = pos0; u.raw = i; return true;
    }
    __device__ __forceinline__ void finish(pg8::Unit&, const pg8::LaneRC&) const {}
};

struct TItem { const float* src; unsigned char* dst; size_t rowpitch; int ldw, k0, col0, nvalid, row0, kbyte0, fp8; };
__device__ __forceinline__ TItem p0_item(int it, const float* w_in, const float* w_ba, const float* w_out, const float* w1, const float* w2, unsigned char* ws) {
    TItem t; constexpr int I_INI = 16 * 4, I_BA = 4 * 4, I_OUT = 16 * 4, I_IN8 = 8 * 14, I_W1 = 32 * 8 * 8;
    int r = it; t.fp8 = 0; t.nvalid = 256;
    if (r < I_INI) { const int kb = r >> 2, nb = r & 3; t.src = w_in; t.dst = ws + WS_WINI; t.ldw = DIN; t.rowpitch = 2048; t.k0 = kb * 64; t.kbyte0 = kb * 128; t.row0 = nb * 256;
        if (nb == 0) { t.col0 = 2048; } else if (nb == 1) { t.col0 = 2304; t.nvalid = 68; } else { t.col0 = (nb - 2) * 256; } return t; } r -= I_INI;
    if (r < I_OUT) { const int kb = r / 4, nb = r % 4; t.src = w_out; t.dst = ws + WS_WOUT; t.ldw = 1024; t.rowpitch = 2048; t.k0 = kb * 64; t.kbyte0 = kb * 128; t.col0 = nb * 256; t.row0 = nb * 256; return t; } r -= I_OUT;
    t.fp8 = 1; t.rowpitch = 1024;
    if (r < I_IN8) { const int kb = r / 14, nb = r % 14; t.src = w_in; t.dst = ws + WS_WIN; t.ldw = DIN; t.k0 = kb * 128; t.kbyte0 = kb * 128; t.row0 = nb * 256;
        t.col0 = (nb < 6) ? 512 + nb * 256 : 2372 + (nb - 6) * 256; return t; } r -= I_IN8;
    if (r < I_BA) { const int kb = r / 4, nb = r % 4; t.src = w_ba; t.dst = ws + WS_WBA; t.ldw = 1024; t.rowpitch = 512; t.k0 = kb * 128; t.kbyte0 = kb * 128; t.col0 = nb * 256; t.row0 = nb * 256; return t; } r -= I_BA;
    if (r < I_W1) { const int e = r >> 6, q = r & 63, kb = q >> 3, nb = q & 7; t.src = w1 + (size_t)e * 1024 * 2048; t.dst = ws + WS_W1 + (size_t)e * 2048 * 1024; t.ldw = 2048; t.k0 = kb * 128; t.kbyte0 = kb * 128; t.col0 = nb * 256; t.row0 = nb * 256; return t; } r -= I_W1;
    { const int e = r >> 5, q = r & 31, kb = q >> 2, nb = q & 3; t.src = w2 + (size_t)e * 1024 * 1024; t.dst = ws + WS_W2 + (size_t)e * 1024 * 1024; t.ldw = 1024; t.k0 = kb * 128; t.kbyte0 = kb * 128; t.col0 = nb * 256; t.row0 = nb * 256; return t; }
}
template <bool ONLY8> __device__ __forceinline__ void p0_load(const TItem& t, int wave, int lane, float (&v)[16][4]) {
    const int rpw = (ONLY8 || t.fp8) ? 16 : 8;
#pragma unroll
    for (int r = 0; r < 16; ++r) if (r < rpw) { const float* row = t.src + (size_t)(t.k0 + wave * rpw + r) * t.ldw + t.col0;
#pragma unroll
        for (int j = 0; j < 4; ++j) { const int n = lane + 64 * j; v[r][j] = (n < t.nvalid) ? __builtin_nontemporal_load(row + n) : 0.f; } }
}
constexpr int IT_W1_BEG = 256, IT_W1_END = 256 + 2048, IT_END = IT_W1_END + 1024, NW1T = 512, NW2T = 512, TAIL_PER = 12;
constexpr int MINI_W1_ITEMS = 2048 - NW1T, MINI_ITEMS = MINI_W1_ITEMS + (1024 - NW2T);
template <bool ONLY8> __device__ __forceinline__ void p0_copy(Frame& F, int j, const int j_end, const int stride, const int skip_at, const int skip_n) {
    refresh(F);
    const float* w_in = F.in(IN_WIN); const float* w_ba = F.in(IN_WBA); const float* w_out = F.in(IN_WOUT); const float* w1 = F.in(IN_W1); const float* w2 = F.in(IN_W2);
    constexpr int TPITCH = 144, TBYTES = 256 * TPITCH;
    const int wave = F.wave, lane = F.lane, tid = F.tid;
    __syncthreads();
    float v[16][4];
    int buf = 0;
    TItem cur; if (j < j_end) { cur = p0_item(j + (j >= skip_at ? skip_n : 0), w_in, w_ba, w_out, w1, w2, F.ws); p0_load<ONLY8>(cur, wave, lane, v); }
    while (j < j_end) {
        LAS unsigned char* T = F.lds + buf * TBYTES;
        if (ONLY8 || cur.fp8) {
#pragma unroll
            for (int jj = 0; jj < 4; ++jj) { u32x4 o; o.x = pk4_fp8(clamp448(v[0][jj] * W_PRESCALE), clamp448(v[1][jj] * W_PRESCALE), clamp448(v[2][jj] * W_PRESCALE), clamp448(v[3][jj] * W_PRESCALE)); o.y = pk4_fp8(clamp448(v[4][jj] * W_PRESCALE), clamp448(v[5][jj] * W_PRESCALE), clamp448(v[6][jj] * W_PRESCALE), clamp448(v[7][jj] * W_PRESCALE));
                o.z = pk4_fp8(clamp448(v[8][jj] * W_PRESCALE), clamp448(v[9][jj] * W_PRESCALE), clamp448(v[10][jj] * W_PRESCALE), clamp448(v[11][jj] * W_PRESCALE)); o.w = pk4_fp8(clamp448(v[12][jj] * W_PRESCALE), clamp448(v[13][jj] * W_PRESCALE), clamp448(v[14][jj] * W_PRESCALE), clamp448(v[15][jj] * W_PRESCALE));
                *(LAS u32x4*)(T + (lane + 64 * jj) * TPITCH + wave * 16) = o; }
        } else {
#pragma unroll
            for (int jj = 0; jj < 4; ++jj) { u32x4 o; o.x = pk2(v[0][jj], v[1][jj]); o.y = pk2(v[2][jj], v[3][jj]); o.z = pk2(v[4][jj], v[5][jj]); o.w = pk2(v[6][jj], v[7][jj]);
                *(LAS u32x4*)(T + (lane + 64 * jj) * TPITCH + wave * 16) = o; }
        }
        const int nj = j + stride; TItem nxt = cur;
        if (nj < j_end) { nxt = p0_item(nj + (nj >= skip_at ? skip_n : 0), w_in, w_ba, w_out, w1, w2, F.ws); p0_load<ONLY8>(nxt, wave, lane, v); }
        __syncthreads();
#pragma unroll
        for (int i = 0; i < 4; ++i) { const int p = tid + 512 * i, row = p >> 3, c = p & 7; const u32x4 o = *(const LAS u32x4*)(T + row * TPITCH + c * 16);
            *(u32x4*)(cur.dst + (size_t)(cur.row0 + row) * cur.rowpitch + cur.kbyte0 + c * 16) = o; }
        cur = nxt; j = nj; buf ^= 1;
    }
    __syncthreads();
}
__device__ __forceinline__ void p0_prologue(Frame& F) {
    refresh(F);
    const float* pool_w = F.in(IN_POOLW); const float* pool_scale = F.in(IN_POOLS); const float* w_bp = F.in(IN_WBP); const float* x = F.in(IN_X); const float* mix_norm = F.in(IN_MIXN);
    p0_copy<false>(F, (int)blockIdx.x, IT_W1_BEG, (int)gridDim.x, 1 << 30, 0);
    {
        const int gt = F.gw * 64 + F.lane, ngt = F.ngw * 64;
        for (int idx = gt; idx < 4 * 32 * 1024; idx += ngt) { const int d = idx & 1023, cq = (idx >> 10) & 31, g = idx >> 15;
            const float* pw = pool_w + ((size_t)g * 128 + cq * 4) * 128; const float* ps = pool_scale + g * 128; const float* wb = w_bp + (size_t)(g * 128) * 1024 + d;
            float a0 = 0.f, a1 = 0.f, a2 = 0.f, a3 = 0.f;
#pragma unroll 16
            for (int j = 0; j < 128; ++j) { const float wv = wb[(size_t)j * 1024] * ps[j]; a0 += pw[j] * wv; a1 += pw[128 + j] * wv; a2 += pw[256 + j] * wv; a3 += pw[384 + j] * wv; }
            u32x2 o; o.x = pk2(a0, a1); o.y = pk2(a2, a3);
            *(u32x2*)(F.w<bf16>(WS_WPC) + (size_t)d * 512 + g * 128 + cq * 4) = o; }
    }
    {
        const int lane = F.lane, st = F.ngw; bf16* Hh = F.w<bf16>(WS_H); unsigned* H8 = F.w<unsigned>(WS_H8X);
        f32x4 va[4], vb[4]; int m = F.gw;
        auto ld = [&](f32x4 (&v)[4], int mm) { const f32x4* xr = (const f32x4*)(x + (size_t)mm * D) + lane;
#pragma unroll
            for (int j = 0; j < 4; ++j) v[j] = __builtin_nontemporal_load(xr + 64 * j); };
        auto row = [&](const f32x4 (&v)[4], int mm) { float ss = 0.f;
#pragma unroll
            for (int j = 0; j < 4; ++j) ss += (v[j].x * v[j].x + v[j].y * v[j].y) + (v[j].z * v[j].z + v[j].w * v[j].w);
            const float rstd = 1.0f / sqrtf(wave_sum(ss) * (1.f / D) + RMS_EPS);
            const f32x4* gr = (const f32x4*)mix_norm + lane; u32x2* o8 = (u32x2*)(Hh + (size_t)mm * D) + lane;
#pragma unroll
            for (int j = 0; j < 4; ++j) { const f32x4 g = gr[64 * j]; const float h0 = v[j].x * rstd * g.x, h1 = v[j].y * rstd * g.y, h2 = v[j].z * rstd * g.z, h3 = v[j].w * rstd * g.w;
                u32x2 w; w.x = pk2(h0, h1); w.y = pk2(h2, h3); o8[64 * j] = w;
                H8[(size_t)mm * 256 + lane + 64 * j] = pk4_fp8(clamp448(h0 * H_PRESCALE), clamp448(h1 * H_PRESCALE), clamp448(h2 * H_PRESCALE), clamp448(h3 * H_PRESCALE)); } };
        if (m < NTOK) ld(va, m);
        while (m < NTOK) { const int m2 = m + st, m3 = m2 + st;
            if (m2 < NTOK) ld(vb, m2);
            row(va, m);
            if (m3 < NTOK) ld(va, m3);
            if (m2 < NTOK) row(vb, m2);
            m = m3; }
    }
}

__device__ __forceinline__ unsigned pk_f16(float a, float b) { const unsigned short x = __builtin_bit_cast(unsigned short, (_Float16)a), y = __builtin_bit_cast(unsigned short, (_Float16)b); return (unsigned)x | ((unsigned)y << 16); }
typedef _Float16 f16x2 __attribute__((ext_vector_type(2)));
__device__ __forceinline__ unsigned pk_f16v(f32x2 v) { return __builtin_bit_cast(unsigned, __builtin_convertvector(v, f16x2)); }
__device__ __forceinline__ void score_seg(int b, int qb, int kb0, int nkb, const bf16* QI, const bf16* KI, const float* WI, unsigned short* SC, LAS unsigned char* stile, int lane) {
    const int r32 = lane & 31, hi = lane >> 5;
    const size_t qrow = (size_t)b * SEQ + 32 * qb + r32;
    bf16x8 qf[4][4];
#pragma unroll
    for (int h = 0; h < 4; ++h)
#pragma unroll
        for (int kk = 0; kk < 4; ++kk) qf[h][kk] = *(const bf16x8*)(QI + qrow * 256 + h * 64 + kk * 16 + hi * 8);
    const f32x4 wv = *(const f32x4*)(WI + qrow * 4);
    const bf16* kip = KI + ((size_t)b * SEQ + r32) * 64 + hi * 8;
    const int kb1 = kb0 + nkb - 1;
    auto body = [&](const bf16x8 (&kf)[4], int kc) {
        f32x2 s2[8];
#pragma unroll
        for (int h = 0; h < 4; ++h) { f32x16 a;
#pragma unroll
            for (int i = 0; i < 16; ++i) a[i] = 0.f;
#pragma unroll
            for (int kk = 0; kk < 4; ++kk) a = __builtin_amdgcn_mfma_f32_32x32x16_bf16(kf[kk], qf[h][kk], a, 0, 0, 0);
            const f32x2 w2 = {wv[h], wv[h]};
#pragma unroll
            for (int j = 0; j < 8; ++j) { f32x2 r; r.x = __int_as_float(max(__float_as_int(a[2 * j]), 0)); r.y = __int_as_float(max(__float_as_int(a[2 * j + 1]), 0));
                s2[j] = (h == 0) ? (w2 * r + (f32x2){0.f, 0.f}) : (w2 * r + s2[j]); } }
#pragma unroll
        for (int g = 0; g < 4; ++g) { u32x2 o; o.x = pk_f16v(s2[2 * g]); o.y = pk_f16v(s2[2 * g + 1]); *(LAS u32x2*)(stile + r32 * 80 + (8 * g + 4 * hi) * 2) = o; }
        LDS_WAIT(); asm volatile("" ::: "memory");
#pragma unroll
        for (int i = 0; i < 2; ++i) { const int rr = i * 16 + (lane >> 2), cc = lane & 3; const u32x4 o = *(const LAS u32x4*)(stile + rr * 80 + cc * 16);
            *(u32x4*)(SC + ((size_t)b * SEQ + 32 * qb + rr) * SEQ + 32 * kc + cc * 8) = o; }
        LDS_WAIT(); asm volatile("" ::: "memory");
    };
    bf16x8 kA[4], kB[4];
#pragma unroll
    for (int kk = 0; kk < 4; ++kk) kA[kk] = *(const bf16x8*)(kip + (size_t)(32 * kb0) * 64 + kk * 16);
    asm volatile("" :: "v"(kA[0]), "v"(kA[1]), "v"(kA[2]), "v"(kA[3]), "v"(wv), "v"(qf[0][0]), "v"(qf[0][1]), "v"(qf[0][2]), "v"(qf[0][3]), "v"(qf[1][0]), "v"(qf[1][1]), "v"(qf[1][2]), "v"(qf[1][3]), "v"(qf[2][0]), "v"(qf[2][1]), "v"(qf[2][2]), "v"(qf[2][3]), "v"(qf[3][0]), "v"(qf[3][1]), "v"(qf[3][2]), "v"(qf[3][3]));
#pragma unroll 1
    for (int kc = kb0; kc <= kb1; kc += 2) {
        { const int kn = (kc + 1 <= kb1) ? kc + 1 : kb1;
#pragma unroll
          for (int kk = 0; kk < 4; ++kk) kB[kk] = *(const bf16x8*)(kip + (size_t)(32 * kn) * 64 + kk * 16); }
        __builtin_amdgcn_sched_barrier(0);
        body(kA, kc);
        if (kc + 1 > kb1) break;
        { const int kn = (kc + 2 <= kb1) ? kc + 2 : kb1;
#pragma unroll
          for (int kk = 0; kk < 4; ++kk) kA[kk] = *(const bf16x8*)(kip + (size_t)(32 * kn) * 64 + kk * 16); }
        __builtin_amdgcn_sched_barrier(0);
        body(kB, kc + 1);
    }
}
template <int W> __device__ __forceinline__ void pooled_group(const bf16* zp, bf16* po, int tok0, int ch) {
    const int t0 = tok0 & (SEQ - 1);
    u32x4 v[7 + W];
#pragma unroll
    for (int r = 0; r < 7 + W; ++r) { const int rel = r - (W - 1); v[r] = (u32x4){0u, 0u, 0u, 0u}; if (t0 + rel >= 0) v[r] = *(const u32x4*)(zp + (size_t)(tok0 + rel) * 512 + ch * 8); }
    float s[8];
#pragma unroll
    for (int j = 0; j < 8; ++j) s[j] = 0.f;
#pragma unroll
    for (int r = 0; r < W; ++r) { s[0] += bflo(v[r].x); s[1] += bfhi(v[r].x); s[2] += bflo(v[r].y); s[3] += bfhi(v[r].y); s[4] += bflo(v[r].z); s[5] += bfhi(v[r].z); s[6] += bflo(v[r].w); s[7] += bfhi(v[r].w); }
#pragma unroll
    for (int j = 0; j < 8; ++j) {
        if (j > 0) { const u32x4 a = v[W - 1 + j], b = v[j - 1];
            s[0] += bflo(a.x) - bflo(b.x); s[1] += bfhi(a.x) - bfhi(b.x); s[2] += bflo(a.y) - bflo(b.y); s[3] += bfhi(a.y) - bfhi(b.y); s[4] += bflo(a.z) - bflo(b.z); s[5] += bfhi(a.z) - bfhi(b.z); s[6] += bflo(a.w) - bflo(b.w); s[7] += bfhi(a.w) - bfhi(b.w); }
        const int n = (t0 + j + 1 < W) ? t0 + j + 1 : W; const float inv = 1.0f / (float)n; const u32x4 cur = v[W - 1 + j];
        u32x4 o; o.x = pk2(s[0] * inv - bflo(cur.x), s[1] * inv - bfhi(cur.x)); o.y = pk2(s[2] * inv - bflo(cur.y), s[3] * inv - bfhi(cur.y));
        o.z = pk2(s[4] * inv - bflo(cur.z), s[5] * inv - bfhi(cur.z)); o.w = pk2(s[6] * inv - bflo(cur.w), s[7] * inv - bfhi(cur.w));
        *(u32x4*)(po + (size_t)(tok0 + j) * 512 + ch * 8) = o; }
}
__device__ __forceinline__ void p2_pooled(Frame& F) {
    refresh(F);
    const bf16* zp = F.w<bf16>(WS_ZPOOL); bf16* po = F.w<bf16>(WS_POOLED);
    for (int wv = F.gw; wv < NTOK / 8 * 64 / 64; wv += F.ngw) {
        const int g = wv & 3, tg = (wv >> 2) * 4 + (F.lane >> 4), ch = g * 16 + (F.lane & 15), tok0 = tg * 8;
        if (g == 0) pooled_group<2>(zp, po, tok0, ch); else if (g == 1) pooled_group<4>(zp, po, tok0, ch); else if (g == 2) pooled_group<8>(zp, po, tok0, ch); else pooled_group<16>(zp, po, tok0, ch);
    }
}

__device__ __forceinline__ unsigned sortable(float v) { const unsigned u = __float_as_uint(v); return u ^ ((u >> 31) ? 0xFFFFFFFFu : 0x80000000u); }
__device__ __forceinline__ unsigned dpp_scan64(unsigned v) {
    v += (unsigned)__builtin_amdgcn_update_dpp(0, (int)v, 0x111, 0xf, 0xf, false);
    v += (unsigned)__builtin_amdgcn_update_dpp(0, (int)v, 0x112, 0xf, 0xf, false);
    v += (unsigned)__builtin_amdgcn_update_dpp(0, (int)v, 0x114, 0xf, 0xf, false);
    v += (unsigned)__builtin_amdgcn_update_dpp(0, (int)v, 0x118, 0xf, 0xf, false);
    v += (unsigned)__builtin_amdgcn_update_dpp(0, (int)v, 0x142, 0xa, 0xf, false);
    v += (unsigned)__builtin_amdgcn_update_dpp(0, (int)v, 0x143, 0xc, 0xf, false);
    return v;
}
__device__ __forceinline__ unsigned umed3(unsigned a, unsigned b, unsigned c) { unsigned r; asm("v_med3_u32 %0, %1, %2, %3" : "=v"(r) : "v"(a), "v"(b), "v"(c)); return r; }
__device__ __forceinline__ void find_bin256(LAS unsigned* hist, int lane, int& k, int& bin, int& bincnt) {
    u32x4 h = *(const LAS u32x4*)(hist + 4 * lane);
#pragma unroll
    for (int c_ = 1; c_ < 8; ++c_) { const u32x4 hc = *(const LAS u32x4*)(hist + c_ * 256 + 4 * lane); h.x += hc.x; h.y += hc.y; h.z += hc.z; h.w += hc.w; }
    const unsigned ls = (h.x + h.y) + (h.z + h.w);
    const unsigned pre = dpp_scan64(ls);
    const unsigned tot = (unsigned)__builtin_amdgcn_readlane((int)pre, 63);
    const unsigned above = tot - pre;
    const bool mine = (above < (unsigned)k) && (above + ls >= (unsigned)k);
    unsigned c = above; int sub; unsigned cnt;
    if (c + h.w >= (unsigned)k) { sub = 3; cnt = h.w; } else { c += h.w; if (c + h.z >= (unsigned)k) { sub = 2; cnt = h.z; } else { c += h.z; if (c + h.y >= (unsigned)k) { sub = 1; cnt = h.y; } else { c += h.y; sub = 0; cnt = h.x; } } }
    const u64 bm = __ballot(mine);
    const int L = (int)__builtin_ctzll(bm | (1ull << 63));
    bin = 4 * L + __builtin_amdgcn_readlane(sub, L); const int ab = __builtin_amdgcn_readlane((int)c, L); bincnt = __builtin_amdgcn_readlane((int)cnt, L);
    k -= ab;
}
__device__ __forceinline__ void p3_load_row(const unsigned short* sc, int row, unsigned (&v)[32], int lane) {
    const int t = row & (SEQ - 1), n = t + 1;
    const int ngrp = (n <= TOPK) ? 0 : ((n + 1023) >> 10); const unsigned* srow = (const unsigned*)(sc + (size_t)row * SEQ) + lane;
#pragma unroll
    for (int g = 0; g < 4; ++g) if (g < ngrp) {
#pragma unroll
        for (int i = 0; i < 8; ++i) v[g * 8 + i] = srow[(g * 8 + i) * 64]; }
}
__device__ __forceinline__ unsigned p3_keys(unsigned w, int e0, int t) {
    unsigned x = w ^ 0x80008000u ^ (((w >> 15) & 0x00010001u) * 0x7fffu);
    if (e0 > t) x = 0u; else if (e0 + 1 > t) x &= 0xffffu;
    return x;
}
struct NoStage { __device__ __forceinline__ void operator()(int) const {} };
template <class LD = NoStage> __device__ __forceinline__ void p3_select_row(Frame& F, int row, LAS unsigned* hist, const unsigned (&key)[32], const LD& ld = LD()) {
    const int lane = F.lane, t = row & (SEQ - 1), n = t + 1;
    u64* mrow = (F.w<u64>(WS_MASK)) + (size_t)row * 64;
    if (n <= TOPK) {
        const int lo = lane * 64; unsigned we, wo;
        if (t >= lo + 63) { we = ~0u; wo = ~0u; } else if (t >= lo) { const int ce = ((t - lo) >> 1) + 1, co = (t - lo + 1) >> 1; we = (ce >= 32) ? ~0u : ((1u << ce) - 1u); wo = (co >= 32) ? ~0u : ((1u << co) - 1u); } else { we = 0u; wo = 0u; }
        mrow[lane] = ((u64)wo << 32) | (u64)we;
        ld(0); ld(1); ld(2); ld(3);
        return;
    }
    const int ngrp = (n + 1023) >> 10;
#define HZERO() do { _Pragma("unroll") for (int j_ = 0; j_ < 9; ++j_) { if (j_ < 8 || lane < 16) *(LAS u32x4*)(hist + 4 * lane + 256 * j_) = (u32x4){0u, 0u, 0u, 0u}; } LDS_WAIT(); } while (0)
    int k = TOPK, bin, bincnt; unsigned T; LAS unsigned* hmine = hist + (lane & 7) * 256;
    ld(0);
    unsigned m0 = 0u, m1 = 0u, m2 = 0u, m3 = 0u;
#pragma unroll
    for (int g = 0; g < 4; ++g) if (g < ngrp) {
#pragma unroll
        for (int i = 0; i < 8; ++i) { const unsigned kv = key[g * 8 + i], kA = kv & 0xffffu, kB = kv >> 16;
            m3 = umed3(m2, m3, kA); m2 = umed3(m1, m2, kA); m1 = umed3(m0, m1, kA); m0 = max(m0, kA);
            m3 = umed3(m2, m3, kB); m2 = umed3(m1, m2, kB); m1 = umed3(m0, m1, kB); m0 = max(m0, kB); } }
    const unsigned Lc = 0xffffu - wave_max_u32(0xffffu - m3);
    ld(1);
    HZERO();
#pragma unroll
    for (int g = 0; g < 4; ++g) if (g < ngrp) {
#pragma unroll
        for (int i = 0; i < 8; ++i) { const unsigned kv = key[g * 8 + i], kA = kv & 0xffffu, kB = kv >> 16;
            if (kA >= Lc) __hip_atomic_fetch_add(hmine + (kA >> 8), 1u, __ATOMIC_RELAXED, __HIP_MEMORY_SCOPE_WORKGROUP);
            if (kB >= Lc) __hip_atomic_fetch_add(hmine + (kB >> 8), 1u, __ATOMIC_RELAXED, __HIP_MEMORY_SCOPE_WORKGROUP); } }
    LDS_WAIT(); asm volatile("" ::: "memory");
    find_bin256(hist, lane, k, bin, bincnt); T = (unsigned)bin << 8;
    LDS_WAIT(); asm volatile("" ::: "memory");
    ld(2);
    if (bincnt != k) {
        const unsigned b0 = (unsigned)bin;
        HZERO();
#pragma unroll
        for (int g = 0; g < 4; ++g) if (g < ngrp) {
#pragma unroll
            for (int i = 0; i < 8; ++i) { const unsigned kv = key[g * 8 + i];
                if (((kv >> 8) & 0xffu) == b0 && (kv & 0xffffu) >= Lc) __hip_atomic_fetch_add(hmine + (kv & 0xffu), 1u, __ATOMIC_RELAXED, __HIP_MEMORY_SCOPE_WORKGROUP);
                if ((kv >> 24) == b0 && (kv >> 16) >= Lc) __hip_atomic_fetch_add(hmine + ((kv >> 16) & 0xffu), 1u, __ATOMIC_RELAXED, __HIP_MEMORY_SCOPE_WORKGROUP); } }
        LDS_WAIT(); asm volatile("" ::: "memory");
        find_bin256(hist, lane, k, bin, bincnt); T |= (unsigned)bin;
        LDS_WAIT(); asm volatile("" ::: "memory");
    }
#undef HZERO
    ld(3);
    T = max(T, Lc);
    const bool exact = (bincnt == k); const int krem = k;
    LAS u32x2* mw = (LAS u32x2*)(hist + 2112);
    mw[lane] = (u32x2){0u, 0u};
    if (exact) {
#pragma unroll
        for (int g = 0; g < 4; ++g) if (g < ngrp) {
#pragma unroll
            for (int i8 = 0; i8 < 8; ++i8) { const int i = g * 8 + i8; const unsigned kv = key[i]; const u64 bA = __ballot((kv & 0xffffu) >= T), bB = __ballot((kv >> 16) >= T);
                if (lane == 0) *(LAS u32x4*)(mw + 2 * i) = (u32x4){(unsigned)bA, (unsigned)bB, (unsigned)(bA >> 32), (unsigned)(bB >> 32)}; } }
    } else {
        const u64 lt_mask = (1ull << lane) - 1ull; int base_eq = 0;
#pragma unroll
        for (int g = 0; g < 4; ++g) if (g < ngrp) {
#pragma unroll
            for (int i8 = 0; i8 < 8; ++i8) { const int i = g * 8 + i8; const unsigned kv = key[i], kA = kv & 0xffffu, kB = kv >> 16;
                const bool eqA = kA == T, eqB = kB == T;
                const u64 beA = __ballot(eqA), beB = __ballot(eqB);
                const int rA = base_eq + __popcll(beA & lt_mask) + __popcll(beB & lt_mask), rB = rA + (eqA ? 1 : 0);
                const u64 bA = __ballot(kA > T || (eqA && rA < krem)), bB = __ballot(kB > T || (eqB && rB < krem));
                if (lane == 0) { mw[2 * i] = (u32x2){(unsigned)bA, (unsigned)bB}; mw[2 * i + 1] = (u32x2){(unsigned)(bA >> 32), (unsigned)(bB >> 32)}; }
                base_eq += __popcll(beA) + __popcll(beB); } }
    }
    LDS_WAIT(); asm volatile("" ::: "memory");
    { const u32x2 w = mw[lane]; mrow[lane] = ((u64)w.y << 32) | (u64)w.x; }
    LDS_WAIT(); asm volatile("" ::: "memory");
}
__device__ __forceinline__ void p3_select(Frame& F) {
    refresh(F);
    LAS unsigned* hist = (LAS unsigned*)(F.lds + F.wave * 9216);
    const unsigned short* sc = F.w<unsigned short>(WS_SC);
    for (int j = F.gw; j < 2048; j += F.ngw) {
        unsigned v[32], key[32];
        p3_load_row(sc, j, v, F.lane);
#pragma unroll 1
        for (int q = 0; q < 8; ++q) { const int b = q >> 1, t = (q & 1) ? (SEQ - 1 - j) : j, row = b * SEQ + t;
            const int n = t + 1;
            if (n > TOPK) {
                const int ngrp = (n + 1023) >> 10;
#pragma unroll
                for (int g = 0; g < 4; ++g) {
                    if (g < ngrp) {
#pragma unroll
                        for (int i = 0; i < 8; ++i) key[g * 8 + i] = p3_keys(v[g * 8 + i], (g * 8 + i) * 128 + 2 * F.lane, t);
                    } else {
#pragma unroll
                        for (int i = 0; i < 8; ++i) key[g * 8 + i] = 0u;
                    } }
            }
            if (q < 7) { const int q2 = q + 1, b2 = q2 >> 1, t2 = (q2 & 1) ? (SEQ - 1 - j) : j; p3_load_row(sc, b2 * SEQ + t2, v, F.lane); }
            p3_select_row(F, row, hist, key);
        }
    }
}

struct MiniJob { const float* src; unsigned char* dst; int ldw; };
__device__ __forceinline__ MiniJob mini_job(int mi, const float* w1, const float* w2, unsigned char* ws) {
    MiniJob j; const int it = mi >> 3, cg = mi & 7;
    if (it < MINI_W1_ITEMS) { const int e = it >> 6, q = it & 63, kb = q >> 3, nb = q & 7; j.ldw = 2048;
        j.src = w1 + (size_t)e * 1024 * 2048 + (size_t)(kb * 128) * 2048 + nb * 256 + cg * 32; j.dst = ws + WS_W1 + ((size_t)e * 2048 + nb * 256 + cg * 32) * 1024 + kb * 128; }
    else { const int r = it - MINI_W1_ITEMS, e = r >> 5, q = r & 31, kb = q >> 2, nb = q & 3; j.ldw = 1024;
        j.src = w2 + (size_t)e * 1024 * 1024 + (size_t)(kb * 128) * 1024 + nb * 256 + cg * 32; j.dst = ws + WS_W2 + ((size_t)e * 1024 + nb * 256 + cg * 32) * 1024 + kb * 128; }
    return j;
}
__device__ __forceinline__ void mini_load(const MiniJob& j, int lane, f32x4 (&cv)[16], int jj) {
    const float* p = j.src + (size_t)(4 * (lane >> 3)) * j.ldw + 4 * (lane & 7);
#pragma unroll
    for (int r = 0; r < 4; ++r) cv[jj * 4 + r] = __builtin_nontemporal_load((const f32x4*)(p + (size_t)(32 * jj + r) * j.ldw));
}
__device__ __forceinline__ void mini_finish(const MiniJob& j, int lane, const f32x4 (&cv)[16], LAS unsigned char* tile) {
    const int k4 = lane >> 3, p = lane & 7;
#pragma unroll
    for (int jj = 0; jj < 4; ++jj) { unsigned d[4];
#pragma unroll
        for (int r = 0; r < 4; ++r) { const f32x4 v = cv[jj * 4 + r]; d[r] = pk4_fp8(clamp448(v.x * W_PRESCALE), clamp448(v.y * W_PRESCALE), clamp448(v.z * W_PRESCALE), clamp448(v.w * W_PRESCALE)); }
        const unsigned a01l = __builtin_amdgcn_perm(d[1], d[0], 0x05010400u), a01h = __builtin_amdgcn_perm(d[1], d[0], 0x07030602u), a23l = __builtin_amdgcn_perm(d[3], d[2], 0x05010400u), a23h = __builtin_amdgcn_perm(d[3], d[2], 0x07030602u);
        const unsigned t0 = __builtin_amdgcn_perm(a23l, a01l, 0x05040100u), t1 = __builtin_amdgcn_perm(a23l, a01l, 0x07060302u), t2 = __builtin_amdgcn_perm(a23h, a01h, 0x05040100u), t3 = __builtin_amdgcn_perm(a23h, a01h, 0x07060302u);
        LAS unsigned char* tp = tile + (4 * p) * 144 + 32 * jj + 4 * k4;
        *(LAS unsigned*)tp = t0; *(LAS unsigned*)(tp + 144) = t1; *(LAS unsigned*)(tp + 288) = t2; *(LAS unsigned*)(tp + 432) = t3; }
    LDS_WAIT(); asm volatile("" ::: "memory");
    { const int n = lane >> 1, h = lane & 1;
#pragma unroll
      for (int i = 0; i < 4; ++i) { const u32x4 o = *(const LAS u32x4*)(tile + n * 144 + h * 64 + i * 16); *(u32x4*)(j.dst + (size_t)n * 1024 + h * 64 + i * 16) = o; } }
    LDS_WAIT(); asm volatile("" ::: "memory");
}
__device__ __forceinline__ void p2_scores_select(Frame& F) {
    refresh(F);
    const int lane = F.lane, wave = F.wave;
    const bf16* QI = F.w<bf16>(WS_QI); const bf16* KI = F.w<bf16>(WS_KI); const float* WI = F.w<float>(WS_WI); unsigned short* SC = F.w<unsigned short>(WS_SC);
    const float* w1 = F.in(IN_W1); const float* w2 = F.in(IN_W2);
    for (int unit = blockIdx.x; unit < 256; unit += F.G) {
        const int b = unit >> 6, p = unit & 63, na = p + 1;
        { LAS unsigned char* stile = F.lds + wave * 2560;
          int idx = (wave * 129) >> 3; const int end = ((wave + 1) * 129) >> 3;
          while (idx < end) { int qb, kb, len;
              if (idx < na) { qb = p; kb = idx; len = (na - idx < end - idx) ? (na - idx) : (end - idx); } else { qb = 127 - p; kb = idx - na; len = end - idx; }
              score_seg(b, qb, kb, len, QI, KI, WI, SC, stile, lane); idx += len; } }
        VM_WAIT(); __syncthreads();
        { refresh(F); const int lane = F.lane; int b_ = b, p_ = p, w_ = wave; asm volatile("" : "+s"(b_), "+s"(p_), "+s"(w_));
          LAS unsigned* hist = (LAS unsigned*)(F.lds + w_ * 9216);
          unsigned v[32], key[32];
#pragma unroll
          for (int i = 0; i < 32; ++i) { v[i] = 0u; key[i] = 0u; }
          auto rowof = [&](int q) { return b_ * SEQ + ((q & 1) ? 32 * (127 - p_) : 32 * p_) + 4 * w_ + (q >> 1); };
          p3_load_row(SC, rowof(0), v, lane);
#pragma unroll 1
          for (int q = 0; q < 8; ++q) { const int row = rowof(q), t = row & (SEQ - 1), n = t + 1;
              const MiniJob mj = mini_job(__builtin_amdgcn_readfirstlane((unit * 8 + w_) * 8 + q), w1, w2, F.ws); f32x4 cv[16];
              if (n > TOPK) {
                  const int ngrp = (n + 1023) >> 10;
#pragma unroll
                  for (int g = 0; g < 4; ++g) {
                      if (g < ngrp) {
#pragma unroll
                          for (int i = 0; i < 8; ++i) key[g * 8 + i] = p3_keys(v[g * 8 + i], (g * 8 + i) * 128 + 2 * lane, t);
                      } else {
#pragma unroll
                          for (int i = 0; i < 8; ++i) key[g * 8 + i] = 0u;
                      } }
              }
              if (q < 7) p3_load_row(SC, rowof(q + 1), v, lane);
              auto stage = [&](int part) { if (part == 0) mini_load(mj, lane, cv, 0); else if (part == 1) mini_load(mj, lane, cv, 1); else if (part == 2) mini_load(mj, lane, cv, 2); else mini_load(mj, lane, cv, 3); };
              p3_select_row(F, row, hist, key, stage);
              mini_finish(mj, lane, cv, F.lds + 73728 + w_ * 4608);
          } }
        VM_WAIT(); __syncthreads();
    }
}

__device__ __forceinline__ int t5_bucket(int n) {
    if (n < 16) return n;
    const int th[16] = {16, 19, 21, 24, 27, 31, 35, 40, 46, 52, 59, 67, 77, 87, 99, 113};
    int b = 16;
#pragma unroll
    for (int i = 1; i < 16; ++i) if (n >= th[i]) b = 16 + i;
    return b;
}
__device__ __forceinline__ void p4_attn_gather(Frame& F) {
    refresh(F);
    const float* rel_bias = F.in(IN_RELB);
    LAS float* biasl = (LAS float*)(F.lds);
    for (int i = F.tid; i < 1024; i += 512) { const int h = i >> 7, d = i & 127; biasl[i] = rel_bias[t5_bucket(d) * 8 + h] * LOG2E; }
    __syncthreads();
    const int lane = F.lane, h = lane >> 3;
    const float bias_far = rel_bias[31 * 8 + h] * LOG2E;
    for (int row = F.gw; row < NTOK; row += F.ngw) {
        const int t = row & (SEQ - 1), b0 = row - t, cnt = (t + 1 < TOPK) ? t + 1 : TOPK;
        const int* irow = (F.w<int>(WS_SELIDX)) + (size_t)row * 256;
        int myidx[4];
        { const u32x4 v = *(const u32x4*)(irow + lane * 4); myidx[0] = (int)v.x; myidx[1] = (int)v.y; myidx[2] = (int)v.z; myidx[3] = (int)v.w; }
        float q[8];
        { const u32x4 v = *(const u32x4*)((F.w<bf16>(WS_Q)) + (size_t)row * 512 + lane * 8); q[0] = bflo(v.x); q[1] = bfhi(v.x); q[2] = bflo(v.y); q[3] = bfhi(v.y); q[4] = bflo(v.z); q[5] = bfhi(v.z); q[6] = bflo(v.w); q[7] = bfhi(v.w); }
        float m = -1e30f, lsum = 0.f, o[8];
#pragma unroll
        for (int j = 0; j < 8; ++j) o[j] = 0.f;
        for (int c0 = 0; c0 < cnt; c0 += 8) {
            u32x4 kv[8], vv[8]; int kid[8]; float lg[8];
#pragma unroll
            for (int j = 0; j < 8; ++j) { const int kk = c0 + j; int id = __shfl(myidx[j & 3], kk >> 2); if (kk >= cnt) id = 0; kid[j] = id;
                kv[j] = *(const u32x4*)((F.w<bf16>(WS_K)) + (size_t)(b0 + id) * 512 + lane * 8); vv[j] = *(const u32x4*)((F.w<bf16>(WS_V)) + (size_t)(b0 + id) * 512 + lane * 8); }
            float cm = -1e30f;
#pragma unroll
            for (int j = 0; j < 8; ++j) { const u32x4 kx = kv[j];
                float d = q[0] * bflo(kx.x) + q[1] * bfhi(kx.x) + q[2] * bflo(kx.y) + q[3] * bfhi(kx.y) + q[4] * bflo(kx.z) + q[5] * bfhi(kx.z) + q[6] * bflo(kx.w) + q[7] * bfhi(kx.w);
                d += __shfl_xor(d, 1); d += __shfl_xor(d, 2); d += __shfl_xor(d, 4);
                const int dist = t - kid[j];
                const float bs = (dist < 128) ? biasl[h * 128 + (dist < 0 ? 0 : dist)] : bias_far;
                lg[j] = (c0 + j < cnt) ? d + bs : -INFINITY;
                cm = fmaxf(cm, lg[j]); }
            const float mn = fmaxf(m, cm), f = __builtin_amdgcn_exp2f(m - mn);
            lsum *= f;
#pragma unroll
            for (int i = 0; i < 8; ++i) o[i] *= f;
            m = mn;
#pragma unroll
            for (int j = 0; j < 8; ++j) { const float p = __builtin_amdgcn_exp2f(lg[j] - m); lsum += p; const u32x4 vx = vv[j];
                o[0] += p * bflo(vx.x); o[1] += p * bfhi(vx.x); o[2] += p * bflo(vx.y); o[3] += p * bfhi(vx.y); o[4] += p * bflo(vx.z); o[5] += p * bfhi(vx.z); o[6] += p * bflo(vx.w); o[7] += p * bfhi(vx.w); }
        }
        const float inv = 1.0f / lsum;
        u32x4 w; w.x = pk2(o[0] * inv, o[1] * inv); w.y = pk2(o[2] * inv, o[3] * inv); w.z = pk2(o[4] * inv, o[5] * inv); w.w = pk2(o[6] * inv, o[7] * inv);
        *(u32x4*)((F.w<bf16>(WS_AO)) + (size_t)row * 512 + lane * 8) = w;
    }
}

__device__ __forceinline__ void p4_attn_dense(Frame& F, char* lds_generic) {
    refresh(F);
    const float* rel_bias = F.in(IN_RELB);
    LAS float* lut8 = (LAS float*)(F.lds + TAB_OFF);
    for (int i = F.tid; i < 1024; i += 512) { const int h = i >> 7, d = i & 127; lut8[i] = (d < 113) ? (rel_bias[t5_bucket(d) * 8 + h] - rel_bias[31 * 8 + h]) * LOG2E : 0.f; }
    __syncthreads();
    const attn_body::AttnTensors AT{(const attn_body::bf16*)F.w<bf16>(WS_Q), (const attn_body::bf16*)F.w<bf16>(WS_K), (const attn_body::bf16*)F.w<bf16>(WS_V), (attn_body::bf16*)F.w<bf16>(WS_AO), (const unsigned long long*)F.w<u64>(WS_MASK)};
    const attn_body::StaticOrder S(F.G, (int)blockIdx.x);
    attn_body::attn_phase<attn_body::StaticOrder>(lds_generic, AT, lut8, S);
}
__device__ __forceinline__ void p7_router(Frame& F) {
    refresh(F);
    const float* w_router = F.in(IN_WR); const float* b_router = F.in(IN_BR); const float* ffn_norm = F.in(IN_FFNN);
    LAS float* X = (LAS float*)F.lds; LAS int* rt = (LAS int*)(F.lds + TAB_OFF); LAS float* LG = (LAS float*)(F.lds + TAB_OFF + 4096); LAS float* RS = (LAS float*)(F.lds + TAB_OFF + 8192);
    const int lane = F.lane, wave = F.wave, n = lane & 31, hi = lane >> 5;
    float bw[64];
#pragma unroll
    for (int q = 0; q < 16; ++q) { const int k0 = 128 * wave + 8 * q + 4 * hi; const f32x4 g = *(const f32x4*)(ffn_norm + k0);
        bw[4 * q] = w_router[(size_t)k0 * 32 + n] * g.x; bw[4 * q + 1] = w_router[(size_t)(k0 + 1) * 32 + n] * g.y; bw[4 * q + 2] = w_router[(size_t)(k0 + 2) * 32 + n] * g.z; bw[4 * q + 3] = w_router[(size_t)(k0 + 3) * 32 + n] * g.w; }
    const f32x4 g0 = *(const f32x4*)(ffn_norm + 8 * lane), g1 = *(const f32x4*)(ffn_norm + 8 * lane + 4), g2 = *(const f32x4*)(ffn_norm + 512 + 8 * lane), g3 = *(const f32x4*)(ffn_norm + 512 + 8 * lane + 4);
    if (F.tid < 32) rt[F.tid] = 0;
    const float brt = b_router[F.tid & 31];
    __syncthreads();
    for (int tg = blockIdx.x; tg < NTOK / 64; tg += F.G) {
        if (threadIdx.x == 0) { panel_poll(F, CW_PANB, tg >> 2, 4u); __builtin_amdgcn_fence(__ATOMIC_ACQUIRE, "agent"); asm volatile("s_waitcnt vmcnt(0)" ::: "memory"); }
        __syncthreads();
#pragma unroll 1
        for (int grp = 0; grp < 2; ++grp) {
            const int tokg = tg * 64 + grp * 32;
            { u32x4 xa[4], xb[4];
#pragma unroll
              for (int i = 0; i < 4; ++i) { const bf16* xr = F.w<bf16>(WS_X1) + (size_t)(tokg + 4 * wave + i) * D + 8 * lane; xa[i] = *(const u32x4*)xr; xb[i] = *(const u32x4*)(xr + 512); }
#pragma unroll
              for (int i = 0; i < 4; ++i) { const int t = 4 * wave + i;
                const f32x4 a0 = {bflo(xa[i].x), bfhi(xa[i].x), bflo(xa[i].y), bfhi(xa[i].y)}, a1 = {bflo(xa[i].z), bfhi(xa[i].z), bflo(xa[i].w), bfhi(xa[i].w)};
                const f32x4 b0 = {bflo(xb[i].x), bfhi(xb[i].x), bflo(xb[i].y), bfhi(xb[i].y)}, b1 = {bflo(xb[i].z), bfhi(xb[i].z), bflo(xb[i].w), bfhi(xb[i].w)};
                float ss = (a0.x * a0.x + a0.y * a0.y) + (a0.z * a0.z + a0.w * a0.w); ss += (a1.x * a1.x + a1.y * a1.y) + (a1.z * a1.z + a1.w * a1.w);
                ss += (b0.x * b0.x + b0.y * b0.y) + (b0.z * b0.z + b0.w * b0.w); ss += (b1.x * b1.x + b1.y * b1.y) + (b1.z * b1.z + b1.w * b1.w);
                LAS float* xrow = X + t * 1024; const int sw = t & 15;
                *(LAS f32x4*)(xrow + (((2 * lane) ^ sw) << 2)) = a0; *(LAS f32x4*)(xrow + (((2 * lane + 1) ^ sw) << 2)) = a1;
                *(LAS f32x4*)(xrow + (((128 + 2 * lane) ^ sw) << 2)) = b0; *(LAS f32x4*)(xrow + (((129 + 2 * lane) ^ sw) << 2)) = b1;
                const float rstd = 1.0f / sqrtf(wave_sum(ss) * (1.f / D) + RMS_EPS), rp = rstd * H_PRESCALE;
                if (lane == 0) RS[t] = rstd;
                unsigned char* hr = F.w<unsigned char>(WS_H) + (size_t)(tokg + t) * D + 8 * lane;
                u32x2 o;
                o.x = pk4_fp8(a0.x * rp * g0.x, a0.y * rp * g0.y, a0.z * rp * g0.z, a0.w * rp * g0.w); o.y = pk4_fp8(a1.x * rp * g1.x, a1.y * rp * g1.y, a1.z * rp * g1.z, a1.w * rp * g1.w); *(u32x2*)hr = o;
                o.x = pk4_fp8(b0.x * rp * g2.x, b0.y * rp * g2.y, b0.z * rp * g2.z, b0.w * rp * g2.w); o.y = pk4_fp8(b1.x * rp * g3.x, b1.y * rp * g3.y, b1.z * rp * g3.z, b1.w * rp * g3.w); *(u32x2*)(hr + 512) = o; } }
            __syncthreads();
            f32x16 acc;
#pragma unroll
            for (int i = 0; i < 16; ++i) acc[i] = 0.f;
            { const LAS float* xrow = X + n * 1024; const int sw = n & 15;
#pragma unroll
              for (int q = 0; q < 16; ++q) { const f32x4 a = *(const LAS f32x4*)(xrow + (((32 * wave + 2 * q + hi) ^ sw) << 2));
                acc = __builtin_amdgcn_mfma_f32_32x32x2f32(a.x, bw[4 * q], acc, 0, 0, 0); acc = __builtin_amdgcn_mfma_f32_32x32x2f32(a.y, bw[4 * q + 1], acc, 0, 0, 0);
                acc = __builtin_amdgcn_mfma_f32_32x32x2f32(a.z, bw[4 * q + 2], acc, 0, 0, 0); acc = __builtin_amdgcn_mfma_f32_32x32x2f32(a.w, bw[4 * q + 3], acc, 0, 0, 0); } }
            __syncthreads();
            { LAS float* P = X + wave * 1024;
#pragma unroll
              for (int i = 0; i < 16; ++i) P[((i & 3) + 8 * (i >> 2) + 4 * hi) * 32 + n] = acc[i]; }
            __syncthreads();
#pragma unroll
            for (int o = 0; o < 2; ++o) { const int idx = F.tid + 512 * o; float s = X[idx];
#pragma unroll
                for (int w = 1; w < 8; ++w) s += X[w * 1024 + idx];
                LG[idx] = s * RS[idx >> 5] + brt; }
            __syncthreads();
#pragma unroll 1
            for (int pass = 0; pass < 2; ++pass) {
                const int t0 = 4 * wave + 2 * pass, tok0 = tokg + t0;
                f32x2 lg; lg.x = LG[t0 * 32 + (lane >> 1)]; lg.y = LG[(t0 + 1) * 32 + (lane >> 1)];
#pragma unroll
                for (int tk = 0; tk < 2; ++tk) {
                    const float v = (tk ? lg.y : lg.x) + 0.f;
                    unsigned sk = sortable(v);
                    float tv[4]; int te[4];
#pragma unroll
                    for (int r = 0; r < 4; ++r) { const unsigned mk = wave_max_u32(sk); const u64 bal = __ballot(sk == mk); const int ln = (int)__builtin_ctzll(bal | (1ull << 63)); const int bi = ln >> 1;
                        tv[r] = __int_as_float(__builtin_amdgcn_readlane(__float_as_int(v), ln)); te[r] = bi; sk = ((lane >> 1) == bi) ? 0u : sk; }
                    const float e1 = __expf(tv[1] - tv[0]), e2 = __expf(tv[2] - tv[0]), e3 = __expf(tv[3] - tv[0]), inv = 1.0f / (1.0f + e1 + e2 + e3);
                    const float gt[4] = {inv, e1 * inv, e2 * inv, e3 * inv};
                    if (lane == 0) { const int tok = tok0 + tk, sl = (tok - tg * 64) * 4;
#pragma unroll
                        for (int r = 0; r < 4; ++r) { const int lp = __hip_atomic_fetch_add(rt + te[r], 1, __ATOMIC_RELAXED, __HIP_MEMORY_SCOPE_WORKGROUP); rt[64 + sl + r] = te[r]; rt[320 + sl + r] = lp; (F.w<float>(WS_TOKGATE))[(size_t)tok * 4 + r] = gt[r]; } }
                }
            }
        }
        __syncthreads();
        if (F.tid < 32) { const int c = rt[F.tid]; int base = 0; if (c) base = (int)__hip_atomic_fetch_add(F.ctl() + CW_ECNT + 64 * F.tid, (unsigned)c, RLX_AGENT); rt[32 + F.tid] = base; }
        __syncthreads();
        if (F.tid < 256) { const int e = rt[64 + F.tid], pos = rt[32 + e] + rt[320 + F.tid]; (F.w<int>(WS_LIST))[(size_t)e * NTOK + pos] = (tg * 64 + (F.tid >> 2)) * 4 + (F.tid & 3); }
        __syncthreads();
        if (F.tid < 32) rt[F.tid] = 0;
        __syncthreads();
    }
}
__device__ __forceinline__ void moe_rows_fill(Frame& F, const int* list, const float* tokgate, const float* b2) {
    const LAS int* tab = (const LAS int*)(F.lds + TAB_OFF); LAS int* rows = (LAS int*)(F.lds + TAB_OFF + 4096); LAS float* bias = (LAS float*)(F.lds + BIAS_OFF);
    const int T = tab[64], nwg = T * 4;
    for (int q = F.tid; q < 5 * 256; q += 512) { const int i = q >> 8, r = q & 255; const long L = (long)i * F.G + (int)blockIdx.x; int ts = 0; float g = 0.f;
        float bv = 0.f;
        if (L < nwg) { const int wgid = pg8::xcd_remap((int)L, nwg), mt = wgid >> 2, pn = wgid & 3; const int te = tab[128 + mt], e = te >> 16, lt = te & 0xffff, cnt = tab[e], pos = lt * 256 + r;
            if (pos < cnt) { ts = list[(size_t)e * NTOK + pos]; g = tokgate[ts]; }
            bv = b2[(size_t)e * 1024 + pn * 256 + r]; }
        rows[2 * q] = ts; rows[2 * q + 1] = __float_as_int(g); bias[q] = bv; }
    __syncthreads();
}
__device__ __forceinline__ void build_moe_tab(Frame& F) {
    refresh(F);
    LAS int* tab = (LAS int*)(F.lds + TAB_OFF);
    if (F.tid < 32) tab[F.tid] = (int)__hip_atomic_load(F.ctl() + CW_ECNT + 64 * F.tid, RLX_AGENT);
    __syncthreads();
    if (F.tid == 0) { int off = 0, T = 0;
        for (int e = 0; e < 32; ++e) { const int c = tab[e], nt = (c + 255) >> 8; tab[32 + e] = off; for (int lt = 0; lt < nt; ++lt) tab[128 + T++] = (e << 16) | lt; off += nt * 256; }
        tab[64] = T; }
    __syncthreads();
}
struct FinRow { u32x2 x[4]; unsigned y[4][4]; };
__device__ __forceinline__ void p10_load(FinRow& r, const bf16* x1, const unsigned char* ys, int m, int lane) {
    const u32x2* xr = (const u32x2*)(x1 + (size_t)m * D) + lane;
#pragma unroll
    for (int j = 0; j < 4; ++j) r.x[j] = __builtin_nontemporal_load(xr + 64 * j);
#pragma unroll
    for (int kq = 0; kq < 4; ++kq) { const unsigned* yr = (const unsigned*)(ys + ((size_t)m * 4 + kq) * D) + lane;
#pragma unroll
        for (int j = 0; j < 4; ++j) r.y[kq][j] = __builtin_nontemporal_load(yr + 64 * j); }
}
__device__ __forceinline__ void p10_row(const FinRow& r, const float* final_norm, float* out, int m, int lane) {
    f32x4 v[4]; float s = 0.f;
#pragma unroll
    for (int j = 0; j < 4; ++j) { f32x4 ysum = {0.f, 0.f, 0.f, 0.f};
#pragma unroll
        for (int kq = 0; kq < 4; ++kq) { const int y = (int)r.y[kq][j]; const auto lo = __builtin_amdgcn_cvt_pk_f32_fp8(y, false), hi2 = __builtin_amdgcn_cvt_pk_f32_fp8(y, true); ysum.x += lo[0]; ysum.y += lo[1]; ysum.z += hi2[0]; ysum.w += hi2[1]; }
        v[j] = (f32x4){bflo(r.x[j].x), bfhi(r.x[j].x), bflo(r.x[j].y), bfhi(r.x[j].y)} + ysum * (1.0f / YS_PRESCALE);
        s += (v[j].x * v[j].x + v[j].y * v[j].y) + (v[j].z * v[j].z + v[j].w * v[j].w); }
    const float rstd = 1.0f / sqrtf(wave_sum(s) * (1.f / D) + RMS_EPS);
    const f32x4* gr = (const f32x4*)final_norm + lane; f32x4* o = (f32x4*)(out + (size_t)m * D) + lane;
#pragma unroll
    for (int j = 0; j < 4; ++j) { const f32x4 g = gr[64 * j]; __builtin_nontemporal_store(v[j] * rstd * g, o + 64 * j); }
}
__device__ __forceinline__ void p10_final(Frame& F) {
    refresh(F);
    const float* final_norm = F.in(IN_FINN); float* out = F.outp();
    const bf16* x1 = F.w<bf16>(WS_X1); const unsigned char* ys = F.w<unsigned char>(WS_YS);
    const int lane = F.lane, st = F.ngw;
    FinRow A, B; int m = F.gw;
    if (m < NTOK) p10_load(A, x1, ys, m, lane);
    while (m < NTOK) {
        const int m2 = m + st, m3 = m2 + st;
        if (m2 < NTOK) p10_load(B, x1, ys, m2, lane);
        p10_row(A, final_norm, out, m, lane);
        if (m3 < NTOK) p10_load(A, x1, ys, m3, lane);
        if (m2 < NTOK) p10_row(B, final_norm, out, m2, lane);
        m = m3;
    }
}

__global__ void __launch_bounds__(NWAVES * 64, 2) fwd_kernel(Args args) {
    extern __shared__ __attribute__((aligned(16))) unsigned char lds[];
    Frame F;
    F.lds = (LAS unsigned char*)lds;
    F.tid = threadIdx.x; F.lane = F.tid & 63; F.wave = __builtin_amdgcn_readfirstlane(F.tid >> 6);
    F.G = gridDim.x; F.gw = blockIdx.x * NWAVES + F.wave; F.ngw = F.G * NWAVES;
    F.ws = args.ws;
    for (int u = F.tid; u < (LDS_BYTES - LDSCTL_OFF) / 4; u += NWAVES * 64) ((LAS unsigned*)(F.lds + LDSCTL_OFF))[u] = 0u;
    __syncthreads();
    XcdBarrier bar = xcd_barrier_post(F.ctl() + CW_BAR, (volatile LAS unsigned*)(F.lds + MISC_OFF) + 8);
    const int bx = (int)blockIdx.x;

    REP(0) p0_prologue(F);
    xcd_barrier(bar);
    {
      { pg8::DenseSched S; S.init(NTOK, 1024, 1024, F.w<bf16>(WS_WINI), F.G, bx);
        EpiInProj<true> E{F.w<bf16>(WS_ZPOOL), F.w<bf16>(WS_Q), F.w<bf16>(WS_K), F.w<bf16>(WS_V), F.w<bf16>(WS_QI), F.w<bf16>(WS_KI), F.w<bf16>(WS_GATE), F.w<float>(WS_WI)};
        pg8::gemm_phase<EpiInProj<true>, pg8::DenseSched, true>(F.lds, (const char*)F.w<bf16>(WS_H), 1024, S, E); }
      { pg8::DenseSched S; S.init(NTOK, 3584, 512, F.w<bf16>(WS_WIN), F.G, bx, 1);
        EpiInProj<false> E{F.w<bf16>(WS_ZPOOL), F.w<bf16>(WS_Q), F.w<bf16>(WS_K), F.w<bf16>(WS_V), F.w<bf16>(WS_QI), F.w<bf16>(WS_KI), F.w<bf16>(WS_GATE), F.w<float>(WS_WI)};
        pg8::gemm_phase<EpiInProj<false>, pg8::DenseSched, true, true, 0x78787878, 0x7c7c7c7c>(F.lds, (const char*)F.w<bf16>(WS_H8X), 512, S, E);
        { const int nidle = S.split ? 128 : F.G; if (bx < nidle) p0_copy<true>(F, IT_W1_END - NW1T + bx, IT_W1_END, nidle, 1 << 30, 0); } } }
    xcd_barrier(bar);
    REP(2) { p2_pooled(F); p2_scores_select(F); }
    xcd_barrier(bar);
    { pg8::DenseSched S; S.init(NTOK, 1024, 512, (F.w<bf16>(WS_WPC)), F.G, bx);
      EpiGate<false> E{(F.w<bf16>(WS_MERGED)), (F.w<bf16>(WS_GATE)), 0};
      pg8::gemm_phase<EpiGate<false>, pg8::DenseSched, true>(F.lds, (const char*)(F.w<bf16>(WS_POOLED)), 512, S, E); }
    REP(4) p4_attn_dense(F, (char*)lds);
    xcd_barrier(bar);
    { pg8::DenseSched S; S.init(NTOK, 1024, 256, (F.w<bf16>(WS_WBA)), F.G, bx);
      EpiGate<true> E{(F.w<bf16>(WS_MERGED)), (F.w<bf16>(WS_GATE)), 1024};
      pg8::gemm_phase<EpiGate<true>, pg8::DenseSched, true, true, 0x78787878, 0x78787878>(F.lds, (const char*)(F.w<bf16>(WS_AO)), 256, S, E);
      }
    panel_signal(F, CW_PANA);
    panel_wait(F, CW_PANA, 4u);
    REP(6) { pg8::DenseSched S; S.init(NTOK, 1024, 1024, (F.w<bf16>(WS_WOUT)), F.G, bx);
      EpiResidual E{F.in(IN_X), F.w<bf16>(WS_X1)};
      pg8::gemm_phase<EpiResidual, pg8::DenseSched, true>(F.lds, (const char*)(F.w<bf16>(WS_MERGED)), 1024, S, E);
      }
    panel_signal(F, CW_PANB);
    p7_router(F);
    xcd_barrier(bar);
    build_moe_tab(F); moe_gather_fill(F, F.w<int>(WS_LIST), F.in(IN_B1));
    REP(8) { MoeSched1 S{(const LAS int*)(F.lds + TAB_OFF), (const LAS int*)(F.lds + TAB_OFF + 4096), (const char*)(F.w<bf16>(WS_W1)), F.G, bx};
      EpiSwiGLU E{F.w<unsigned char>(WS_ACT), (const LAS float*)(F.lds + BIAS_OFF)};
      pg8::gemm_phase<EpiSwiGLU, MoeSched1, true, true, 0x78787878, 0x7c7c7c7c>(F.lds, (const char*)(F.w<bf16>(WS_H)), 512, S, E); }
    { const int T = ((const LAS int*)(F.lds + TAB_OFF))[64], rem = (T * 8) % F.G, nid = F.G - rem, base = IT_END - NW2T; int cover = nid * TAIL_PER; if (cover > NW2T) cover = NW2T;
      if (bx >= rem) p0_copy<true>(F, base + (bx - rem), base + cover, nid, 1 << 30, 0);
      if (cover < NW2T) p0_copy<true>(F, base + cover + bx, IT_END, F.G, 1 << 30, 0); }
    xcd_barrier(bar);
    moe_rows_fill(F, F.w<int>(WS_LIST), F.w<float>(WS_TOKGATE), F.in(IN_B2));
    REP(9) { MoeSched2 S{(const LAS int*)(F.lds + TAB_OFF), (const char*)(F.w<bf16>(WS_W2)), F.G, bx};
      EpiMoeOut E{F.w<unsigned char>(WS_YS), (const LAS float*)(F.lds + BIAS_OFF), (const LAS int*)(F.lds + TAB_OFF + 4096)};
      pg8::gemm_phase<EpiMoeOut, MoeSched2, true, true, 0x78787878, 0x7d7d7d7d>(F.lds, (const char*)(F.w<bf16>(WS_ACT)), 512, S, E); }
    xcd_barrier(bar);
    REP(10) p10_final(F);
}

#ifndef PROBE_PH
#define PROBE_PH -1
#endif
#if PROBE_PH >= 0
__global__ void __launch_bounds__(NWAVES * 64, 2) probe_kernel(Args args) {
    extern __shared__ __attribute__((aligned(16))) unsigned char lds[];
    Frame F; F.lds = (LAS unsigned char*)lds; F.tid = threadIdx.x; F.lane = F.tid & 63; F.wave = __builtin_amdgcn_readfirstlane(F.tid >> 6);
    F.G = gridDim.x; F.gw = blockIdx.x * NWAVES + F.wave; F.ngw = F.G * NWAVES; F.ws = args.ws;
    if (PROBE_PH == 0) p0_prologue(F);
    if (PROBE_PH == 2) { p2_pooled(F); p2_scores_select(F); }
    if (PROBE_PH == 3) p3_select(F);
    if (PROBE_PH == 4) p4_attn_gather(F);
    if (PROBE_PH == 10) p10_final(F);
    if (PROBE_PH == 20) p2_scores_select(F);
    if (PROBE_PH == 21) p2_pooled(F);
    const int bx = (int)blockIdx.x;
    if (PROBE_PH == 1) {
      { pg8::DenseSched S; S.init(NTOK, 1024, 1024, F.w<bf16>(WS_WINI), F.G, bx);
        EpiInProj<true> E{F.w<bf16>(WS_ZPOOL), F.w<bf16>(WS_Q), F.w<bf16>(WS_K), F.w<bf16>(WS_V), F.w<bf16>(WS_QI), F.w<bf16>(WS_KI), F.w<bf16>(WS_GATE), F.w<float>(WS_WI)};
        pg8::gemm_phase<EpiInProj<true>, pg8::DenseSched, true>(F.lds, (const char*)F.w<bf16>(WS_H), 1024, S, E); }
      { pg8::DenseSched S; S.init(NTOK, 3584, 512, F.w<bf16>(WS_WIN), F.G, bx, 1);
        EpiInProj<false> E{F.w<bf16>(WS_ZPOOL), F.w<bf16>(WS_Q), F.w<bf16>(WS_K), F.w<bf16>(WS_V), F.w<bf16>(WS_QI), F.w<bf16>(WS_KI), F.w<bf16>(WS_GATE), F.w<float>(WS_WI)};
        pg8::gemm_phase<EpiInProj<false>, pg8::DenseSched, true, true, 0x78787878, 0x7c7c7c7c>(F.lds, (const char*)F.w<bf16>(WS_H8X), 512, S, E); } }
    if (PROBE_PH == 6) { pg8::DenseSched S; S.init(NTOK, 1024, 1024, F.w<bf16>(WS_WOUT), F.G, bx);
      EpiResidual E{F.in(IN_X), F.w<bf16>(WS_X1)};
      pg8::gemm_phase<EpiResidual, pg8::DenseSched, true>(F.lds, (const char*)F.w<bf16>(WS_MERGED), 1024, S, E); }
    if (PROBE_PH == 7) p7_router(F);
    if (PROBE_PH == 8) { build_moe_tab(F); moe_gather_fill(F, F.w<int>(WS_LIST), F.in(IN_B1)); MoeSched1 S{(const LAS int*)(F.lds + TAB_OFF), (const LAS int*)(F.lds + TAB_OFF + 4096), (const char*)F.w<bf16>(WS_W1), F.G, bx};
      EpiSwiGLU E{F.w<unsigned char>(WS_ACT), (const LAS float*)(F.lds + BIAS_OFF)};
      pg8::gemm_phase<EpiSwiGLU, MoeSched1, true, true, 0x78787878, 0x7c7c7c7c>(F.lds, (const char*)F.w<bf16>(WS_H), 512, S, E); }
    if (PROBE_PH == 9) { build_moe_tab(F); moe_rows_fill(F, F.w<int>(WS_LIST), F.w<float>(WS_TOKGATE), F.in(IN_B2)); MoeSched2 S{(const LAS int*)(F.lds + TAB_OFF), (const char*)F.w<bf16>(WS_W2), F.G, bx};
      EpiMoeOut E{F.w<unsigned char>(WS_YS), (const LAS float*)(F.lds + BIAS_OFF), (const LAS int*)(F.lds + TAB_OFF + 4096)};
      pg8::gemm_phase<EpiMoeOut, MoeSched2, true, true, 0x78787878, 0x7d7d7d7d>(F.lds, (const char*)F.w<bf16>(WS_ACT), 512, S, E); }
    if (PROBE_PH == 40) p4_attn_dense(F, (char*)lds);
    if (PROBE_PH == 99) { }
}
#endif

extern "C" void kernel_launch(void* const* d_in, const int* in_sizes, int n_in, void* d_out, int out_size, void* d_ws, size_t ws_size, hipStream_t stream) {
    static int grid = 0;
    if (grid == 0) {
        if (n_in != 17 || in_sizes[0] != NTOK * D || out_size != NTOK * D || ws_size < WS_END) { fprintf(stderr, "kernel_launch: unexpected problem shape (n_in %d, in0 %d, out %d, ws %zu)\n", n_in, n_in > 0 ? in_sizes[0] : -1, out_size, ws_size); grid = -1; return; }
        int dev = 0, cus = 0, per_cu = 0;
        if (hipGetDevice(&dev) != hipSuccess || hipDeviceGetAttribute(&cus, hipDeviceAttributeMultiprocessorCount, dev) != hipSuccess) { grid = -1; return; }
        if (hipFuncSetAttribute((const void*)fwd_kernel, hipFuncAttributeMaxDynamicSharedMemorySize, LDS_BYTES) != hipSuccess) { fprintf(stderr, "kernel_launch: hipFuncSetAttribute failed\n"); grid = -1; return; }
        if (hipOccupancyMaxActiveBlocksPerMultiprocessor(&per_cu, (const void*)fwd_kernel, NWAVES * 64, LDS_BYTES) != hipSuccess || per_cu < 1) fprintf(stderr, "kernel_launch: occupancy query reports %d\n", per_cu);
#if PROBE_PH >= 0
        (void)hipFuncSetAttribute((const void*)probe_kernel, hipFuncAttributeMaxDynamicSharedMemorySize, LDS_BYTES);
#endif
        (void)hipGetLastError();
        grid = cus;
    }
    if (grid < 0) return;
    if (hipMemsetAsync((char*)d_ws + WS_CTL, 0, CTL_ZERO_BYTES, stream) != hipSuccess) return;
    Args a{};
    for (int i = 0; i < 17; ++i) a.in[i] = (const float*)d_in[i];
    a.out = (float*)d_out; a.ws = (unsigned char*)d_ws;
    hipLaunchKernelGGL(fwd_kernel, dim3(grid), dim3(NWAVES * 64), LDS_BYTES, stream, a);
#if PROBE_PH >= 0
    hipLaunchKernelGGL(probe_kernel, dim3(grid), dim3(NWAVES * 64), LDS_BYTES, stream, a);
#endif
}
```

```cpp
#include <hip/hip_runtime.h>
#include <cstdio>
#include <cstdint>
#include <hip/hip_bf16.h>
#include <cmath>
#ifndef DUP
#define DUP 0
#endif
#define REP(k) for (int rep_ = 0; rep_ < 1 + ((DUP >> (k)) & 1); ++rep_)

#define LAS __attribute__((address_space(3)))
#define GAS __attribute__((address_space(1)))
typedef unsigned short bf16;
typedef short bf16x8 __attribute__((ext_vector_type(8)));
typedef float f32x4 __attribute__((ext_vector_type(4)));
typedef float f32x2 __attribute__((ext_vector_type(2)));
typedef float f32x16 __attribute__((ext_vector_type(16)));
typedef unsigned u32x4 __attribute__((ext_vector_type(4)));
typedef unsigned u32x2 __attribute__((ext_vector_type(2)));
typedef unsigned long long u64;

constexpr int NB = 4, SEQ = 4096, NTOK = NB * SEQ, D = 1024;
constexpr int DIN = 4420, DINP = 4608;
constexpr int NE = 32, DFF = 1024, TOPK = 256;
constexpr float RMS_EPS = 1e-5f;
constexpr float LOG2E = 1.4426950408889634f;
constexpr float QSCALE = 0.125f * LOG2E;
constexpr int ACT_ROWS = 73728;
constexpr int NWAVES = 8;

constexpr size_t MiB = 1u << 20;
constexpr size_t WS_CTL = 0, CTL_ZERO_BYTES = 96 * 1024;
constexpr size_t WS_WIN = 2 * MiB;
constexpr size_t WS_WINI = 6 * MiB;
constexpr size_t WS_H8X = 80 * MiB;
constexpr size_t WS_WPC = 11 * MiB;
constexpr size_t WS_WBA = 12 * MiB;
constexpr size_t WS_WOUT = 13 * MiB;
constexpr size_t WS_W1 = 16 * MiB;
constexpr size_t WS_W2 = 144 * MiB;
constexpr size_t WS_H = 208 * MiB;
constexpr size_t WS_ZPOOL = 240 * MiB;
constexpr size_t WS_Q = 256 * MiB, WS_K = 272 * MiB, WS_V = 288 * MiB;
constexpr size_t WS_QI = 304 * MiB;
constexpr size_t WS_KI = 312 * MiB;
constexpr size_t WS_WI = 314 * MiB;
constexpr size_t WS_GATE = 316 * MiB;
constexpr size_t WS_POOLED = 380 * MiB;
constexpr size_t WS_AO = 396 * MiB;
constexpr size_t WS_MERGED = 412 * MiB;
constexpr size_t WS_X1 = 444 * MiB;
constexpr size_t WS_SC = 508 * MiB;
constexpr size_t WS_YS = 508 * MiB;
constexpr size_t WS_MASK = 764 * MiB;
constexpr size_t WS_SELIDX = 772 * MiB;
constexpr size_t WS_TOKGATE = 788 * MiB;
constexpr size_t WS_LIST = 790 * MiB;
constexpr size_t WS_ACT = 792 * MiB;
constexpr size_t WS_END = 936 * MiB;
constexpr int CW_BAR = 4096;
constexpr int CW_ECNT = 16384;
constexpr int CW_PANA = 18432, CW_PANB = 20480, CW_PANC = 22528;

constexpr int RING_BYTES = 131072;
constexpr int LDSCTL_OFF = RING_BYTES, MISC_OFF = LDSCTL_OFF + 320;
constexpr int TAB_OFF = RING_BYTES + 1024;
constexpr int LDS_BYTES = 163840;
constexpr int BIAS_OFF = TAB_OFF + 14336;

#define RLX_AGENT __ATOMIC_RELAXED, __HIP_MEMORY_SCOPE_AGENT
#define LDS_WAIT() asm volatile("s_waitcnt lgkmcnt(0)" ::: "memory")
#define VM_WAIT() asm volatile("s_waitcnt vmcnt(0)" ::: "memory")
__device__ __forceinline__ unsigned f2bf(float f) { unsigned u = __builtin_bit_cast(unsigned, f); return (u + 0x7fffu + ((u >> 16) & 1u)) >> 16; }
__device__ __forceinline__ unsigned pk2(float lo, float hi) { return f2bf(lo) | (f2bf(hi) << 16); }
__device__ __forceinline__ float bflo(unsigned w) { return __uint_as_float(w << 16); }
__device__ __forceinline__ float bfhi(unsigned w) { return __uint_as_float(w & 0xffff0000u); }
__device__ __forceinline__ unsigned cvt_pk_bf16(float lo, float hi) { unsigned r; asm volatile("v_cvt_pk_bf16_f32 %0, %1, %2" : "=v"(r) : "v"(lo), "v"(hi)); return r; }
#define DPPF(v, ctrl, rmask) __int_as_float(__builtin_amdgcn_update_dpp(0, __float_as_int(v), ctrl, rmask, 0xf, false))
#define DPPU(v, ctrl, rmask) ((unsigned)__builtin_amdgcn_update_dpp(0, (int)(v), ctrl, rmask, 0xf, false))
__device__ __forceinline__ float wave_sum(float v) {
    v += DPPF(v, 0x111, 0xf); v += DPPF(v, 0x112, 0xf); v += DPPF(v, 0x114, 0xf); v += DPPF(v, 0x118, 0xf); v += DPPF(v, 0x142, 0xa); v += DPPF(v, 0x143, 0xc);
    return __int_as_float(__builtin_amdgcn_readlane(__float_as_int(v), 63));
}
__device__ __forceinline__ unsigned wave_max_u32(unsigned v) {
    v = max(v, DPPU(v, 0x111, 0xf)); v = max(v, DPPU(v, 0x112, 0xf)); v = max(v, DPPU(v, 0x114, 0xf)); v = max(v, DPPU(v, 0x118, 0xf)); v = max(v, DPPU(v, 0x142, 0xa)); v = max(v, DPPU(v, 0x143, 0xc));
    return (unsigned)__builtin_amdgcn_readlane((int)v, 63);
}
__device__ __forceinline__ float sigmoidf_(float x) { return __builtin_amdgcn_rcpf(1.0f + __builtin_amdgcn_exp2f(x * -1.4426950408889634f)); }

namespace pg8 {
constexpr int BM = 256, BK = 64, HALF = 128, HTB = HALF * BK * 2, STAGE_BYTES = 8 * HTB, NXCD = 8, WGM = 8;
__host__ __device__ __forceinline__ int lds_byte(int r, int c) { const int st = (r >> 4) * 2 + (c >> 5), rr = r & 15, cc = c & 31, ob = rr * 64 + cc * 2; return st * 1024 + (ob ^ (((ob >> 9) & 1) << 5)); }
__host__ __device__ __forceinline__ void stage_rc(int b, int& R, int& C) { const int st = b / 1024, sb = b % 1024, swz = sb ^ (((sb >> 9) & 1) << 5); R = (st >> 1) * 16 + swz / 64; C = (st & 1) * 32 + (swz % 64) / 2; }
__host__ __device__ __forceinline__ int perm32(int rho) { const int n = rho >> 4, i = rho & 15; return 8 * (i >> 2) + 4 * n + (i & 3); }

struct LaneRC { int R[2], C[2]; };
struct Unit { unsigned aoff[2][2]; const char* b0; const char* b1; int row0; int pn; int aux; int aux2; int aux3; int raw; };

__device__ __forceinline__ int xcd_remap(int L, int nwg) { const int q = nwg / NXCD, r = nwg % NXCD, xcd = L % NXCD, off = L / NXCD; return (xcd < r ? xcd * (q + 1) : r * (q + 1) + (xcd - r) * q) + off; }

struct DenseSched {
    int nM, nN, nwg, G, c, K; const char* Bt;
    __device__ __forceinline__ void init(int M, int N, int K_, const void* Bt_, int G_, int c_, int split_ = 0) { nM = M / BM; nN = N / BM; nwg = nM * nN; G = G_; c = c_; K = K_; Bt = (const char*)Bt_; split = (split_ && G_ == 256 && nwg == 896) ? 1 : 0; }
    int split;
    __device__ __forceinline__ bool next(int i, Unit& u, const LaneRC& rc) const {
        long L = (long)i * G + c;
        if (split) { if (i >= 3) { if (c < 128 || i >= 4) return false; L = 768 + (c - 128); } }
        if (L >= nwg) return false;
        const int wgid = xcd_remap((int)L, nwg);
        const int nig = WGM * nN, gid = wgid / nig, fm = gid * WGM, gsz = (nM - fm) < WGM ? (nM - fm) : WGM;
        const int pm = fm + ((wgid % nig) % gsz), pn = (wgid % nig) / gsz;
#pragma unroll
        for (int h = 0; h < 2; ++h)
#pragma unroll
            for (int i2 = 0; i2 < 2; ++i2) u.aoff[h][i2] = (unsigned)((pm * BM + h * HALF + rc.R[i2]) * K + rc.C[i2]) * 2u;
        u.b0 = Bt + (size_t)pn * BM * K * 2; u.b1 = u.b0 + (size_t)HALF * K * 2; u.row0 = pm * BM; u.pn = pn; u.aux = 0; u.aux2 = 0; u.aux3 = 0; u.raw = 0; return true;
    }
    __device__ __forceinline__ void finish(Unit&, const LaneRC&) const {}
    __device__ __forceinline__ bool unit_pm(int i, int& pm) const {
        long L = (long)i * G + c;
        if (split) { if (i >= 3) { if (c < 128 || i >= 4) return false; L = 768 + (c - 128); } }
        if (L >= nwg) return false;
        const int wgid = xcd_remap((int)L, nwg);
        const int nig = WGM * nN, gid = wgid / nig, fm = gid * WGM, gsz = (nM - fm) < WGM ? (nM - fm) : WGM;
        pm = fm + ((wgid % nig) % gsz); return true;
    }
};

typedef int i32x8 __attribute__((ext_vector_type(8))); typedef int i32x4 __attribute__((ext_vector_type(4)));
template <bool FP8> struct FragT;
template <> struct FragT<false> { struct type { bf16x8 k[2]; };
    static __device__ __forceinline__ void load(type& d, const LAS unsigned char* p) { d.k[0] = *(const LAS bf16x8*)p; d.k[1] = *(const LAS bf16x8*)(p + 1024); }
    static __device__ __forceinline__ f32x4 mma16(const type& b, const type& a, f32x4 c, int k) { return __builtin_amdgcn_mfma_f32_16x16x32_bf16(b.k[k], a.k[k], c, 0, 0, 0); }
    static __device__ __forceinline__ f32x4 mma8(const type&, const type&, f32x4 c, int, int) { return c; } };
template <> struct FragT<true> { typedef i32x8 type;
    static __device__ __forceinline__ void load(type& d, const LAS unsigned char* p) { const i32x4 lo = *(const LAS i32x4*)p, hi = *(const LAS i32x4*)(p + 1024); d = __builtin_shufflevector(lo, hi, 0, 1, 2, 3, 4, 5, 6, 7); }
    static __device__ __forceinline__ f32x4 mma16(const type&, const type&, f32x4 c, int) { return c; }
    static __device__ __forceinline__ f32x4 mma8(const type& b, const type& a, f32x4 c, int scw, int sca) { asm volatile("v_mfma_scale_f32_16x16x128_f8f6f4 %0, %1, %2, %0, %3, %4 op_sel_hi:[0,0,0]" : "+v"(c) : "v"(b), "v"(a), "v"(scw), "v"(sca)); return c; } };
template <class Epi, class Sched, bool ALIGN_EPI, bool FP8 = false, int SCW = 0x7f7f7f7f, int SCA = 0x7f7f7f7f>
__device__ __forceinline__ void gemm_phase(LAS unsigned char* lds, const char* gA, const int K, const Sched& S, const Epi& E) {
    int tid_ = threadIdx.x; asm volatile("" : "+v"(tid_));
    const int tid = tid_, wid = __builtin_amdgcn_readfirstlane(tid >> 6), lane = tid & 63, wr = wid >> 2, wc = wid & 3, fr = lane & 15, fq = lane >> 4;
    const int nt = K / BK;
    LaneRC rc; unsigned voffB[2];
#pragma unroll
    for (int i = 0; i < 2; ++i) { int R, C; stage_rc(tid * 16 + i * 8192, R, C); rc.R[i] = R; rc.C[i] = C; const int Rb = Epi::PERM ? ((R & ~31) + perm32(R & 31)) : R; voffB[i] = (unsigned)(Rb * K + C) * 2u; }
    const size_t kstep = (size_t)(BK * 2);
    const unsigned ldsw = (unsigned)wid * 1024u;
    const int aoff = lds_byte(wr * 64 + fr, fq * 8), boff = lds_byte(wc * 32 + fr, fq * 8);
#define PG8_SA(b, h) (((b) * 2 + (h)) * HTB)
#define PG8_SB(b, h) ((4 + (b) * 2 + (h)) * HTB)
#define PG8_STAGE(bufoff, gbase, voff) do { _Pragma("unroll") for (int _i = 0; _i < 2; ++_i) \
        __builtin_amdgcn_global_load_lds((const unsigned*)((const char*)(gbase) + (voff)[_i]), (LAS unsigned*)(lds + (bufoff) + ldsw + _i * 8192), 16, 0, 0); } while (0)
#define PG8_LDA(dst, b, h) do { _Pragma("unroll") for (int m = 0; m < 4; ++m) FragT<FP8>::load(dst[m], lds + PG8_SA(b, h) + aoff + m * 2048); } while (0)
#define PG8_LDB(dst, b, h) do { _Pragma("unroll") for (int n = 0; n < 2; ++n) FragT<FP8>::load(dst[n], lds + PG8_SB(b, h) + boff + n * 2048); } while (0)
#define PG8_MMA(ai, bj, At, Bt) do { __builtin_amdgcn_s_setprio(1); \
        if constexpr (FP8) { _Pragma("unroll") for (int m = 0; m < 4; ++m) _Pragma("unroll") for (int n = 0; n < 2; ++n) \
            acc[ai][bj][m][n] = FragT<FP8>::mma8(Bt[n], At[m], acc[ai][bj][m][n], SCW, SCA); } \
        else { _Pragma("unroll") for (int m = 0; m < 4; ++m) _Pragma("unroll") for (int n = 0; n < 2; ++n) _Pragma("unroll") for (int k = 0; k < 2; ++k) \
            acc[ai][bj][m][n] = FragT<FP8>::mma16(Bt[n], At[m], acc[ai][bj][m][n], k); } \
        __builtin_amdgcn_s_setprio(0); } while (0)
#define PG8_WAIT_V(n) asm volatile("s_waitcnt vmcnt(" #n ")" ::: "memory")
#define PG8_WAIT_L(n) asm volatile("s_waitcnt lgkmcnt(" #n ")" ::: "memory")
#define PG8_BAR __builtin_amdgcn_s_barrier()
#define PG8_SCHED __builtin_amdgcn_sched_barrier(0)
    Unit cur, nxt; int ui = 0;
    if (!S.next(0, cur, rc)) return;
    S.finish(cur, rc);
    f32x4 acc[2][2][4][2];
#pragma unroll
    for (int a = 0; a < 2; ++a)
#pragma unroll
        for (int b = 0; b < 2; ++b)
#pragma unroll
            for (int m = 0; m < 4; ++m)
#pragma unroll
                for (int n = 0; n < 2; ++n) acc[a][b][m][n] = (f32x4){0.f, 0.f, 0.f, 0.f};
    typedef typename FragT<FP8>::type frag_t;
    frag_t At[4], B0[2], B1[2];
    PG8_STAGE(PG8_SB(0, 0), cur.b0, voffB); PG8_STAGE(PG8_SB(0, 1), cur.b1, voffB); PG8_STAGE(PG8_SA(0, 0), gA, cur.aoff[0]); PG8_STAGE(PG8_SA(0, 1), gA, cur.aoff[1]);
    if (wr == 1) PG8_BAR;
    PG8_WAIT_V(2); PG8_BAR;
    PG8_STAGE(PG8_SB(1, 0), cur.b0 + kstep, voffB); PG8_STAGE(PG8_SA(1, 0), gA + kstep, cur.aoff[0]); PG8_STAGE(PG8_SB(1, 1), cur.b1 + kstep, voffB);
    PG8_WAIT_V(6); PG8_BAR;
    for (;;) {
        const bool has_next = S.next(ui + 1, nxt, rc);
        if (!has_next) nxt = cur;
#define PG8_TRIP(A1, A2, AO2, B2_0, B2_1) do { \
            const char* a1 = (A1); const char* a2 = (A2); const char* b2_0 = (B2_0); const char* b2_1 = (B2_1); const char* a3 = a2 + kstep; const char* b3_0 = b2_0 + kstep; const char* b3_1 = b2_1 + kstep; \
              \
            PG8_LDB(B0, 0, 0); PG8_LDB(B1, 0, 1); PG8_SCHED; PG8_LDA(At, 0, 0); PG8_STAGE(PG8_SA(1, 1), a1, cur.aoff[1]); \
            PG8_WAIT_V(8); PG8_WAIT_L(0); PG8_BAR; PG8_MMA(0, 0, At, B0); PG8_MMA(0, 1, At, B1); PG8_BAR; PG8_SCHED; \
              \
            PG8_LDA(At, 0, 1); PG8_STAGE(PG8_SB(0, 0), b2_0, voffB); PG8_STAGE(PG8_SB(0, 1), b2_1, voffB); PG8_STAGE(PG8_SA(0, 0), a2, (AO2)[0]); \
            PG8_WAIT_V(8); PG8_WAIT_L(0); PG8_BAR; PG8_MMA(1, 0, At, B0); PG8_MMA(1, 1, At, B1); PG8_BAR; PG8_SCHED; \
              \
            PG8_LDB(B0, 1, 0); PG8_LDB(B1, 1, 1); PG8_SCHED; PG8_LDA(At, 1, 0); PG8_STAGE(PG8_SA(0, 1), a2, (AO2)[1]); \
            PG8_WAIT_V(8); PG8_WAIT_L(0); PG8_BAR; PG8_MMA(0, 0, At, B0); PG8_MMA(0, 1, At, B1); PG8_BAR; PG8_SCHED; \
              \
            PG8_LDA(At, 1, 1); PG8_STAGE(PG8_SB(1, 0), b3_0, voffB); PG8_STAGE(PG8_SB(1, 1), b3_1, voffB); PG8_STAGE(PG8_SA(1, 0), a3, (AO2)[0]); \
            PG8_WAIT_V(8); PG8_WAIT_L(0); PG8_BAR; PG8_MMA(1, 0, At, B0); PG8_MMA(1, 1, At, B1); PG8_BAR; PG8_SCHED; } while (0)
#pragma unroll 1
        for (int t = 0; t < nt; t += 2) {
            const bool last = (t == nt - 2);
            unsigned ao2[2][2];
#pragma unroll
            for (int h = 0; h < 2; ++h)
#pragma unroll
                for (int i2 = 0; i2 < 2; ++i2) ao2[h][i2] = last ? nxt.aoff[h][i2] : cur.aoff[h][i2];
            PG8_TRIP(gA + (size_t)(t + 1) * kstep, last ? gA : gA + (size_t)(t + 2) * kstep, ao2, last ? nxt.b0 : cur.b0 + (size_t)(t + 2) * kstep, last ? nxt.b1 : cur.b1 + (size_t)(t + 2) * kstep);
        }
        if constexpr (ALIGN_EPI) { if (wr == 0) PG8_BAR; }
        if constexpr (FP8) asm volatile("s_nop 15\n\ts_nop 7" ::: "memory");
        E(acc, cur, wr, wc, fr, fq);
        if (!has_next) break;
#pragma unroll
        for (int a = 0; a < 2; ++a)
#pragma unroll
            for (int b = 0; b < 2; ++b)
#pragma unroll
                for (int m = 0; m < 4; ++m)
#pragma unroll
                    for (int n = 0; n < 2; ++n) acc[a][b][m][n] = (f32x4){0.f, 0.f, 0.f, 0.f};
        cur = nxt; ++ui;
        if constexpr (ALIGN_EPI) { if (wr == 1) PG8_BAR; }
    }
    PG8_WAIT_V(0);
    if constexpr (!ALIGN_EPI) { if (wr == 0) PG8_BAR; }
    PG8_BAR;
#undef PG8_SA
#undef PG8_SB
#undef PG8_STAGE
#undef PG8_LDA
#undef PG8_LDB
#undef PG8_MMA
#undef PG8_TRIP
#undef PG8_WAIT_V
#undef PG8_WAIT_L
#undef PG8_BAR
#undef PG8_SCHED
}
}

#define XB_TMO      128
#define XB_XCNT(j)  (256  + 64 * (j))
#define XB_XSUB(j)  (1280 + 64 * (j))
#define XB_XGEN(j)  (2304 + 64 * (j))
#define XB_TOP      3328
#define XB_TOPGEN   3392
#define XCD_BAR_WORDS 3456
#define XB_SPIN_CAP (1u << 18)
__device__ __forceinline__ unsigned xb_ld(unsigned* p)              { return __hip_atomic_load(p, __ATOMIC_RELAXED, __HIP_MEMORY_SCOPE_AGENT); }
__device__ __forceinline__ unsigned xb_add(unsigned* p, unsigned v) { return __hip_atomic_fetch_add(p, v, __ATOMIC_RELAXED, __HIP_MEMORY_SCOPE_AGENT); }
__device__ __forceinline__ unsigned xb_xcc_id() { return (unsigned)__builtin_amdgcn_s_getreg((3 << 11) | 20) & 0xFu; }
#define XB_SPIN(cond, bar) do { unsigned _sp = 0; while (cond) { __builtin_amdgcn_s_sleep(1); \
    if ((++_sp & 255u) == 0u) { if (xb_ld(&(bar)[XB_TMO])) break; if (_sp > XB_SPIN_CAP) { atomicAdd(&(bar)[XB_TMO], 1u); break; } } } } while (0)
struct XcdBarrier { unsigned* bar; unsigned x; volatile LAS unsigned* st; };
__device__ __forceinline__ XcdBarrier xcd_barrier_post(unsigned* bar, volatile LAS unsigned* st) {
    XcdBarrier b; b.bar = bar; b.x = xb_xcc_id(); b.st = st;
    if (threadIdx.x == 0) (void)xb_add(&bar[XB_XCNT(b.x)], 1u);
    return b;
}
__device__ __forceinline__ void xcd_barrier_complete(unsigned* bar, unsigned x, unsigned& nloc, unsigned& nx) {
    const unsigned G = gridDim.x * gridDim.y * gridDim.z;
    unsigned sum, cnt, mine, sp = 0u;
    for (;;) {
        sum = 0u; cnt = 0u; mine = 0u;
#pragma unroll
        for (unsigned j = 0; j < 16; ++j) { const unsigned c = xb_ld(&bar[XB_XCNT(j)]); sum += c; cnt += (c > 0u) ? 1u : 0u; mine = (j == x) ? c : mine; }
        if (sum == G) break;
        __builtin_amdgcn_s_sleep(1);
        if ((++sp & 255u) == 0u) { if (xb_ld(&bar[XB_TMO])) break; if (sp > XB_SPIN_CAP) { atomicAdd(&bar[XB_TMO], 1u); break; } }
    }
    nloc = mine > 0u ? mine : 1u; nx = cnt > 0u ? cnt : 1u;
}
__device__ __forceinline__ void xcd_barrier(const XcdBarrier& b) {
    asm volatile("s_waitcnt vmcnt(0)" ::: "memory");
    __syncthreads();
    if (threadIdx.x == 0) {
        unsigned* bar = b.bar;
        __builtin_amdgcn_s_waitcnt(0);
        unsigned nloc = b.st[0], nx = b.st[1];
        if (nloc == 0u) { xcd_barrier_complete(bar, b.x, nloc, nx); b.st[0] = nloc; b.st[1] = nx; }
        const unsigned old = xb_add(&bar[XB_XSUB(b.x)], 1u);
        const unsigned gen = old / nloc;
        if (old + 1u == (gen + 1u) * nloc) {
            __builtin_amdgcn_fence(__ATOMIC_RELEASE, "agent");
            asm volatile("s_waitcnt vmcnt(0)" ::: "memory");
            const unsigned og = xb_add(&bar[XB_TOP], 1u);
            const unsigned tg = og / nx;
            if (og + 1u == (tg + 1u) * nx) xb_add(&bar[XB_TOPGEN], 1u);
            else XB_SPIN(xb_ld(&bar[XB_TOPGEN]) == tg, bar);
            __builtin_amdgcn_fence(__ATOMIC_ACQUIRE, "agent");
            xb_add(&bar[XB_XGEN(b.x)], 1u);
            asm volatile("s_waitcnt vmcnt(0)" ::: "memory");
        } else {
            XB_SPIN(xb_ld(&bar[XB_XGEN(b.x)]) == gen, bar);
            __builtin_amdgcn_fence(__ATOMIC_ACQUIRE, "agent");
            asm volatile("s_waitcnt vmcnt(0)" ::: "memory");
        }
    }
    __syncthreads();
}

namespace attn_body {
using bf16=__hip_bfloat16;
using bf16x8=__attribute__((ext_vector_type(8)))short;
using s16x4=__attribute__((ext_vector_type(4)))short;
using f32x16=__attribute__((ext_vector_type(16)))float;
using u32x4=__attribute__((ext_vector_type(4)))unsigned;
using u32x2v=__attribute__((ext_vector_type(2)))unsigned;
constexpr float AO_PRESCALE=128.0f;
constexpr int BATCH=4,NHEAD=8,SEQ=4096,D=64,DM=NHEAD*D;
constexpr int NW=8,QBLK=32,QB=QBLK*NW,KVBLK=64,NQB=SEQ/QB;
constexpr int ATTN_PITCH=DM, ATTN_UNIT_ROWS=QB;
__device__ __forceinline__ int crow(int r,int hi){return (r&3)+8*(r>>2)+4*hi;}
#define SBAR() __builtin_amdgcn_sched_barrier(0)
__device__ __forceinline__ void amask(f32x16&p0,f32x16&p1,const u32x2v mk,int hi){
  const unsigned a=mk.x>>(2*hi), b=mk.y>>(2*hi); const unsigned NEGI=0xff800000u;
  #define AM1(r,src) { int m0_,m1_; asm("v_bfe_i32 %0, %1, %2, 1":"=v"(m0_):"v"(src),"n"((((r)&3)>>1)+4*((r)>>2))); asm("v_bfe_i32 %0, %1, %2, 1":"=v"(m1_):"v"(src),"n"((((r)&3)>>1)+4*((r)>>2)+16)); \
      float x0_=p0[r],x1_=p1[r]; asm("v_bfi_b32 %0, %1, %2, %3":"=v"(x0_):"v"(m0_),"v"(x0_),"s"(NEGI)); asm("v_bfi_b32 %0, %1, %2, %3":"=v"(x1_):"v"(m1_),"v"(x1_),"s"(NEGI)); p0[r]=x0_; p1[r]=x1_; }
  AM1(0,a) AM1(1,b) AM1(2,a) AM1(3,b) AM1(4,a) AM1(5,b) AM1(6,a) AM1(7,b) AM1(8,a) AM1(9,b) AM1(10,a) AM1(11,b) AM1(12,a) AM1(13,b) AM1(14,a) AM1(15,b)
  #undef AM1
}
__device__ __forceinline__ void abias(f32x16&p0,f32x16&p1,int jb,int qrel,int hi,const __attribute__((address_space(3))) float*lut){
  const int d00=qrel+128-64*jb-4*hi;
  #pragma unroll
  for(int r=0;r<16;++r){ const int d0=d00-((r&3)+8*(r>>2)); const unsigned i0=(unsigned)d0<127u?(unsigned)d0:127u; const unsigned i1=(unsigned)(d0-32)<127u?(unsigned)(d0-32):127u;
    p0[r]+=lut[i0]; p1[r]+=lut[i1]; }
}

constexpr int NSLOT=3, SLOTB=8192;
constexpr int LDS_K=0, LDS_V=NSLOT*SLOTB, LDS_WS=2*NSLOT*SLOTB, LDS_OST=LDS_WS+NW*64*4, LDS_MK=LDS_OST+NW*4096, LDS_BYTES=LDS_MK+NW*512;
constexpr float C2=0.125f*1.4426950408889634f;
__device__ __forceinline__ void glds16(const void*gsrc,unsigned lds_dst){unsigned keep;
  asm volatile("s_mov_b32 %0, m0\n\ts_mov_b32 m0, %2\n\ts_nop 0\n\tglobal_load_lds_dwordx4 %1, off\n\ts_mov_b32 m0, %0":"=&s"(keep):"v"(gsrc),"s"(lds_dst):"memory");}
__device__ __forceinline__ void glds4(const void*gsrc,unsigned lds_dst){unsigned keep;
  asm volatile("s_mov_b32 %0, m0\n\ts_mov_b32 m0, %2\n\ts_nop 0\n\tglobal_load_lds_dword %1, off\n\ts_mov_b32 m0, %0":"=&s"(keep):"v"(gsrc),"s"(lds_dst):"memory");}
__device__ __forceinline__ float max3f(float a,float b,float c){float r;asm("v_max3_f32 %0, %1, %2, %3":"=v"(r):"v"(a),"v"(b),"v"(c));return r;}
__device__ __forceinline__ float max2f(float a,float b){float r;asm("v_max_f32_e32 %0, %1, %2":"=v"(r):"v"(a),"v"(b));return r;}
__device__ __forceinline__ float fadd_s(float a,float b){float r;asm("v_add_f32_e32 %0, %1, %2":"=v"(r):"v"(a),"v"(b));return r;}
__device__ __forceinline__ float fsub_s(float a,float b){float r;asm("v_sub_f32_e32 %0, %1, %2":"=v"(r):"v"(a),"v"(b));return r;}
typedef float f32x2_t __attribute__((ext_vector_type(2))); typedef __bf16 bf16x2_t __attribute__((ext_vector_type(2)));
__device__ __forceinline__ unsigned cvtpk_s(float lo,float hi){f32x2_t v={lo,hi};bf16x2_t b=__builtin_convertvector(v,bf16x2_t);return __builtin_bit_cast(unsigned,b);}
#define WAIT_BAR(N) asm volatile("s_waitcnt vmcnt(" #N ") lgkmcnt(0)\n\ts_barrier":::"memory")

__device__ __forceinline__ void qkt(f32x16&p0,f32x16&p1,const char*Kslot,const bf16x8*qr,const f32x16&negm,int r32,int hi){
  const char*kb=Kslot+hi*1024+r32*16;
  #pragma unroll
  for(int d0=0;d0<4;++d0){
    const bf16x8 b0=*reinterpret_cast<const bf16x8*>(kb+d0*2048);
    const bf16x8 b1=*reinterpret_cast<const bf16x8*>(kb+d0*2048+512);
    if(d0==0){p0=__builtin_amdgcn_mfma_f32_32x32x16_bf16(b0,qr[0],negm,0,0,0);p1=__builtin_amdgcn_mfma_f32_32x32x16_bf16(b1,qr[0],negm,0,0,0);}
    else{p0=__builtin_amdgcn_mfma_f32_32x32x16_bf16(b0,qr[d0],p0,0,0,0);p1=__builtin_amdgcn_mfma_f32_32x32x16_bf16(b1,qr[d0],p1,0,0,0);}}
}
typedef __attribute__((address_space(3))) const char* lds_cptr;
typedef short v4i16_t __attribute__((ext_vector_type(4)));
__device__ __forceinline__ void kload8(bf16x8*kf,lds_cptr kp){
  kf[0]=*(const __attribute__((address_space(3))) bf16x8*)(kp);      kf[1]=*(const __attribute__((address_space(3))) bf16x8*)(kp+512);
  kf[2]=*(const __attribute__((address_space(3))) bf16x8*)(kp+2048); kf[3]=*(const __attribute__((address_space(3))) bf16x8*)(kp+2560);
  kf[4]=*(const __attribute__((address_space(3))) bf16x8*)(kp+4096); kf[5]=*(const __attribute__((address_space(3))) bf16x8*)(kp+4608);
  kf[6]=*(const __attribute__((address_space(3))) bf16x8*)(kp+6144); kf[7]=*(const __attribute__((address_space(3))) bf16x8*)(kp+6656);
}
__device__ __forceinline__ void kload2(bf16x8*kf,lds_cptr kp,int j){ kf[2*j]=*(const __attribute__((address_space(3))) bf16x8*)(kp+j*2048); kf[2*j+1]=*(const __attribute__((address_space(3))) bf16x8*)(kp+j*2048+512); }
__device__ __forceinline__ s16x4 vtr(lds_cptr p){ return __builtin_bit_cast(s16x4,__builtin_amdgcn_ds_read_tr16_b64_v4i16((__attribute__((address_space(3))) v4i16_t*)p)); }
__device__ __forceinline__ float rowmax(const f32x16&p0,const f32x16&p1){
  float a=max3f(p0[0],p0[1],p1[0]),b=max3f(p0[2],p0[3],p1[1]);a=max3f(a,p1[2],p1[3]);
  #pragma unroll
  for(int r=4;r<16;r+=4){a=max3f(a,p0[r],p0[r+1]);b=max3f(b,p0[r+2],p0[r+3]);a=max3f(a,p1[r],p1[r+1]);b=max3f(b,p1[r+2],p1[r+3]);}
  const float m=max2f(a,b);
  auto rr=__builtin_amdgcn_permlane32_swap(__float_as_uint(m),__float_as_uint(m),false,false);
  return max2f(__uint_as_float(rr[0]),__uint_as_float(rr[1]));
}
__device__ __forceinline__ void pv(f32x16*o,int vb,bf16x8 pa0,bf16x8 pa1,bf16x8 pa2,bf16x8 pa3){
  #pragma unroll
  for(int d0=0;d0<2;++d0){s16x4 lo[4],hi[4];
    #pragma unroll
    for(int ks=0;ks<4;++ks){
      asm volatile("ds_read_b64_tr_b16 %0,%1 offset:%c2":"=&v"(lo[ks]):"v"(vb),"i"(d0*4096+ks*1024):"memory");
      asm volatile("ds_read_b64_tr_b16 %0,%1 offset:%c2":"=&v"(hi[ks]):"v"(vb),"i"(d0*4096+ks*1024+512):"memory");}
    asm volatile("s_waitcnt lgkmcnt(0)":::"memory");SBAR();
    #define PK(k) (bf16x8){lo[k][0],lo[k][1],lo[k][2],lo[k][3],hi[k][0],hi[k][1],hi[k][2],hi[k][3]}
    o[d0]=__builtin_amdgcn_mfma_f32_32x32x16_bf16(pa0,PK(0),o[d0],0,0,0);
    o[d0]=__builtin_amdgcn_mfma_f32_32x32x16_bf16(pa1,PK(1),o[d0],0,0,0);
    o[d0]=__builtin_amdgcn_mfma_f32_32x32x16_bf16(pa2,PK(2),o[d0],0,0,0);
    o[d0]=__builtin_amdgcn_mfma_f32_32x32x16_bf16(pa3,PK(3),o[d0],0,0,0);
    #undef PK
  }
}

#ifndef ATTN_STORE16
#define ATTN_STORE16(p,v) asm volatile("global_store_dwordx4 %0, %1, off sc0 sc1" :: "v"((GAS void*)(p)), "v"(v) : "memory")
#endif
template<int THRL> __device__ __forceinline__ void attn_unit(int b,int h,int qb,const bf16*Q,const bf16*__restrict__ K,const bf16*__restrict__ V,bf16*O,const unsigned long long*MK,const __attribute__((address_space(3))) float*lut,char*shm){
  int tid_=threadIdx.x; asm volatile("":"+v"(tid_)); const int tid=tid_,lane=tid&63,r32=lane&31,hi=lane>>5; const int wid=__builtin_amdgcn_readfirstlane(tid>>6);
  const long rowbase=(long)b*SEQ; const int q0=qb*QB;
  const bf16*Qw=Q+(rowbase+q0+wid*QBLK)*DM+h*D;
  const bf16*Kh=K+rowbase*DM+h*D,*Vh=V+rowbase*DM+h*D;
  const unsigned lds0=(unsigned)(uintptr_t)shm;
  float*wsf=(float*)(shm+LDS_WS)+wid*64;
  const bf16*ksrc=Kh+(long)lane*DM+wid*8;
  const bf16*vsrc=Vh+(long)(16*(wid&3)+(lane>>2))*DM+(wid>>2)*32+(lane&3)*8;
  const unsigned kdst=lds0+LDS_K+wid*1024, vdst=lds0+LDS_V+wid*1024;
  #define DMA_K(t,slot) glds16(ksrc+(long)(t)*KVBLK*DM,(unsigned)__builtin_amdgcn_readfirstlane(kdst+(slot)))
  #define DMA_V(t,slot) glds16(vsrc+(long)(t)*KVBLK*DM,(unsigned)__builtin_amdgcn_readfirstlane(vdst+(slot)))
  const int vb0=(int)(lds0+LDS_V)+((lane>>4)&1)*32+(lane&3)*8+(4*hi+((lane&15)>>2))*64;
  const char*Kbase=shm+LDS_K; bf16x8 kf[8];
  const lds_cptr shm3=(lds_cptr)shm; const lds_cptr kp0=shm3+LDS_K+hi*1024+r32*16; const lds_cptr vp0=shm3+LDS_V+((lane>>4)&1)*32+(lane&3)*8+(4*hi+((lane&15)>>2))*64; const lds_cptr mkp=shm3+LDS_MK+wid*512+r32*4;
  const int NT=(q0+QB)/KVBLK;
  const char*msrc=(const char*)(MK+(rowbase+q0+wid*QBLK+r32)*(SEQ/64))+hi*4; const unsigned mdst=lds0+LDS_MK+wid*512;
  #define DMA_M(t) glds4(msrc+(long)(t)*8,(unsigned)__builtin_amdgcn_readfirstlane(mdst+(((t)&1)<<8)))
  DMA_M(0);DMA_M(1);
  DMA_K(0,0);DMA_V(0,0);DMA_K(1,SLOTB);
  bf16x8 qr[4];
  #pragma unroll
  for(int d0=0;d0<4;++d0)qr[d0]=*reinterpret_cast<const bf16x8*>(&Qw[(long)r32*DM+d0*16+hi*8]);
  float mhat=0.f,l_reg=0.f;f32x16 o[2];o[0]=f32x16{};o[1]=f32x16{};const f32x16 negm=f32x16{};
  const int qrel=wid*QBLK+r32;
  #define MREAD(t) (u32x2v){*(const __attribute__((address_space(3))) unsigned*)(mkp+(((t)&1)<<8)),*(const __attribute__((address_space(3))) unsigned*)(mkp+(((t)&1)<<8)+128)}
  #define CMASK(P0,P1,t,MC) do{int jb_=(t)-(NT-6); if(jb_>=0 && 32*wid+65-64*jb_<113 && 64*jb_-128<=32*wid+31)abias(P0,P1,jb_,qrel,hi,lut); const u32x2v mk_=MREAD(t); amask(P0,P1,mk_,hi);}while(0)
  bool resc=false;
  #define START(P0,P1) do{ const float rm=rowmax(P0,P1); resc=false; \
    { const float dl=__builtin_fmaxf(rm,-1000.f); mhat=fadd_s(mhat,dl); \
      _Pragma("unroll") for(int r=0;r<16;++r){P0[r]=fsub_s(P0[r],dl);P1[r]=fsub_s(P1[r],dl);} \
      } \
    _Pragma("unroll") for(int r=0;r<16;++r)P0[r]=__builtin_amdgcn_exp2f(P0[r]); }while(0)
  #define RESC() do{ if(resc){ asm volatile("s_waitcnt lgkmcnt(0)":::"memory"); \
      _Pragma("unroll") for(int d_=0;d_<2;++d_) _Pragma("unroll") for(int r=0;r<16;++r)o[d_][r]*=wsf[crow(r,hi)]; } }while(0)
  f32x16 pA0,pA1,pB0,pB1;
  int sl_prev=0,sl_cur=0,sl_next=SLOTB;
  #define ROT() do{sl_prev=sl_cur;sl_cur=sl_next;sl_next=(sl_next==(NSLOT-1)*SLOTB)?0:sl_next+SLOTB;}while(0)
  DMA_K(2,2*SLOTB);
  WAIT_BAR(3);
  qkt(pA0,pA1,Kbase,qr,negm,r32,hi);asm volatile("s_nop 15\n\ts_nop 7":"+v"(pA0),"+v"(pA1));CMASK(pA0,pA1,0,0);
  START(pA0,pA1);
  _Pragma("unroll") for(int r=0;r<16;++r)pA1[r]=__builtin_amdgcn_exp2f(pA1[r]);
  WAIT_BAR(0);
  DMA_K(3,0);DMA_V(1,SLOTB);
  ROT();
  kload8(kf,kp0+sl_cur);
  WAIT_BAR(2);
  s16x4 vlo[8],vhi[8]; u32x4 pw0,pw1,pw2,pw3;
  #define PKW(P,B) cvtpk_s(P[B],P[B+1])
  #define PAF(k) __builtin_bit_cast(bf16x8,pw##k)
  #define VFR(i) (bf16x8){vlo[i][0],vlo[i][1],vlo[i][2],vlo[i][3],vhi[i][0],vhi[i][1],vhi[i][2],vhi[i][3]}
  #define PIN(x) asm volatile("":"+v"(x))
  #define MX3(a,b,c) __builtin_fmaxf(__builtin_fmaxf((a),(b)),(c))
  #define GAPA(MF,A0,A1,A2,A3,W0,W1,PW) do{ MF; sacc+=A0; sacc+=A1; sacc+=A2; sacc+=A3; PIN(sacc); W0; W1; PIN(PW); SBAR(); }while(0)
  #define EX(v) __builtin_amdgcn_exp2f(v)
  #define GAPB(MF,X,B) do{ MF; X[B]=EX(X[B]); X[B+1]=EX(X[B+1]); X[B+2]=EX(X[B+2]); X[B+3]=EX(X[B+3]); PIN(X); SBAR(); }while(0)
  #define VRD(i) do{ vlo[i]=vtr(vp_+(((i)>>2)*4096+((i)&3)*1024)); vhi[i]=vtr(vp_+(((i)>>2)*4096+((i)&3)*1024+512)); }while(0)
  #define KRD(G,j) do{ if(G){ kload2(kf,kp0+sl_next,j); SBAR(); } }while(0)
  #define STEP(C0,C1,P0,P1,t,GK,GV,GL,MC,MN,GM) do{ SBAR(); if(GM){DMA_M((t)+1);} \
    const lds_cptr vp_=vp0+sl_prev; \
    VRD(0); SBAR(); float sacc=(P0[0]+P0[1]); \
    GAPA(C0=__builtin_amdgcn_mfma_f32_32x32x16_bf16(kf[0],qr[0],negm,0,0,0), P0[2],P0[3],P0[4],P0[5],     pw0[0]=PKW(P0,0), pw0[1]=PKW(P0,2), pw0); \
    VRD(4); SBAR(); GAPA(C1=__builtin_amdgcn_mfma_f32_32x32x16_bf16(kf[1],qr[0],negm,0,0,0), P0[6],P0[7],P0[8],P0[9],     pw0[2]=PKW(P0,4), pw0[3]=PKW(P0,6), pw0); \
    VRD(1); SBAR(); GAPA(C0=__builtin_amdgcn_mfma_f32_32x32x16_bf16(kf[2],qr[1],C0,0,0,0),   P0[10],P0[11],P0[12],P0[13], pw1[0]=PKW(P0,8), pw1[1]=PKW(P0,10), pw1); \
    VRD(5); SBAR(); GAPA(C1=__builtin_amdgcn_mfma_f32_32x32x16_bf16(kf[3],qr[1],C1,0,0,0),   P0[14],P0[15],P1[0],P1[1],   pw1[2]=PKW(P0,12),pw1[3]=PKW(P0,14), pw1); \
    VRD(2); SBAR(); GAPA(C0=__builtin_amdgcn_mfma_f32_32x32x16_bf16(kf[4],qr[2],C0,0,0,0),   P1[2],P1[3],P1[4],P1[5],     pw2[0]=PKW(P1,0), pw2[1]=PKW(P1,2), pw2); \
    VRD(6); SBAR(); GAPA(C1=__builtin_amdgcn_mfma_f32_32x32x16_bf16(kf[5],qr[2],C1,0,0,0),   P1[6],P1[7],P1[8],P1[9],     pw2[2]=PKW(P1,4), pw2[3]=PKW(P1,6), pw2); \
    VRD(3); SBAR(); GAPA(C0=__builtin_amdgcn_mfma_f32_32x32x16_bf16(kf[6],qr[3],C0,0,0,0),   P1[10],P1[11],P1[12],P1[13], pw3[0]=PKW(P1,8), pw3[1]=PKW(P1,10), pw3); \
    VRD(7); SBAR(); GAPA(C1=__builtin_amdgcn_mfma_f32_32x32x16_bf16(kf[7],qr[3],C1,0,0,0),   P1[14],P1[15],0.f,0.f,       pw3[2]=PKW(P1,12),pw3[3]=PKW(P1,14), pw3); \
    l_reg+=sacc; \
    if(GK){DMA_K((t)+3,sl_cur);} if(GV){DMA_V((t)+1,sl_next);} \
    _Pragma("unroll") for(int r=0;r<16;++r){C0[r]-=mhat;C1[r]-=mhat;} \
    CMASK(C0,C1,t,MC); \
    { float a=MX3(C0[0],C0[1],C1[0]),b=MX3(C0[2],C0[3],C1[1]); a=MX3(a,C1[2],C1[3]); \
      _Pragma("unroll") for(int r=4;r<16;r+=4){a=MX3(a,C0[r],C0[r+1]);b=MX3(b,C0[r+2],C0[r+3]);a=MX3(a,C1[r],C1[r+1]);b=MX3(b,C1[r+2],C1[r+3]);} \
      float rm=__builtin_fmaxf(a,b); { auto rr=__builtin_amdgcn_permlane32_swap(__float_as_uint(rm),__float_as_uint(rm),false,false); rm=__builtin_fmaxf(__uint_as_float(rr[0]),__uint_as_float(rr[1])); } \
      resc=false; \
      if(__builtin_expect(__any(rm>(float)THRL),0)){ const float dl=__builtin_fmaxf(rm,0.f); mhat+=dl; \
        _Pragma("unroll") for(int r=0;r<16;++r){C0[r]-=dl;C1[r]-=dl;} \
        const float f=__builtin_amdgcn_exp2f(-dl); l_reg*=f; if(hi==0)wsf[r32]=f; resc=true; } } \
    SBAR(); \
    GAPB(o[0]=__builtin_amdgcn_mfma_f32_32x32x16_bf16(PAF(0),VFR(0),o[0],0,0,0), C0,0); \
    GAPB(o[1]=__builtin_amdgcn_mfma_f32_32x32x16_bf16(PAF(0),VFR(4),o[1],0,0,0), C0,4); \
    KRD(GL,0); GAPB(o[0]=__builtin_amdgcn_mfma_f32_32x32x16_bf16(PAF(1),VFR(1),o[0],0,0,0), C0,8); \
    KRD(GL,1); GAPB(o[1]=__builtin_amdgcn_mfma_f32_32x32x16_bf16(PAF(1),VFR(5),o[1],0,0,0), C0,12); \
    KRD(GL,2); GAPB(o[0]=__builtin_amdgcn_mfma_f32_32x32x16_bf16(PAF(2),VFR(2),o[0],0,0,0), C1,0); \
    KRD(GL,3); GAPB(o[1]=__builtin_amdgcn_mfma_f32_32x32x16_bf16(PAF(2),VFR(6),o[1],0,0,0), C1,4); \
    GAPB(o[0]=__builtin_amdgcn_mfma_f32_32x32x16_bf16(PAF(3),VFR(3),o[0],0,0,0), C1,8); \
    GAPB(o[1]=__builtin_amdgcn_mfma_f32_32x32x16_bf16(PAF(3),VFR(7),o[1],0,0,0), C1,12); \
    }while(0)
  int t=1;
  #undef CMASK
  #define CMASK(P0,P1,t,MC) do{ const u32x2v mk_=MREAD(t); amask(P0,P1,mk_,hi);}while(0)
  for(;t+7<NT;t+=2){
    STEP(pB0,pB1,pA0,pA1,t,true,true,true,0,0,true);     WAIT_BAR(2); RESC(); ROT();
    STEP(pA0,pA1,pB0,pB1,t+1,true,true,true,0,0,true);   WAIT_BAR(2); RESC(); ROT();
  }
  #undef CMASK
  #define CMASK(P0,P1,t,MC) do{int jb_=(t)-(NT-6); if(jb_>=0 && 32*wid+65-64*jb_<113 && 64*jb_-128<=32*wid+31)abias(P0,P1,jb_,qrel,hi,lut); const u32x2v mk_=MREAD(t); amask(P0,P1,mk_,hi);}while(0)
  #define ENDW(tt,M) do{ if((tt)+3<NT){WAIT_BAR(2);} else if((tt)+2<NT){WAIT_BAR(1);} else {WAIT_BAR(0);} }while(0)
  for(;t+1<NT;t+=2){
    STEP(pB0,pB1,pA0,pA1,t,(t+3<NT),(t+1<NT),(t+1<NT),0,0,(t+1<NT));       ENDW(t,0);   RESC(); ROT();
    STEP(pA0,pA1,pB0,pB1,t+1,(t+4<NT),(t+2<NT),(t+2<NT),0,0,(t+2<NT));     ENDW(t+1,0); RESC(); ROT();
  }
  STEP(pB0,pB1,pA0,pA1,NT-1,false,false,false,0,0,false); RESC();
  { float sacc=pB0[0]+pB0[1]; _Pragma("unroll") for(int r=2;r<16;++r)sacc+=pB0[r]; _Pragma("unroll") for(int r=0;r<16;++r)sacc+=pB1[r]; l_reg+=sacc;
    pw0=(u32x4){PKW(pB0,0),PKW(pB0,2),PKW(pB0,4),PKW(pB0,6)};pw1=(u32x4){PKW(pB0,8),PKW(pB0,10),PKW(pB0,12),PKW(pB0,14)};pw2=(u32x4){PKW(pB1,0),PKW(pB1,2),PKW(pB1,4),PKW(pB1,6)};pw3=(u32x4){PKW(pB1,8),PKW(pB1,10),PKW(pB1,12),PKW(pB1,14)};
    SBAR(); pv(o,vb0+sl_cur,PAF(0),PAF(1),PAF(2),PAF(3)); }
  #undef PKW
  #undef PAF
  #undef VFR
  #undef PIN
  #undef MX3
  #undef GAPA
  #undef GAPB
  #undef EX
  #undef VRD
  #undef KRD
  #undef STEP
  #undef ENDW
  {auto rr=__builtin_amdgcn_permlane32_swap(__float_as_uint(l_reg),__float_as_uint(l_reg),false,false);l_reg=__uint_as_float(rr[0])+__uint_as_float(rr[1]);}
  if(hi==0)wsf[32+r32]=l_reg;asm volatile("s_waitcnt lgkmcnt(0)":::"memory");
  float rli[16];
  #pragma unroll
  for(int r=0;r<16;++r)rli[r]=__builtin_amdgcn_rcpf(wsf[32+crow(r,hi)]);
  unsigned char*Ow=(unsigned char*)O+(rowbase+q0+wid*QBLK)*(long)DM+h*D;
  { unsigned char*stg=(unsigned char*)(shm+LDS_OST)+wid*4096;
    #pragma unroll
    for(int r=0;r<16;++r){const int orow=crow(r,hi); const float sc=rli[r]*AO_PRESCALE;
      #pragma unroll
      for(int d0=0;d0<2;++d0){const float x=__builtin_amdgcn_fmed3f(o[d0][r]*sc,-448.f,448.f); stg[orow*64+d0*32+r32]=(unsigned char)(__builtin_amdgcn_cvt_pk_fp8_f32(x,x,0,false)&0xff);}}
    asm volatile("s_waitcnt lgkmcnt(0)":::"memory");
    #pragma unroll
    for(int i=0;i<2;++i){const int row=i*16+(lane>>2),ch=lane&3; const u32x4 v=*(const u32x4*)(stg+row*64+ch*16); ATTN_STORE16(Ow+(long)row*DM+ch*16,v);} }
  asm volatile("s_waitcnt lgkmcnt(0)\n\ts_barrier":::"memory");
  #undef DMA_K
  #undef DMA_V
  #undef DMA_M
  #undef MREAD
  #undef CMASK
  #undef START
  #undef RESC
  #undef ROT
}
constexpr int ATTN_LDS_BYTES=LDS_BYTES;
struct AttnTensors { const bf16* Q; const bf16* K; const bf16* V; bf16* O; const unsigned long long* MK; };
struct AttnUnit { int bh; int qb; };
struct StaticOrder {
  int vcu; unsigned* pan;
  __device__ __forceinline__ explicit StaticOrder(int grid,int block,unsigned* pan_):vcu((block%8)*(grid/8)+block/8),pan(pan_){}
  __device__ __forceinline__ bool next(int i,AttnUnit&u)const{ if(i>=2)return false; const int s=vcu&7; u.bh=vcu>>3; u.qb=(i==0)?s:15-s; return true; }
  __device__ __forceinline__ void a_ready(const AttnUnit&)const{}
  __device__ __forceinline__ void done(const AttnUnit&u)const{ asm volatile("s_waitcnt vmcnt(0)":::"memory"); __syncthreads(); if(threadIdx.x==0)(void)__hip_atomic_fetch_add(pan+32*((u.bh/NHEAD)*16+u.qb),1u,__ATOMIC_RELAXED,__HIP_MEMORY_SCOPE_AGENT); }
};
template<class Sched,int THRL=8> __device__ __forceinline__ void attn_phase(char*lds,const AttnTensors&T,const __attribute__((address_space(3))) float*lut8,const Sched&S){
  AttnUnit u;
  for(int i=0;S.next(i,u);++i){ S.a_ready(u); attn_unit<THRL>(u.bh/NHEAD,u.bh%NHEAD,u.qb,T.Q,T.K,T.V,T.O,T.MK,lut8+(u.bh%NHEAD)*128,lds); S.done(u); }
}
#undef SBAR
#undef WAIT_BAR
}

struct Args { const float* in[17]; float* out; unsigned char* ws; };
enum { IN_X = 0, IN_MIXN, IN_WIN, IN_POOLW, IN_POOLS, IN_WBP, IN_WBA, IN_RELB, IN_WOUT, IN_FFNN, IN_WR, IN_BR, IN_W1, IN_B1, IN_W2, IN_B2, IN_FINN, IN_OUT = 17 };
struct Frame {
    LAS unsigned char* lds;
    unsigned char* ws;
    int tid, lane, wave, G, gw, ngw;
    __device__ __forceinline__ const float* in(int i) const {
        auto kp = __builtin_amdgcn_kernarg_segment_ptr(); u64 p;
        asm volatile("s_load_dwordx2 %0, %1, %2\n\ts_waitcnt lgkmcnt(0)" : "=s"(p) : "s"(kp), "s"(i * 8) : "memory");
        return (const float*)(const GAS float*)p; }
    __device__ __forceinline__ float* outp() const { return (float*)in(IN_OUT); }
    template <class T> __device__ __forceinline__ T* w(size_t off) const { return (T*)(ws + off); }
    __device__ __forceinline__ unsigned* ctl() const { return (unsigned*)(ws + WS_CTL); }
};

__device__ __forceinline__ void refresh(Frame& F) { int t = threadIdx.x; asm volatile("" : "+v"(t)); F.tid = t; F.lane = t & 63; }

__device__ __forceinline__ void panel_signal(Frame& F, int cw) {
    asm volatile("s_waitcnt vmcnt(0)" ::: "memory");
    __syncthreads();
    if (threadIdx.x == 0) { pg8::DenseSched s; s.init(NTOK, 1024, 0, nullptr, (int)gridDim.x, (int)blockIdx.x); for (int i = 0;; ++i) { int pm; if (!s.unit_pm(i, pm)) break; (void)xb_add(F.ctl() + cw + 32 * pm, 1u); } }
}
__device__ __forceinline__ void panel_poll(Frame& F, int cw, int pm, unsigned need) { unsigned* bar = F.ctl() + CW_BAR; unsigned* p = F.ctl() + cw + 32 * pm; XB_SPIN(xb_ld(p) < need, bar); }
__device__ __forceinline__ void panel_wait(Frame& F, int cw, unsigned need) {
    if (threadIdx.x == 0) { pg8::DenseSched s; s.init(NTOK, 1024, 0, nullptr, (int)gridDim.x, (int)blockIdx.x); for (int i = 0;; ++i) { int pm; if (!s.unit_pm(i, pm)) break; panel_poll(F, cw, pm, need); }
        __builtin_amdgcn_fence(__ATOMIC_ACQUIRE, "agent"); asm volatile("s_waitcnt vmcnt(0)" ::: "memory"); }
    __syncthreads();
}

template <bool INDEXER> struct EpiInProj {
    static constexpr bool PERM = true;
    bf16 *zpool, *q, *k, *v, *qi, *ki, *gate; float* wi;
    __device__ __forceinline__ void operator()(const f32x4 (&acc)[2][2][4][2], const pg8::Unit& u, int wr, int wc, int fr, int fq) const {
        const int pn = u.pn, row0 = u.row0 + wr * 64 + fr;
        if (INDEXER && pn == 1) {
#pragma unroll
            for (int ai = 0; ai < 2; ++ai)
#pragma unroll
                for (int m = 0; m < 4; ++m) { const int row = row0 + ai * 128 + m * 16;
                    const f32x4 v0 = acc[ai][0][m][0], v1 = acc[ai][0][m][1];
                    if (wc < 2) { u32x4 w; w.x = cvt_pk_bf16(v0[0], v0[1]); w.y = cvt_pk_bf16(v0[2], v0[3]); w.z = cvt_pk_bf16(v1[0], v1[1]); w.w = cvt_pk_bf16(v1[2], v1[3]);
                        *(u32x4*)(ki + (size_t)row * 64 + wc * 32 + 8 * fq) = w; }
                    else if (wc == 2 && fq == 0) { *(f32x4*)(wi + (size_t)row * 4) = v0; } }
            return;
        }
        bf16* base; int ldc, colt, mode = 0; float sc = 1.f;
        if (INDEXER) { if (pn == 0) { base = qi; ldc = 256; colt = 0; } else { base = zpool; ldc = 512; colt = (pn - 2) * 256; } }
        else if (pn < 2) { base = q; ldc = 512; colt = pn * 256; sc = QSCALE; }
        else if (pn < 4) { base = k; ldc = 512; colt = (pn - 2) * 256; }
        else if (pn < 6) { base = v; ldc = 512; colt = (pn - 4) * 256; }
        else { base = gate; ldc = 2048; colt = (pn - 6) * 256; mode = 1; }
        const int col0 = colt + wc * 32 + 8 * fq;
#pragma unroll
        for (int ai = 0; ai < 2; ++ai)
#pragma unroll
            for (int m = 0; m < 4; ++m) { bf16* rowp = base + (size_t)(row0 + ai * 128 + m * 16) * ldc + col0;
#pragma unroll
                for (int bj = 0; bj < 2; ++bj) { f32x4 v0 = acc[ai][bj][m][0], v1 = acc[ai][bj][m][1];
                    if (mode == 1) {
#pragma unroll
                        for (int j = 0; j < 4; ++j) { v0[j] = sigmoidf_(v0[j]); v1[j] = sigmoidf_(v1[j]); } }
                    else { v0 = v0 * sc; v1 = v1 * sc; }
                    u32x4 w; w.x = cvt_pk_bf16(v0[0], v0[1]); w.y = cvt_pk_bf16(v0[2], v0[3]); w.z = cvt_pk_bf16(v1[0], v1[1]); w.w = cvt_pk_bf16(v1[2], v1[3]);
                    *(u32x4*)(rowp + bj * 128) = w; } }
    }
};
__device__ __forceinline__ void store16_wt(const void* base, unsigned byteoff, u32x4 v) { asm volatile("global_store_dwordx4 %0, %1, %2 sc0 sc1" :: "v"(byteoff), "v"(v), "s"((GAS const void*)base) : "memory"); }
template <bool ADD> struct EpiGate {
    static constexpr bool PERM = true;
    bf16* merged; const bf16* gate; int goff;
    __device__ __forceinline__ void operator()(const f32x4 (&acc)[2][2][4][2], const pg8::Unit& u, int wr, int wc, int fr, int fq) const {
        const int row0 = u.row0 + wr * 64 + fr, col0 = u.pn * 256 + wc * 32 + 8 * fq;
#pragma unroll
        for (int ai = 0; ai < 2; ++ai)
#pragma unroll
            for (int m = 0; m < 4; ++m) { const size_t row = (size_t)(row0 + ai * 128 + m * 16);
#pragma unroll
                for (int bj = 0; bj < 2; ++bj) { const int col = col0 + bj * 128;
                    const u32x4 g = *(const u32x4*)(gate + row * 2048 + goff + col);
                    f32x4 v0 = acc[ai][bj][m][0], v1 = acc[ai][bj][m][1];
                    v0[0] *= bflo(g.x); v0[1] *= bfhi(g.x); v0[2] *= bflo(g.y); v0[3] *= bfhi(g.y); v1[0] *= bflo(g.z); v1[1] *= bfhi(g.z); v1[2] *= bflo(g.w); v1[3] *= bfhi(g.w);
                    if (ADD) { const u32x4 p = *(const u32x4*)(merged + row * 1024 + col);
                        v0[0] += bflo(p.x); v0[1] += bfhi(p.x); v0[2] += bflo(p.y); v0[3] += bfhi(p.y); v1[0] += bflo(p.z); v1[1] += bfhi(p.z); v1[2] += bflo(p.w); v1[3] += bfhi(p.w); }
                    u32x4 w; w.x = cvt_pk_bf16(v0[0], v0[1]); w.y = cvt_pk_bf16(v0[2], v0[3]); w.z = cvt_pk_bf16(v1[0], v1[1]); w.w = cvt_pk_bf16(v1[2], v1[3]);
                    if (ADD) store16_wt((const char*)merged + ((size_t)(ai * 128 + m * 16) * 1024 + bj * 128) * 2, (unsigned)(row0 * 1024 + col0) * 2u, w);
                    else *(u32x4*)(merged + row * 1024 + col) = w; } }
    }
};
struct EpiResidual {
    static constexpr bool PERM = true;
    const float* x; bf16* x1;
    __device__ __forceinline__ void operator()(const f32x4 (&acc)[2][2][4][2], const pg8::Unit& u, int wr, int wc, int fr, int fq) const {
        const int row0 = u.row0 + wr * 64 + fr, col0 = u.pn * 256 + wc * 32 + 8 * fq;
#pragma unroll
        for (int ai = 0; ai < 2; ++ai)
#pragma unroll
            for (int m = 0; m < 4; ++m) { const size_t off = (size_t)(row0 + ai * 128 + m * 16) * D + col0;
#pragma unroll
                for (int bj = 0; bj < 2; ++bj) { const f32x4 b0 = *(const f32x4*)(x + off + bj * 128), b1 = *(const f32x4*)(x + off + bj * 128 + 4);
                    const f32x4 v0 = b0 + acc[ai][bj][m][0], v1 = b1 + acc[ai][bj][m][1];
                    u32x4 w; w.x = cvt_pk_bf16(v0[0], v0[1]); w.y = cvt_pk_bf16(v0[2], v0[3]); w.z = cvt_pk_bf16(v1[0], v1[1]); w.w = cvt_pk_bf16(v1[2], v1[3]);
                    store16_wt((const char*)x1 + ((size_t)(ai * 128 + m * 16) * D + bj * 128) * 2, (unsigned)(row0 * D + col0) * 2u, w); } }
    }
};
__device__ __forceinline__ float clamp448(float x) { return __builtin_amdgcn_fmed3f(x, -448.0f, 448.0f); }
__device__ __forceinline__ unsigned pk4_fp8(float a, float b, float c, float d) { int w = 0; w = __builtin_amdgcn_cvt_pk_fp8_f32(a, b, w, false); w = __builtin_amdgcn_cvt_pk_fp8_f32(c, d, w, true); return (unsigned)w; }
constexpr float ACT_PRESCALE = 4.0f, H_PRESCALE = 8.0f, W_PRESCALE = 128.0f, YS_PRESCALE = 64.0f;
struct EpiSwiGLU {
    static constexpr bool PERM = true;
    unsigned char* act; const LAS float* bias;
    __device__ __forceinline__ void operator()(const f32x4 (&acc)[2][2][4][2], const pg8::Unit& u, int wr, int wc, int fr, int fq) const {
        const int row0 = u.row0 + wr * 64 + fr, colr = u.pn * 128 + wc * 32 + 8 * fq;
        const LAS float* bg = bias + u.raw * 256 + wc * 32 + 8 * fq; const LAS float* bu = bg + 128;
        const f32x4 bg0 = *(const LAS f32x4*)bg, bg1 = *(const LAS f32x4*)(bg + 4), bu0 = *(const LAS f32x4*)bu, bu1 = *(const LAS f32x4*)(bu + 4);
#pragma unroll
        for (int ai = 0; ai < 2; ++ai)
#pragma unroll
            for (int m = 0; m < 4; ++m) { const size_t row = (size_t)(row0 + ai * 128 + m * 16);
                f32x4 g0 = acc[ai][0][m][0] + bg0, g1 = acc[ai][0][m][1] + bg1, u0 = acc[ai][1][m][0] + bu0, u1 = acc[ai][1][m][1] + bu1, r0, r1;
#pragma unroll
                for (int j = 0; j < 4; ++j) {
                    { const float g = fminf(g0[j], 7.0f), uu = fminf(fmaxf(u0[j], -7.0f), 7.0f); r0[j] = g * sigmoidf_(1.702f * g) * (uu + 1.0f) * ACT_PRESCALE; }
                    { const float g = fminf(g1[j], 7.0f), uu = fminf(fmaxf(u1[j], -7.0f), 7.0f); r1[j] = g * sigmoidf_(1.702f * g) * (uu + 1.0f) * ACT_PRESCALE; } }
                u32x2 w; w.x = pk4_fp8(r0[0], r0[1], r0[2], r0[3]); w.y = pk4_fp8(r1[0], r1[1], r1[2], r1[3]);
                *(u32x2*)(act + row * 1024 + colr) = w; }
    }
};
struct EpiMoeOut {
    static constexpr bool PERM = true;
    unsigned char* ys; const LAS float* bias; const LAS int* rows;
    __device__ __forceinline__ void operator()(const f32x4 (&acc)[2][2][4][2], const pg8::Unit& u, int wr, int wc, int fr, int fq) const {
        const int nvalid = u.aux2, slot = u.raw;
        const int col0 = u.pn * 256 + wc * 32 + 8 * fq;
#pragma unroll
        for (int bj = 0; bj < 2; ++bj) {
            const f32x4 bv0 = *(const LAS f32x4*)(bias + slot * 256 + wc * 32 + 8 * fq + bj * 128), bv1 = *(const LAS f32x4*)(bias + slot * 256 + wc * 32 + 8 * fq + bj * 128 + 4);
#pragma unroll
            for (int ai = 0; ai < 2; ++ai)
#pragma unroll
                for (int m = 0; m < 4; ++m) { const int r = ai * 128 + wr * 64 + m * 16 + fr;
                    if (r < nvalid) { const int ts = rows[(slot * 256 + r) * 2]; const float gt = __int_as_float(rows[(slot * 256 + r) * 2 + 1]) * YS_PRESCALE; unsigned char* rowp = ys + (size_t)ts * 1024 + col0;
                        const f32x4 v0 = (acc[ai][bj][m][0] + bv0) * gt, v1 = (acc[ai][bj][m][1] + bv1) * gt;
                        u32x2 w; w.x = pk4_fp8(clamp448(v0[0]), clamp448(v0[1]), clamp448(v0[2]), clamp448(v0[3])); w.y = pk4_fp8(clamp448(v1[0]), clamp448(v1[1]), clamp448(v1[2]), clamp448(v1[3]));
                        *(u32x2*)(rowp + bj * 128) = w; } }
            asm volatile("" ::: "memory");
        }
    }
};

struct MoeSched1 {
    const LAS int* tab; const LAS int* gath; const char* W1T; int G, c;
    __device__ __forceinline__ bool next(int i, pg8::Unit& u, const pg8::LaneRC& rc) const {
        const int T = tab[64], nwg = T * 8; const long L = (long)i * G + c; if (L >= nwg) return false;
        const int wgid = pg8::xcd_remap((int)L, nwg), mt = wgid >> 3, pn = wgid & 7;
        const int te = tab[128 + mt], e = te >> 16, lt = te & 0xffff, cnt = tab[e], pos0 = lt * 256;
#pragma unroll
        for (int h = 0; h < 2; ++h)
#pragma unroll
            for (int i2 = 0; i2 < 2; ++i2) u.aoff[h][i2] = (unsigned)(gath[i * 256 + h * 128 + rc.R[i2]] * 512 + rc.C[i2]) * 2u;
        u.b0 = W1T + ((size_t)e * 2048 + (size_t)pn * 128) * 1024; u.b1 = u.b0 + (size_t)1024 * 1024;
        u.row0 = tab[32 + e] + pos0; u.pn = pn; u.aux = e; u.aux2 = (cnt - pos0 < 256) ? (cnt - pos0) : 256; u.aux3 = pos0; u.raw = i; return true;
    }
    __device__ __forceinline__ void finish(pg8::Unit&, const pg8::LaneRC&) const {}
};
__device__ __forceinline__ void moe_gather_fill(Frame& F, const int* list, const float* b1) {
    const LAS int* tab = (const LAS int*)(F.lds + TAB_OFF); LAS int* gath = (LAS int*)(F.lds + TAB_OFF + 4096); LAS float* bias = (LAS float*)(F.lds + BIAS_OFF);
    const int T = tab[64], nwg = T * 8;
    for (int q = F.tid; q < 9 * 256; q += 512) { const int i = q >> 8, r = q & 255; const long L = (long)i * F.G + (int)blockIdx.x; int tok = 0; float bv = 0.f;
        if (L < nwg) { const int wgid = pg8::xcd_remap((int)L, nwg), mt = wgid >> 3, pn = wgid & 7; const int te = tab[128 + mt], e = te >> 16, lt = te & 0xffff, cnt = tab[e], pos = lt * 256 + r;
            if (pos < cnt) tok = list[(size_t)e * NTOK + pos] >> 2;
            bv = b1[(size_t)e * 2048 + (r < 128 ? 0 : 1024) + pn * 128 + (r & 127)]; }
        gath[q] = tok; bias[q] = bv; }
    __syncthreads();
}
struct MoeSched2 {
    const LAS int* tab; const char* W2T; int G, c;
    __device__ __forceinline__ bool next(int i, pg8::Unit& u, const pg8::LaneRC& rc) const {
        const int T = tab[64], nwg = T * 4; const long L = (long)i * G + c; if (L >= nwg) return false;
        const int wgid = pg8::xcd_remap((int)L, nwg), mt = wgid >> 2, pn = wgid & 3;
        const int te = tab[128 + mt], e = te >> 16, lt = te & 0xffff, cnt = tab[e], pos0 = lt * 256, row0 = tab[32 + e] + pos0;
#pragma unroll
        for (int h = 0; h < 2; ++h)
#pragma unroll
            for (int i2 = 0; i2 < 2; ++i2) u.aoff[h][i2] = (unsigned)((row0 + h * 128 + rc.R[i2]) * 512 + rc.C[i2]) * 2u;
        u.b0 = W2T + ((size_t)e * 1024 + (size_t)pn * 256) * 1024; u.b1 = u.b0 + (size_t)128 * 1024;
        u.row0 = row0; u.pn = pn; u.aux = e; u.aux2 = (cnt - pos0 < 256) ? (cnt - pos0) : 256; u.aux3 = pos0; u.raw = i; return true;
    }
    __device__ __forceinline__ void finish(pg8::Unit&, const pg8::LaneRC&) const {}
};

struct TItem { const float* src; unsigned char* dst; size_t rowpitch; int ldw, k0, col0, nvalid, row0, kbyte0, fp8; };
__device__ __forceinline__ TItem p0_item(int it, const float* w_in, const float* w_ba, const float* w_out, const float* w1, const float* w2, unsigned char* ws) {
    TItem t; constexpr int I_INI = 16 * 4, I_BA = 4 * 4, I_OUT = 16 * 4, I_IN8 = 8 * 14, I_W1 = 32 * 8 * 8;
    int r = it; t.fp8 = 0; t.nvalid = 256;
    if (r < I_INI) { const int kb = r >> 2, nb = r & 3; t.src = w_in; t.dst = ws + WS_WINI; t.ldw = DIN; t.rowpitch = 2048; t.k0 = kb * 64; t.kbyte0 = kb * 128; t.row0 = nb * 256;
        if (nb == 0) { t.col0 = 2048; } else if (nb == 1) { t.col0 = 2304; t.nvalid = 68; } else { t.col0 = (nb - 2) * 256; } return t; } r -= I_INI;
    if (r < I_OUT) { const int kb = r / 4, nb = r % 4; t.src = w_out; t.dst = ws + WS_WOUT; t.ldw = 1024; t.rowpitch = 2048; t.k0 = kb * 64; t.kbyte0 = kb * 128; t.col0 = nb * 256; t.row0 = nb * 256; return t; } r -= I_OUT;
    t.fp8 = 1; t.rowpitch = 1024;
    if (r < I_IN8) { const int kb = r / 14, nb = r % 14; t.src = w_in; t.dst = ws + WS_WIN; t.ldw = DIN; t.k0 = kb * 128; t.kbyte0 = kb * 128; t.row0 = nb * 256;
        t.col0 = (nb < 6) ? 512 + nb * 256 : 2372 + (nb - 6) * 256; return t; } r -= I_IN8;
    if (r < I_BA) { const int kb = r / 4, nb = r % 4; t.src = w_ba; t.dst = ws + WS_WBA; t.ldw = 1024; t.rowpitch = 512; t.k0 = kb * 128; t.kbyte0 = kb * 128; t.col0 = nb * 256; t.row0 = nb * 256; return t; } r -= I_BA;
    if (r < I_W1) { const int e = r >> 6, q = r & 63, kb = q >> 3, nb = q & 7; t.src = w1 + (size_t)e * 1024 * 2048; t.dst = ws + WS_W1 + (size_t)e * 2048 * 1024; t.ldw = 2048; t.k0 = kb * 128; t.kbyte0 = kb * 128; t.col0 = nb * 256; t.row0 = nb * 256; return t; } r -= I_W1;
    { const int e = r >> 5, q = r & 31, kb = q >> 2, nb = q & 3; t.src = w2 + (size_t)e * 1024 * 1024; t.dst = ws + WS_W2 + (size_t)e * 1024 * 1024; t.ldw = 1024; t.k0 = kb * 128; t.kbyte0 = kb * 128; t.col0 = nb * 256; t.row0 = nb * 256; return t; }
}
template <bool ONLY8> __device__ __forceinline__ void p0_load(const TItem& t, int wave, int lane, float (&v)[16][4]) {
    const int rpw = (ONLY8 || t.fp8) ? 16 : 8;
#pragma unroll
    for (int r = 0; r < 16; ++r) if (r < rpw) { const float* row = t.src + (size_t)(t.k0 + wave * rpw + r) * t.ldw + t.col0;
#pragma unroll
        for (int j = 0; j < 4; ++j) { const int n = lane + 64 * j; v[r][j] = (n < t.nvalid) ? __builtin_nontemporal_load(row + n) : 0.f; } }
}
constexpr int IT_W1_BEG = 256, IT_W1_END = 256 + 2048, IT_END = IT_W1_END + 1024, NW1T = 512, NW2T = 512, TAIL_PER = 12;
constexpr int MINI_W1_ITEMS = 2048 - NW1T, MINI_ITEMS = MINI_W1_ITEMS + (1024 - NW2T);
template <bool ONLY8> __device__ __forceinline__ void p0_copy(Frame& F, int j, const int j_end, const int stride, const int skip_at, const int skip_n) {
    refresh(F);
    const float* w_in = F.in(IN_WIN); const float* w_ba = F.in(IN_WBA); const float* w_out = F.in(IN_WOUT); const float* w1 = F.in(IN_W1); const float* w2 = F.in(IN_W2);
    constexpr int TPITCH = 144, TBYTES = 256 * TPITCH;
    const int wave = F.wave, lane = F.lane, tid = F.tid;
    __syncthreads();
    float v[16][4];
    int buf = 0;
    TItem cur; if (j < j_end) { cur = p0_item(j + (j >= skip_at ? skip_n : 0), w_in, w_ba, w_out, w1, w2, F.ws); p0_load<ONLY8>(cur, wave, lane, v); }
    while (j < j_end) {
        LAS unsigned char* T = F.lds + buf * TBYTES;
        if (ONLY8 || cur.fp8) {
#pragma unroll
            for (int jj = 0; jj < 4; ++jj) { u32x4 o; o.x = pk4_fp8(clamp448(v[0][jj] * W_PRESCALE), clamp448(v[1][jj] * W_PRESCALE), clamp448(v[2][jj] * W_PRESCALE), clamp448(v[3][jj] * W_PRESCALE)); o.y = pk4_fp8(clamp448(v[4][jj] * W_PRESCALE), clamp448(v[5][jj] * W_PRESCALE), clamp448(v[6][jj] * W_PRESCALE), clamp448(v[7][jj] * W_PRESCALE));
                o.z = pk4_fp8(clamp448(v[8][jj] * W_PRESCALE), clamp448(v[9][jj] * W_PRESCALE), clamp448(v[10][jj] * W_PRESCALE), clamp448(v[11][jj] * W_PRESCALE)); o.w = pk4_fp8(clamp448(v[12][jj] * W_PRESCALE), clamp448(v[13][jj] * W_PRESCALE), clamp448(v[14][jj] * W_PRESCALE), clamp448(v[15][jj] * W_PRESCALE));
                *(LAS u32x4*)(T + (lane + 64 * jj) * TPITCH + wave * 16) = o; }
        } else {
#pragma unroll
            for (int jj = 0; jj < 4; ++jj) { u32x4 o; o.x = pk2(v[0][jj], v[1][jj]); o.y = pk2(v[2][jj], v[3][jj]); o.z = pk2(v[4][jj], v[5][jj]); o.w = pk2(v[6][jj], v[7][jj]);
                *(LAS u32x4*)(T + (lane + 64 * jj) * TPITCH + wave * 16) = o; }
        }
        const int nj = j + stride; TItem nxt = cur;
        if (nj < j_end) { nxt = p0_item(nj + (nj >= skip_at ? skip_n : 0), w_in, w_ba, w_out, w1, w2, F.ws); p0_load<ONLY8>(nxt, wave, lane, v); }
        __syncthreads();
#pragma unroll
        for (int i = 0; i < 4; ++i) { const int p = tid + 512 * i, row = p >> 3, c = p & 7; const u32x4 o = *(const LAS u32x4*)(T + row * TPITCH + c * 16);
            *(u32x4*)(cur.dst + (size_t)(cur.row0 + row) * cur.rowpitch + cur.kbyte0 + c * 16) = o; }
        cur = nxt; j = nj; buf ^= 1;
    }
    __syncthreads();
}
__device__ __forceinline__ void p0_prologue(Frame& F) {
    refresh(F);
    const float* pool_w = F.in(IN_POOLW); const float* pool_scale = F.in(IN_POOLS); const float* w_bp = F.in(IN_WBP); const float* x = F.in(IN_X); const float* mix_norm = F.in(IN_MIXN);
    p0_copy<false>(F, (int)blockIdx.x, IT_W1_BEG, (int)gridDim.x, 1 << 30, 0);
    {
        const int gt = F.gw * 64 + F.lane, ngt = F.ngw * 64;
        for (int idx = gt; idx < 4 * 32 * 1024; idx += ngt) { const int d = idx & 1023, cq = (idx >> 10) & 31, g = idx >> 15;
            const float* pw = pool_w + ((size_t)g * 128 + cq * 4) * 128; const float* ps = pool_scale + g * 128; const float* wb = w_bp + (size_t)(g * 128) * 1024 + d;
            float a0 = 0.f, a1 = 0.f, a2 = 0.f, a3 = 0.f;
#pragma unroll 16
            for (int j = 0; j < 128; ++j) { const float wv = wb[(size_t)j * 1024] * ps[j]; a0 += pw[j] * wv; a1 += pw[128 + j] * wv; a2 += pw[256 + j] * wv; a3 += pw[384 + j] * wv; }
            u32x2 o; o.x = pk2(a0, a1); o.y = pk2(a2, a3);
            *(u32x2*)(F.w<bf16>(WS_WPC) + (size_t)d * 512 + g * 128 + cq * 4) = o; }
    }
    {
        const int lane = F.lane, st = F.ngw; bf16* Hh = F.w<bf16>(WS_H); unsigned* H8 = F.w<unsigned>(WS_H8X);
        f32x4 va[4], vb[4]; int m = F.gw;
        auto ld = [&](f32x4 (&v)[4], int mm) { const f32x4* xr = (const f32x4*)(x + (size_t)mm * D) + lane;
#pragma unroll
            for (int j = 0; j < 4; ++j) v[j] = __builtin_nontemporal_load(xr + 64 * j); };
        auto row = [&](const f32x4 (&v)[4], int mm) { float ss = 0.f;
#pragma unroll
            for (int j = 0; j < 4; ++j) ss += (v[j].x * v[j].x + v[j].y * v[j].y) + (v[j].z * v[j].z + v[j].w * v[j].w);
            const float rstd = 1.0f / sqrtf(wave_sum(ss) * (1.f / D) + RMS_EPS);
            const f32x4* gr = (const f32x4*)mix_norm + lane; u32x2* o8 = (u32x2*)(Hh + (size_t)mm * D) + lane;
#pragma unroll
            for (int j = 0; j < 4; ++j) { const f32x4 g = gr[64 * j]; const float h0 = v[j].x * rstd * g.x, h1 = v[j].y * rstd * g.y, h2 = v[j].z * rstd * g.z, h3 = v[j].w * rstd * g.w;
                u32x2 w; w.x = pk2(h0, h1); w.y = pk2(h2, h3); o8[64 * j] = w;
                H8[(size_t)mm * 256 + lane + 64 * j] = pk4_fp8(clamp448(h0 * H_PRESCALE), clamp448(h1 * H_PRESCALE), clamp448(h2 * H_PRESCALE), clamp448(h3 * H_PRESCALE)); } };
        if (m < NTOK) ld(va, m);
        while (m < NTOK) { const int m2 = m + st, m3 = m2 + st;
            if (m2 < NTOK) ld(vb, m2);
            row(va, m);
            if (m3 < NTOK) ld(va, m3);
            if (m2 < NTOK) row(vb, m2);
            m = m3; }
    }
}

__device__ __forceinline__ unsigned pk_f16(float a, float b) { const unsigned short x = __builtin_bit_cast(unsigned short, (_Float16)a), y = __builtin_bit_cast(unsigned short, (_Float16)b); return (unsigned)x | ((unsigned)y << 16); }
typedef _Float16 f16x2 __attribute__((ext_vector_type(2)));
__device__ __forceinline__ unsigned pk_f16v(f32x2 v) { return __builtin_bit_cast(unsigned, __builtin_convertvector(v, f16x2)); }
__device__ __forceinline__ void score_seg(int b, int qb, int kb0, int nkb, const bf16* QI, const bf16* KI, const float* WI, unsigned short* SC, LAS unsigned char* stile, int lane) {
    const int r32 = lane & 31, hi = lane >> 5;
    const size_t qrow = (size_t)b * SEQ + 32 * qb + r32;
    bf16x8 qf[4][4];
#pragma unroll
    for (int h = 0; h < 4; ++h)
#pragma unroll
        for (int kk = 0; kk < 4; ++kk) qf[h][kk] = *(const bf16x8*)(QI + qrow * 256 + h * 64 + kk * 16 + hi * 8);
    const f32x4 wv = *(const f32x4*)(WI + qrow * 4);
    const bf16* kip = KI + ((size_t)b * SEQ + r32) * 64 + hi * 8;
    const int kb1 = kb0 + nkb - 1;
    auto body = [&](const bf16x8 (&kf)[4], int kc) {
        f32x2 s2[8];
#pragma unroll
        for (int h = 0; h < 4; ++h) { f32x16 a;
#pragma unroll
            for (int i = 0; i < 16; ++i) a[i] = 0.f;
#pragma unroll
            for (int kk = 0; kk < 4; ++kk) a = __builtin_amdgcn_mfma_f32_32x32x16_bf16(kf[kk], qf[h][kk], a, 0, 0, 0);
            const f32x2 w2 = {wv[h], wv[h]};
#pragma unroll
            for (int j = 0; j < 8; ++j) { f32x2 r; r.x = __int_as_float(max(__float_as_int(a[2 * j]), 0)); r.y = __int_as_float(max(__float_as_int(a[2 * j + 1]), 0));
                s2[j] = (h == 0) ? (w2 * r + (f32x2){0.f, 0.f}) : (w2 * r + s2[j]); } }
#pragma unroll
        for (int g = 0; g < 4; ++g) { u32x2 o; o.x = pk_f16v(s2[2 * g]); o.y = pk_f16v(s2[2 * g + 1]); *(LAS u32x2*)(stile + r32 * 80 + (8 * g + 4 * hi) * 2) = o; }
        LDS_WAIT(); asm volatile("" ::: "memory");
#pragma unroll
        for (int i = 0; i < 2; ++i) { const int rr = i * 16 + (lane >> 2), cc = lane & 3; const u32x4 o = *(const LAS u32x4*)(stile + rr * 80 + cc * 16);
            *(u32x4*)(SC + ((size_t)b * SEQ + 32 * qb + rr) * SEQ + 32 * kc + cc * 8) = o; }
        LDS_WAIT(); asm volatile("" ::: "memory");
    };
    bf16x8 kA[4], kB[4];
#pragma unroll
    for (int kk = 0; kk < 4; ++kk) kA[kk] = *(const bf16x8*)(kip + (size_t)(32 * kb0) * 64 + kk * 16);
    asm volatile("" :: "v"(kA[0]), "v"(kA[1]), "v"(kA[2]), "v"(kA[3]), "v"(wv), "v"(qf[0][0]), "v"(qf[0][1]), "v"(qf[0][2]), "v"(qf[0][3]), "v"(qf[1][0]), "v"(qf[1][1]), "v"(qf[1][2]), "v"(qf[1][3]), "v"(qf[2][0]), "v"(qf[2][1]), "v"(qf[2][2]), "v"(qf[2][3]), "v"(qf[3][0]), "v"(qf[3][1]), "v"(qf[3][2]), "v"(qf[3][3]));
#pragma unroll 1
    for (int kc = kb0; kc <= kb1; kc += 2) {
        { const int kn = (kc + 1 <= kb1) ? kc + 1 : kb1;
#pragma unroll
          for (int kk = 0; kk < 4; ++kk) kB[kk] = *(const bf16x8*)(kip + (size_t)(32 * kn) * 64 + kk * 16); }
        __builtin_amdgcn_sched_barrier(0);
        body(kA, kc);
        if (kc + 1 > kb1) break;
        { const int kn = (kc + 2 <= kb1) ? kc + 2 : kb1;
#pragma unroll
          for (int kk = 0; kk < 4; ++kk) kA[kk] = *(const bf16x8*)(kip + (size_t)(32 * kn) * 64 + kk * 16); }
        __builtin_amdgcn_sched_barrier(0);
        body(kB, kc + 1);
    }
}
template <int W> __device__ __forceinline__ void pooled_group(const bf16* zp, bf16* po, int tok0, int ch) {
    const int t0 = tok0 & (SEQ - 1);
    u32x4 v[7 + W];
#pragma unroll
    for (int r = 0; r < 7 + W; ++r) { const int rel = r - (W - 1); v[r] = (u32x4){0u, 0u, 0u, 0u}; if (t0 + rel >= 0) v[r] = *(const u32x4*)(zp + (size_t)(tok0 + rel) * 512 + ch * 8); }
    float s[8];
#pragma unroll
    for (int j = 0; j < 8; ++j) s[j] = 0.f;
#pragma unroll
    for (int r = 0; r < W; ++r) { s[0] += bflo(v[r].x); s[1] += bfhi(v[r].x); s[2] += bflo(v[r].y); s[3] += bfhi(v[r].y); s[4] += bflo(v[r].z); s[5] += bfhi(v[r].z); s[6] += bflo(v[r].w); s[7] += bfhi(v[r].w); }
#pragma unroll
    for (int j = 0; j < 8; ++j) {
        if (j > 0) { const u32x4 a = v[W - 1 + j], b = v[j - 1];
            s[0] += bflo(a.x) - bflo(b.x); s[1] += bfhi(a.x) - bfhi(b.x); s[2] += bflo(a.y) - bflo(b.y); s[3] += bfhi(a.y) - bfhi(b.y); s[4] += bflo(a.z) - bflo(b.z); s[5] += bfhi(a.z) - bfhi(b.z); s[6] += bflo(a.w) - bflo(b.w); s[7] += bfhi(a.w) - bfhi(b.w); }
        const int n = (t0 + j + 1 < W) ? t0 + j + 1 : W; const float inv = 1.0f / (float)n; const u32x4 cur = v[W - 1 + j];
        u32x4 o; o.x = pk2(s[0] * inv - bflo(cur.x), s[1] * inv - bfhi(cur.x)); o.y = pk2(s[2] * inv - bflo(cur.y), s[3] * inv - bfhi(cur.y));
        o.z = pk2(s[4] * inv - bflo(cur.z), s[5] * inv - bfhi(cur.z)); o.w = pk2(s[6] * inv - bflo(cur.w), s[7] * inv - bfhi(cur.w));
        *(u32x4*)(po + (size_t)(tok0 + j) * 512 + ch * 8) = o; }
}
__device__ __forceinline__ void p2_pooled(Frame& F) {
    refresh(F);
    const bf16* zp = F.w<bf16>(WS_ZPOOL); bf16* po = F.w<bf16>(WS_POOLED);
    for (int wv = F.gw; wv < NTOK / 8 * 64 / 64; wv += F.ngw) {
        const int g = wv & 3, tg = (wv >> 2) * 4 + (F.lane >> 4), ch = g * 16 + (F.lane & 15), tok0 = tg * 8;
        if (g == 0) pooled_group<2>(zp, po, tok0, ch); else if (g == 1) pooled_group<4>(zp, po, tok0, ch); else if (g == 2) pooled_group<8>(zp, po, tok0, ch); else pooled_group<16>(zp, po, tok0, ch);
    }
}

__device__ __forceinline__ unsigned sortable(float v) { const unsigned u = __float_as_uint(v); return u ^ ((u >> 31) ? 0xFFFFFFFFu : 0x80000000u); }
__device__ __forceinline__ unsigned dpp_scan64(unsigned v) {
    v += (unsigned)__builtin_amdgcn_update_dpp(0, (int)v, 0x111, 0xf, 0xf, false);
    v += (unsigned)__builtin_amdgcn_update_dpp(0, (int)v, 0x112, 0xf, 0xf, false);
    v += (unsigned)__builtin_amdgcn_update_dpp(0, (int)v, 0x114, 0xf, 0xf, false);
    v += (unsigned)__builtin_amdgcn_update_dpp(0, (int)v, 0x118, 0xf, 0xf, false);
    v += (unsigned)__builtin_amdgcn_update_dpp(0, (int)v, 0x142, 0xa, 0xf, false);
    v += (unsigned)__builtin_amdgcn_update_dpp(0, (int)v, 0x143, 0xc, 0xf, false);
    return v;
}
__device__ __forceinline__ unsigned umed3(unsigned a, unsigned b, unsigned c) { unsigned r; asm("v_med3_u32 %0, %1, %2, %3" : "=v"(r) : "v"(a), "v"(b), "v"(c)); return r; }
__device__ __forceinline__ void find_bin256(LAS unsigned* hist, int lane, int& k, int& bin, int& bincnt) {
    u32x4 h = *(const LAS u32x4*)(hist + 4 * lane);
#pragma unroll
    for (int c_ = 1; c_ < 8; ++c_) { const u32x4 hc = *(const LAS u32x4*)(hist + c_ * 256 + 4 * lane); h.x += hc.x; h.y += hc.y; h.z += hc.z; h.w += hc.w; }
    const unsigned ls = (h.x + h.y) + (h.z + h.w);
    const unsigned pre = dpp_scan64(ls);
    const unsigned tot = (unsigned)__builtin_amdgcn_readlane((int)pre, 63);
    const unsigned above = tot - pre;
    const bool mine = (above < (unsigned)k) && (above + ls >= (unsigned)k);
    unsigned c = above; int sub; unsigned cnt;
    if (c + h.w >= (unsigned)k) { sub = 3; cnt = h.w; } else { c += h.w; if (c + h.z >= (unsigned)k) { sub = 2; cnt = h.z; } else { c += h.z; if (c + h.y >= (unsigned)k) { sub = 1; cnt = h.y; } else { c += h.y; sub = 0; cnt = h.x; } } }
    const u64 bm = __ballot(mine);
    const int L = (int)__builtin_ctzll(bm | (1ull << 63));
    bin = 4 * L + __builtin_amdgcn_readlane(sub, L); const int ab = __builtin_amdgcn_readlane((int)c, L); bincnt = __builtin_amdgcn_readlane((int)cnt, L);
    k -= ab;
}
__device__ __forceinline__ void p3_load_row(const unsigned short* sc, int row, unsigned (&v)[32], int lane) {
    const int t = row & (SEQ - 1), n = t + 1;
    const int ngrp = (n <= TOPK) ? 0 : ((n + 1023) >> 10); const unsigned* srow = (const unsigned*)(sc + (size_t)row * SEQ) + lane;
#pragma unroll
    for (int g = 0; g < 4; ++g) if (g < ngrp) {
#pragma unroll
        for (int i = 0; i < 8; ++i) v[g * 8 + i] = srow[(g * 8 + i) * 64]; }
}
__device__ __forceinline__ unsigned p3_keys(unsigned w, int e0, int t) {
    unsigned x = w ^ 0x80008000u ^ (((w >> 15) & 0x00010001u) * 0x7fffu);
    if (e0 > t) x = 0u; else if (e0 + 1 > t) x &= 0xffffu;
    return x;
}
struct NoStage { __device__ __forceinline__ void operator()(int) const {} };
template <class LD = NoStage> __device__ __forceinline__ void p3_select_row(Frame& F, int row, LAS unsigned* hist, const unsigned (&key)[32], const LD& ld = LD()) {
    const int lane = F.lane, t = row & (SEQ - 1), n = t + 1;
    u64* mrow = (F.w<u64>(WS_MASK)) + (size_t)row * 64;
    if (n <= TOPK) {
        const int lo = lane * 64; unsigned we, wo;
        if (t >= lo + 63) { we = ~0u; wo = ~0u; } else if (t >= lo) { const int ce = ((t - lo) >> 1) + 1, co = (t - lo + 1) >> 1; we = (ce >= 32) ? ~0u : ((1u << ce) - 1u); wo = (co >= 32) ? ~0u : ((1u << co) - 1u); } else { we = 0u; wo = 0u; }
        mrow[lane] = ((u64)wo << 32) | (u64)we;
        ld(0); ld(1); ld(2); ld(3);
        return;
    }
    const int ngrp = (n + 1023) >> 10;
#define HZERO() do { _Pragma("unroll") for (int j_ = 0; j_ < 9; ++j_) { if (j_ < 8 || lane < 16) *(LAS u32x4*)(hist + 4 * lane + 256 * j_) = (u32x4){0u, 0u, 0u, 0u}; } LDS_WAIT(); } while (0)
    int k = TOPK, bin, bincnt; unsigned T; LAS unsigned* hmine = hist + (lane & 7) * 256;
    ld(0);
    unsigned m0 = 0u, m1 = 0u, m2 = 0u, m3 = 0u;
#pragma unroll
    for (int g = 0; g < 4; ++g) if (g < ngrp) {
#pragma unroll
        for (int i = 0; i < 8; ++i) { const unsigned kv = key[g * 8 + i], kA = kv & 0xffffu, kB = kv >> 16;
            m3 = umed3(m2, m3, kA); m2 = umed3(m1, m2, kA); m1 = umed3(m0, m1, kA); m0 = max(m0, kA);
            m3 = umed3(m2, m3, kB); m2 = umed3(m1, m2, kB); m1 = umed3(m0, m1, kB); m0 = max(m0, kB); } }
    const unsigned Lc = 0xffffu - wave_max_u32(0xffffu - m3);
    ld(1);
    HZERO();
#pragma unroll
    for (int g = 0; g < 4; ++g) if (g < ngrp) {
#pragma unroll
        for (int i = 0; i < 8; ++i) { const unsigned kv = key[g * 8 + i], kA = kv & 0xffffu, kB = kv >> 16;
            if (kA >= Lc) __hip_atomic_fetch_add(hmine + (kA >> 8), 1u, __ATOMIC_RELAXED, __HIP_MEMORY_SCOPE_WORKGROUP);
            if (kB >= Lc) __hip_atomic_fetch_add(hmine + (kB >> 8), 1u, __ATOMIC_RELAXED, __HIP_MEMORY_SCOPE_WORKGROUP); } }
    LDS_WAIT(); asm volatile("" ::: "memory");
    find_bin256(hist, lane, k, bin, bincnt); T = (unsigned)bin << 8;
    LDS_WAIT(); asm volatile("" ::: "memory");
    ld(2);
    if (bincnt != k) {
        const unsigned b0 = (unsigned)bin;
        HZERO();
#pragma unroll
        for (int g = 0; g < 4; ++g) if (g < ngrp) {
#pragma unroll
            for (int i = 0; i < 8; ++i) { const unsigned kv = key[g * 8 + i];
                if (((kv >> 8) & 0xffu) == b0 && (kv & 0xffffu) >= Lc) __hip_atomic_fetch_add(hmine + (kv & 0xffu), 1u, __ATOMIC_RELAXED, __HIP_MEMORY_SCOPE_WORKGROUP);
                if ((kv >> 24) == b0 && (kv >> 16) >= Lc) __hip_atomic_fetch_add(hmine + ((kv >> 16) & 0xffu), 1u, __ATOMIC_RELAXED, __HIP_MEMORY_SCOPE_WORKGROUP); } }
        LDS_WAIT(); asm volatile("" ::: "memory");
        find_bin256(hist, lane, k, bin, bincnt); T |= (unsigned)bin;
        LDS_WAIT(); asm volatile("" ::: "memory");
    }
#undef HZERO
    ld(3);
    T = max(T, Lc);
    const bool exact = (bincnt == k); const int krem = k;
    LAS u32x2* mw = (LAS u32x2*)(hist + 2112);
    mw[lane] = (u32x2){0u, 0u};
    if (exact) {
#pragma unroll
        for (int g = 0; g < 4; ++g) if (g < ngrp) {
#pragma unroll
            for (int i8 = 0; i8 < 8; ++i8) { const int i = g * 8 + i8; const unsigned kv = key[i]; const u64 bA = __ballot((kv & 0xffffu) >= T), bB = __ballot((kv >> 16) >= T);
                if (lane == 0) *(LAS u32x4*)(mw + 2 * i) = (u32x4){(unsigned)bA, (unsigned)bB, (unsigned)(bA >> 32), (unsigned)(bB >> 32)}; } }
    } else {
        const u64 lt_mask = (1ull << lane) - 1ull; int base_eq = 0;
#pragma unroll
        for (int g = 0; g < 4; ++g) if (g < ngrp) {
#pragma unroll
            for (int i8 = 0; i8 < 8; ++i8) { const int i = g * 8 + i8; const unsigned kv = key[i], kA = kv & 0xffffu, kB = kv >> 16;
                const bool eqA = kA == T, eqB = kB == T;
                const u64 beA = __ballot(eqA), beB = __ballot(eqB);
                const int rA = base_eq + __popcll(beA & lt_mask) + __popcll(beB & lt_mask), rB = rA + (eqA ? 1 : 0);
                const u64 bA = __ballot(kA > T || (eqA && rA < krem)), bB = __ballot(kB > T || (eqB && rB < krem));
                if (lane == 0) { mw[2 * i] = (u32x2){(unsigned)bA, (unsigned)bB}; mw[2 * i + 1] = (u32x2){(unsigned)(bA >> 32), (unsigned)(bB >> 32)}; }
                base_eq += __popcll(beA) + __popcll(beB); } }
    }
    LDS_WAIT(); asm volatile("" ::: "memory");
    { const u32x2 w = mw[lane]; mrow[lane] = ((u64)w.y << 32) | (u64)w.x; }
    LDS_WAIT(); asm volatile("" ::: "memory");
}
__device__ __forceinline__ void p3_select(Frame& F) {
    refresh(F);
    LAS unsigned* hist = (LAS unsigned*)(F.lds + F.wave * 9216);
    const unsigned short* sc = F.w<unsigned short>(WS_SC);
    for (int j = F.gw; j < 2048; j += F.ngw) {
        unsigned v[32], key[32];
        p3_load_row(sc, j, v, F.lane);
#pragma unroll 1
        for (int q = 0; q < 8; ++q) { const int b = q >> 1, t = (q & 1) ? (SEQ - 1 - j) : j, row = b * SEQ + t;
            const int n = t + 1;
            if (n > TOPK) {
                const int ngrp = (n + 1023) >> 10;
#pragma unroll
                for (int g = 0; g < 4; ++g) {
                    if (g < ngrp) {
#pragma unroll
                        for (int i = 0; i < 8; ++i) key[g * 8 + i] = p3_keys(v[g * 8 + i], (g * 8 + i) * 128 + 2 * F.lane, t);
                    } else {
#pragma unroll
                        for (int i = 0; i < 8; ++i) key[g * 8 + i] = 0u;
                    } }
            }
            if (q < 7) { const int q2 = q + 1, b2 = q2 >> 1, t2 = (q2 & 1) ? (SEQ - 1 - j) : j; p3_load_row(sc, b2 * SEQ + t2, v, F.lane); }
            p3_select_row(F, row, hist, key);
        }
    }
}

struct MiniJob { const float* src; unsigned char* dst; int ldw; };
__device__ __forceinline__ MiniJob mini_job(int mi, const float* w1, const float* w2, unsigned char* ws) {
    MiniJob j; const int it = mi >> 3, cg = mi & 7;
    if (it < MINI_W1_ITEMS) { const int e = it >> 6, q = it & 63, kb = q >> 3, nb = q & 7; j.ldw = 2048;
        j.src = w1 + (size_t)e * 1024 * 2048 + (size_t)(kb * 128) * 2048 + nb * 256 + cg * 32; j.dst = ws + WS_W1 + ((size_t)e * 2048 + nb * 256 + cg * 32) * 1024 + kb * 128; }
    else { const int r = it - MINI_W1_ITEMS, e = r >> 5, q = r & 31, kb = q >> 2, nb = q & 3; j.ldw = 1024;
        j.src = w2 + (size_t)e * 1024 * 1024 + (size_t)(kb * 128) * 1024 + nb * 256 + cg * 32; j.dst = ws + WS_W2 + ((size_t)e * 1024 + nb * 256 + cg * 32) * 1024 + kb * 128; }
    return j;
}
__device__ __forceinline__ void mini_load(const MiniJob& j, int lane, f32x4 (&cv)[16], int jj) {
    const float* p = j.src + (size_t)(4 * (lane >> 3)) * j.ldw + 4 * (lane & 7);
#pragma unroll
    for (int r = 0; r < 4; ++r) cv[jj * 4 + r] = __builtin_nontemporal_load((const f32x4*)(p + (size_t)(32 * jj + r) * j.ldw));
}
__device__ __forceinline__ void mini_finish(const MiniJob& j, int lane, const f32x4 (&cv)[16], LAS unsigned char* tile) {
    const int k4 = lane >> 3, p = lane & 7;
#pragma unroll
    for (int jj = 0; jj < 4; ++jj) { unsigned d[4];
#pragma unroll
        for (int r = 0; r < 4; ++r) { const f32x4 v = cv[jj * 4 + r]; d[r] = pk4_fp8(clamp448(v.x * W_PRESCALE), clamp448(v.y * W_PRESCALE), clamp448(v.z * W_PRESCALE), clamp448(v.w * W_PRESCALE)); }
        const unsigned a01l = __builtin_amdgcn_perm(d[1], d[0], 0x05010400u), a01h = __builtin_amdgcn_perm(d[1], d[0], 0x07030602u), a23l = __builtin_amdgcn_perm(d[3], d[2], 0x05010400u), a23h = __builtin_amdgcn_perm(d[3], d[2], 0x07030602u);
        const unsigned t0 = __builtin_amdgcn_perm(a23l, a01l, 0x05040100u), t1 = __builtin_amdgcn_perm(a23l, a01l, 0x07060302u), t2 = __builtin_amdgcn_perm(a23h, a01h, 0x05040100u), t3 = __builtin_amdgcn_perm(a23h, a01h, 0x07060302u);
        LAS unsigned char* tp = tile + (4 * p) * 144 + 32 * jj + 4 * k4;
        *(LAS unsigned*)tp = t0; *(LAS unsigned*)(tp + 144) = t1; *(LAS unsigned*)(tp + 288) = t2; *(LAS unsigned*)(tp + 432) = t3; }
    LDS_WAIT(); asm volatile("" ::: "memory");
    { const int n = lane >> 1, h = lane & 1;
#pragma unroll
      for (int i = 0; i < 4; ++i) { const u32x4 o = *(const LAS u32x4*)(tile + n * 144 + h * 64 + i * 16); *(u32x4*)(j.dst + (size_t)n * 1024 + h * 64 + i * 16) = o; } }
    LDS_WAIT(); asm volatile("" ::: "memory");
}
__device__ __forceinline__ void p2_scores_select(Frame& F) {
    refresh(F);
    const int lane = F.lane, wave = F.wave;
    const bf16* QI = F.w<bf16>(WS_QI); const bf16* KI = F.w<bf16>(WS_KI); const float* WI = F.w<float>(WS_WI); unsigned short* SC = F.w<unsigned short>(WS_SC);
    const float* w1 = F.in(IN_W1); const float* w2 = F.in(IN_W2);
    for (int unit = blockIdx.x; unit < 256; unit += F.G) {
        const int b = unit >> 6, p = unit & 63, na = p + 1;
        { LAS unsigned char* stile = F.lds + wave * 2560;
          int idx = (wave * 129) >> 3; const int end = ((wave + 1) * 129) >> 3;
          while (idx < end) { int qb, kb, len;
              if (idx < na) { qb = p; kb = idx; len = (na - idx < end - idx) ? (na - idx) : (end - idx); } else { qb = 127 - p; kb = idx - na; len = end - idx; }
              score_seg(b, qb, kb, len, QI, KI, WI, SC, stile, lane); idx += len; } }
        VM_WAIT(); __syncthreads();
        { refresh(F); const int lane = F.lane; int b_ = b, p_ = p, w_ = wave; asm volatile("" : "+s"(b_), "+s"(p_), "+s"(w_));
          LAS unsigned* hist = (LAS unsigned*)(F.lds + w_ * 9216);
          unsigned v[32], key[32];
#pragma unroll
          for (int i = 0; i < 32; ++i) { v[i] = 0u; key[i] = 0u; }
          auto rowof = [&](int q) { return b_ * SEQ + ((q & 1) ? 32 * (127 - p_) : 32 * p_) + 4 * w_ + (q >> 1); };
          p3_load_row(SC, rowof(0), v, lane);
#pragma unroll 1
          for (int q = 0; q < 8; ++q) { const int row = rowof(q), t = row & (SEQ - 1), n = t + 1;
              const MiniJob mj = mini_job(__builtin_amdgcn_readfirstlane((unit * 8 + w_) * 8 + q), w1, w2, F.ws); f32x4 cv[16];
              if (n > TOPK) {
                  const int ngrp = (n + 1023) >> 10;
#pragma unroll
                  for (int g = 0; g < 4; ++g) {
                      if (g < ngrp) {
#pragma unroll
                          for (int i = 0; i < 8; ++i) key[g * 8 + i] = p3_keys(v[g * 8 + i], (g * 8 + i) * 128 + 2 * lane, t);
                      } else {
#pragma unroll
                          for (int i = 0; i < 8; ++i) key[g * 8 + i] = 0u;
                      } }
              }
              if (q < 7) p3_load_row(SC, rowof(q + 1), v, lane);
              auto stage = [&](int part) { if (part == 0) mini_load(mj, lane, cv, 0); else if (part == 1) mini_load(mj, lane, cv, 1); else if (part == 2) mini_load(mj, lane, cv, 2); else mini_load(mj, lane, cv, 3); };
              p3_select_row(F, row, hist, key, stage);
              mini_finish(mj, lane, cv, F.lds + 73728 + w_ * 4608);
          } }
        VM_WAIT(); __syncthreads();
    }
}

__device__ __forceinline__ int t5_bucket(int n) {
    if (n < 16) return n;
    const int th[16] = {16, 19, 21, 24, 27, 31, 35, 40, 46, 52, 59, 67, 77, 87, 99, 113};
    int b = 16;
#pragma unroll
    for (int i = 1; i < 16; ++i) if (n >= th[i]) b = 16 + i;
    return b;
}
__device__ __forceinline__ void p4_attn_gather(Frame& F) {
    refresh(F);
    const float* rel_bias = F.in(IN_RELB);
    LAS float* biasl = (LAS float*)(F.lds);
    for (int i = F.tid; i < 1024; i += 512) { const int h = i >> 7, d = i & 127; biasl[i] = rel_bias[t5_bucket(d) * 8 + h] * LOG2E; }
    __syncthreads();
    const int lane = F.lane, h = lane >> 3;
    const float bias_far = rel_bias[31 * 8 + h] * LOG2E;
    for (int row = F.gw; row < NTOK; row += F.ngw) {
        const int t = row & (SEQ - 1), b0 = row - t, cnt = (t + 1 < TOPK) ? t + 1 : TOPK;
        const int* irow = (F.w<int>(WS_SELIDX)) + (size_t)row * 256;
        int myidx[4];
        { const u32x4 v = *(const u32x4*)(irow + lane * 4); myidx[0] = (int)v.x; myidx[1] = (int)v.y; myidx[2] = (int)v.z; myidx[3] = (int)v.w; }
        float q[8];
        { const u32x4 v = *(const u32x4*)((F.w<bf16>(WS_Q)) + (size_t)row * 512 + lane * 8); q[0] = bflo(v.x); q[1] = bfhi(v.x); q[2] = bflo(v.y); q[3] = bfhi(v.y); q[4] = bflo(v.z); q[5] = bfhi(v.z); q[6] = bflo(v.w); q[7] = bfhi(v.w); }
        float m = -1e30f, lsum = 0.f, o[8];
#pragma unroll
        for (int j = 0; j < 8; ++j) o[j] = 0.f;
        for (int c0 = 0; c0 < cnt; c0 += 8) {
            u32x4 kv[8], vv[8]; int kid[8]; float lg[8];
#pragma unroll
            for (int j = 0; j < 8; ++j) { const int kk = c0 + j; int id = __shfl(myidx[j & 3], kk >> 2); if (kk >= cnt) id = 0; kid[j] = id;
                kv[j] = *(const u32x4*)((F.w<bf16>(WS_K)) + (size_t)(b0 + id) * 512 + lane * 8); vv[j] = *(const u32x4*)((F.w<bf16>(WS_V)) + (size_t)(b0 + id) * 512 + lane * 8); }
            float cm = -1e30f;
#pragma unroll
            for (int j = 0; j < 8; ++j) { const u32x4 kx = kv[j];
                float d = q[0] * bflo(kx.x) + q[1] * bfhi(kx.x) + q[2] * bflo(kx.y) + q[3] * bfhi(kx.y) + q[4] * bflo(kx.z) + q[5] * bfhi(kx.z) + q[6] * bflo(kx.w) + q[7] * bfhi(kx.w);
                d += __shfl_xor(d, 1); d += __shfl_xor(d, 2); d += __shfl_xor(d, 4);
                const int dist = t - kid[j];
                const float bs = (dist < 128) ? biasl[h * 128 + (dist < 0 ? 0 : dist)] : bias_far;
                lg[j] = (c0 + j < cnt) ? d + bs : -INFINITY;
                cm = fmaxf(cm, lg[j]); }
            const float mn = fmaxf(m, cm), f = __builtin_amdgcn_exp2f(m - mn);
            lsum *= f;
#pragma unroll
            for (int i = 0; i < 8; ++i) o[i] *= f;
            m = mn;
#pragma unroll
            for (int j = 0; j < 8; ++j) { const float p = __builtin_amdgcn_exp2f(lg[j] - m); lsum += p; const u32x4 vx = vv[j];
                o[0] += p * bflo(vx.x); o[1] += p * bfhi(vx.x); o[2] += p * bflo(vx.y); o[3] += p * bfhi(vx.y); o[4] += p * bflo(vx.z); o[5] += p * bfhi(vx.z); o[6] += p * bflo(vx.w); o[7] += p * bfhi(vx.w); }
        }
        const float inv = 1.0f / lsum;
        u32x4 w; w.x = pk2(o[0] * inv, o[1] * inv); w.y = pk2(o[2] * inv, o[3] * inv); w.z = pk2(o[4] * inv, o[5] * inv); w.w = pk2(o[6] * inv, o[7] * inv);
        *(u32x4*)((F.w<bf16>(WS_AO)) + (size_t)row * 512 + lane * 8) = w;
    }
}

__device__ __forceinline__ void p4_attn_dense(Frame& F, char* lds_generic) {
    refresh(F);
    const float* rel_bias = F.in(IN_RELB);
    LAS float* lut8 = (LAS float*)(F.lds + TAB_OFF);
    for (int i = F.tid; i < 1024; i += 512) { const int h = i >> 7, d = i & 127; lut8[i] = (d < 113) ? (rel_bias[t5_bucket(d) * 8 + h] - rel_bias[31 * 8 + h]) * LOG2E : 0.f; }
    __syncthreads();
    const attn_body::AttnTensors AT{(const attn_body::bf16*)F.w<bf16>(WS_Q), (const attn_body::bf16*)F.w<bf16>(WS_K), (const attn_body::bf16*)F.w<bf16>(WS_V), (attn_body::bf16*)F.w<bf16>(WS_AO), (const unsigned long long*)F.w<u64>(WS_MASK)};
    const attn_body::StaticOrder S(F.G, (int)blockIdx.x, F.ctl() + CW_PANC);
    attn_body::attn_phase<attn_body::StaticOrder>(lds_generic, AT, lut8, S);
}
__device__ __forceinline__ void p7_router(Frame& F) {
    refresh(F);
    const float* w_router = F.in(IN_WR); const float* b_router = F.in(IN_BR); const float* ffn_norm = F.in(IN_FFNN);
    LAS float* X = (LAS float*)F.lds; LAS int* rt = (LAS int*)(F.lds + TAB_OFF); LAS float* LG = (LAS float*)(F.lds + TAB_OFF + 4096); LAS float* RS = (LAS float*)(F.lds + TAB_OFF + 8192);
    const int lane = F.lane, wave = F.wave, n = lane & 31, hi = lane >> 5;
    float bw[64];
#pragma unroll
    for (int q = 0; q < 16; ++q) { const int k0 = 128 * wave + 8 * q + 4 * hi; const f32x4 g = *(const f32x4*)(ffn_norm + k0);
        bw[4 * q] = w_router[(size_t)k0 * 32 + n] * g.x; bw[4 * q + 1] = w_router[(size_t)(k0 + 1) * 32 + n] * g.y; bw[4 * q + 2] = w_router[(size_t)(k0 + 2) * 32 + n] * g.z; bw[4 * q + 3] = w_router[(size_t)(k0 + 3) * 32 + n] * g.w; }
    const f32x4 g0 = *(const f32x4*)(ffn_norm + 8 * lane), g1 = *(const f32x4*)(ffn_norm + 8 * lane + 4), g2 = *(const f32x4*)(ffn_norm + 512 + 8 * lane), g3 = *(const f32x4*)(ffn_norm + 512 + 8 * lane + 4);
    if (F.tid < 32) rt[F.tid] = 0;
    const float brt = b_router[F.tid & 31];
    __syncthreads();
    for (int tg = blockIdx.x; tg < NTOK / 64; tg += F.G) {
        if (threadIdx.x == 0) { panel_poll(F, CW_PANB, tg >> 2, 4u); __builtin_amdgcn_fence(__ATOMIC_ACQUIRE, "agent"); asm volatile("s_waitcnt vmcnt(0)" ::: "memory"); }
        __syncthreads();
#pragma unroll 1
        for (int grp = 0; grp < 2; ++grp) {
            const int tokg = tg * 64 + grp * 32;
            { u32x4 xa[4], xb[4];
#pragma unroll
              for (int i = 0; i < 4; ++i) { const bf16* xr = F.w<bf16>(WS_X1) + (size_t)(tokg + 4 * wave + i) * D + 8 * lane; xa[i] = *(const u32x4*)xr; xb[i] = *(const u32x4*)(xr + 512); }
#pragma unroll
              for (int i = 0; i < 4; ++i) { const int t = 4 * wave + i;
                const f32x4 a0 = {bflo(xa[i].x), bfhi(xa[i].x), bflo(xa[i].y), bfhi(xa[i].y)}, a1 = {bflo(xa[i].z), bfhi(xa[i].z), bflo(xa[i].w), bfhi(xa[i].w)};
                const f32x4 b0 = {bflo(xb[i].x), bfhi(xb[i].x), bflo(xb[i].y), bfhi(xb[i].y)}, b1 = {bflo(xb[i].z), bfhi(xb[i].z), bflo(xb[i].w), bfhi(xb[i].w)};
                float ss = (a0.x * a0.x + a0.y * a0.y) + (a0.z * a0.z + a0.w * a0.w); ss += (a1.x * a1.x + a1.y * a1.y) + (a1.z * a1.z + a1.w * a1.w);
                ss += (b0.x * b0.x + b0.y * b0.y) + (b0.z * b0.z + b0.w * b0.w); ss += (b1.x * b1.x + b1.y * b1.y) + (b1.z * b1.z + b1.w * b1.w);
                LAS float* xrow = X + t * 1024; const int sw = t & 15;
                *(LAS f32x4*)(xrow + (((2 * lane) ^ sw) << 2)) = a0; *(LAS f32x4*)(xrow + (((2 * lane + 1) ^ sw) << 2)) = a1;
                *(LAS f32x4*)(xrow + (((128 + 2 * lane) ^ sw) << 2)) = b0; *(LAS f32x4*)(xrow + (((129 + 2 * lane) ^ sw) << 2)) = b1;
                const float rstd = 1.0f / sqrtf(wave_sum(ss) * (1.f / D) + RMS_EPS), rp = rstd * H_PRESCALE;
                if (lane == 0) RS[t] = rstd;
                unsigned char* hr = F.w<unsigned char>(WS_H) + (size_t)(tokg + t) * D + 8 * lane;
                u32x2 o;
                o.x = pk4_fp8(a0.x * rp * g0.x, a0.y * rp * g0.y, a0.z * rp * g0.z, a0.w * rp * g0.w); o.y = pk4_fp8(a1.x * rp * g1.x, a1.y * rp * g1.y, a1.z * rp * g1.z, a1.w * rp * g1.w); *(u32x2*)hr = o;
                o.x = pk4_fp8(b0.x * rp * g2.x, b0.y * rp * g2.y, b0.z * rp * g2.z, b0.w * rp * g2.w); o.y = pk4_fp8(b1.x * rp * g3.x, b1.y * rp * g3.y, b1.z * rp * g3.z, b1.w * rp * g3.w); *(u32x2*)(hr + 512) = o; } }
            __syncthreads();
            f32x16 acc;
#pragma unroll
            for (int i = 0; i < 16; ++i) acc[i] = 0.f;
            { const LAS float* xrow = X + n * 1024; const int sw = n & 15;
#pragma unroll
              for (int q = 0; q < 16; ++q) { const f32x4 a = *(const LAS f32x4*)(xrow + (((32 * wave + 2 * q + hi) ^ sw) << 2));
                acc = __builtin_amdgcn_mfma_f32_32x32x2f32(a.x, bw[4 * q], acc, 0, 0, 0); acc = __builtin_amdgcn_mfma_f32_32x32x2f32(a.y, bw[4 * q + 1], acc, 0, 0, 0);
                acc = __builtin_amdgcn_mfma_f32_32x32x2f32(a.z, bw[4 * q + 2], acc, 0, 0, 0); acc = __builtin_amdgcn_mfma_f32_32x32x2f32(a.w, bw[4 * q + 3], acc, 0, 0, 0); } }
            __syncthreads();
            { LAS float* P = X + wave * 1024;
#pragma unroll
              for (int i = 0; i < 16; ++i) P[((i & 3) + 8 * (i >> 2) + 4 * hi) * 32 + n] = acc[i]; }
            __syncthreads();
#pragma unroll
            for (int o = 0; o < 2; ++o) { const int idx = F.tid + 512 * o; float s = X[idx];
#pragma unroll
                for (int w = 1; w < 8; ++w) s += X[w * 1024 + idx];
                LG[idx] = s * RS[idx >> 5] + brt; }
            __syncthreads();
#pragma unroll 1
            for (int pass = 0; pass < 2; ++pass) {
                const int t0 = 4 * wave + 2 * pass, tok0 = tokg + t0;
                f32x2 lg; lg.x = LG[t0 * 32 + (lane >> 1)]; lg.y = LG[(t0 + 1) * 32 + (lane >> 1)];
#pragma unroll
                for (int tk = 0; tk < 2; ++tk) {
                    const float v = (tk ? lg.y : lg.x) + 0.f;
                    unsigned sk = sortable(v);
                    float tv[4]; int te[4];
#pragma unroll
                    for (int r = 0; r < 4; ++r) { const unsigned mk = wave_max_u32(sk); const u64 bal = __ballot(sk == mk); const int ln = (int)__builtin_ctzll(bal | (1ull << 63)); const int bi = ln >> 1;
                        tv[r] = __int_as_float(__builtin_amdgcn_readlane(__float_as_int(v), ln)); te[r] = bi; sk = ((lane >> 1) == bi) ? 0u : sk; }
                    const float e1 = __expf(tv[1] - tv[0]), e2 = __expf(tv[2] - tv[0]), e3 = __expf(tv[3] - tv[0]), inv = 1.0f / (1.0f + e1 + e2 + e3);
                    const float gt[4] = {inv, e1 * inv, e2 * inv, e3 * inv};
                    if (lane == 0) { const int tok = tok0 + tk, sl = (tok - tg * 64) * 4;
#pragma unroll
                        for (int r = 0; r < 4; ++r) { const int lp = __hip_atomic_fetch_add(rt + te[r], 1, __ATOMIC_RELAXED, __HIP_MEMORY_SCOPE_WORKGROUP); rt[64 + sl + r] = te[r]; rt[320 + sl + r] = lp; (F.w<float>(WS_TOKGATE))[(size_t)tok * 4 + r] = gt[r]; } }
                }
            }
        }
        __syncthreads();
        if (F.tid < 32) { const int c = rt[F.tid]; int base = 0; if (c) base = (int)__hip_atomic_fetch_add(F.ctl() + CW_ECNT + 64 * F.tid, (unsigned)c, RLX_AGENT); rt[32 + F.tid] = base; }
        __syncthreads();
        if (F.tid < 256) { const int e = rt[64 + F.tid], pos = rt[32 + e] + rt[320 + F.tid]; (F.w<int>(WS_LIST))[(size_t)e * NTOK + pos] = (tg * 64 + (F.tid >> 2)) * 4 + (F.tid & 3); }
        __syncthreads();
        if (F.tid < 32) rt[F.tid] = 0;
        __syncthreads();
    }
}
__device__ __forceinline__ void moe_rows_fill(Frame& F, const int* list, const float* tokgate, const float* b2) {
    const LAS int* tab = (const LAS int*)(F.lds + TAB_OFF); LAS int* rows = (LAS int*)(F.lds + TAB_OFF + 4096); LAS float* bias = (LAS float*)(F.lds + BIAS_OFF);
    const int T = tab[64], nwg = T * 4;
    for (int q = F.tid; q < 5 * 256; q += 512) { const int i = q >> 8, r = q & 255; const long L = (long)i * F.G + (int)blockIdx.x; int ts = 0; float g = 0.f;
        float bv = 0.f;
        if (L < nwg) { const int wgid = pg8::xcd_remap((int)L, nwg), mt = wgid >> 2, pn = wgid & 3; const int te = tab[128 + mt], e = te >> 16, lt = te & 0xffff, cnt = tab[e], pos = lt * 256 + r;
            if (pos < cnt) { ts = list[(size_t)e * NTOK + pos]; g = tokgate[ts]; }
            bv = b2[(size_t)e * 1024 + pn * 256 + r]; }
        rows[2 * q] = ts; rows[2 * q + 1] = __float_as_int(g); bias[q] = bv; }
    __syncthreads();
}
__device__ __forceinline__ void build_moe_tab(Frame& F) {
    refresh(F);
    LAS int* tab = (LAS int*)(F.lds + TAB_OFF);
    if (F.tid < 32) tab[F.tid] = (int)__hip_atomic_load(F.ctl() + CW_ECNT + 64 * F.tid, RLX_AGENT);
    __syncthreads();
    if (F.tid == 0) { int off = 0, T = 0;
        for (int e = 0; e < 32; ++e) { const int c = tab[e], nt = (c + 255) >> 8; tab[32 + e] = off; for (int lt = 0; lt < nt; ++lt) tab[128 + T++] = (e << 16) | lt; off += nt * 256; }
        tab[64] = T; }
    __syncthreads();
}
struct FinRow { u32x2 x[4]; unsigned y[4][4]; };
__device__ __forceinline__ void p10_load(FinRow& r, const bf16* x1, const unsigned char* ys, int m, int lane) {
    const u32x2* xr = (const u32x2*)(x1 + (size_t)m * D) + lane;
#pragma unroll
    for (int j = 0; j < 4; ++j) r.x[j] = __builtin_nontemporal_load(xr + 64 * j);
#pragma unroll
    for (int kq = 0; kq < 4; ++kq) { const unsigned* yr = (const unsigned*)(ys + ((size_t)m * 4 + kq) * D) + lane;
#pragma unroll
        for (int j = 0; j < 4; ++j) r.y[kq][j] = __builtin_nontemporal_load(yr + 64 * j); }
}
__device__ __forceinline__ void p10_row(const FinRow& r, const float* final_norm, float* out, int m, int lane) {
    f32x4 v[4]; float s = 0.f;
#pragma unroll
    for (int j = 0; j < 4; ++j) { f32x4 ysum = {0.f, 0.f, 0.f, 0.f};
#pragma unroll
        for (int kq = 0; kq < 4; ++kq) { const int y = (int)r.y[kq][j]; const auto lo = __builtin_amdgcn_cvt_pk_f32_fp8(y, false), hi2 = __builtin_amdgcn_cvt_pk_f32_fp8(y, true); ysum.x += lo[0]; ysum.y += lo[1]; ysum.z += hi2[0]; ysum.w += hi2[1]; }
        v[j] = (f32x4){bflo(r.x[j].x), bfhi(r.x[j].x), bflo(r.x[j].y), bfhi(r.x[j].y)} + ysum * (1.0f / YS_PRESCALE);
        s += (v[j].x * v[j].x + v[j].y * v[j].y) + (v[j].z * v[j].z + v[j].w * v[j].w); }
    const float rstd = 1.0f / sqrtf(wave_sum(s) * (1.f / D) + RMS_EPS);
    const f32x4* gr = (const f32x4*)final_norm + lane; f32x4* o = (f32x4*)(out + (size_t)m * D) + lane;
#pragma unroll
    for (int j = 0; j < 4; ++j) { const f32x4 g = gr[64 * j]; __builtin_nontemporal_store(v[j] * rstd * g, o + 64 * j); }
}
__device__ __forceinline__ void p10_final(Frame& F) {
    refresh(F);
    const float* final_norm = F.in(IN_FINN); float* out = F.outp();
    const bf16* x1 = F.w<bf16>(WS_X1); const unsigned char* ys = F.w<unsigned char>(WS_YS);
    const int lane = F.lane, st = F.ngw;
    FinRow A, B; int m = F.gw;
    if (m < NTOK) p10_load(A, x1, ys, m, lane);
    while (m < NTOK) {
        const int m2 = m + st, m3 = m2 + st;
        if (m2 < NTOK) p10_load(B, x1, ys, m2, lane);
        p10_row(A, final_norm, out, m, lane);
        if (m3 < NTOK) p10_load(A, x1, ys, m3, lane);
        if (m2 < NTOK) p10_row(B, final_norm, out, m2, lane);
        m = m3;
    }
}

__global__ void __launch_bounds__(NWAVES * 64, 2) fwd_kernel(Args args) {
    extern __shared__ __attribute__((aligned(16))) unsigned char lds[];
    Frame F;
    F.lds = (LAS unsigned char*)lds;
    F.tid = threadIdx.x; F.lane = F.tid & 63; F.wave = __builtin_amdgcn_readfirstlane(F.tid >> 6);
    F.G = gridDim.x; F.gw = blockIdx.x * NWAVES + F.wave; F.ngw = F.G * NWAVES;
    F.ws = args.ws;
    for (int u = F.tid; u < (LDS_BYTES - LDSCTL_OFF) / 4; u += NWAVES * 64) ((LAS unsigned*)(F.lds + LDSCTL_OFF))[u] = 0u;
    __syncthreads();
    XcdBarrier bar = xcd_barrier_post(F.ctl() + CW_BAR, (volatile LAS unsigned*)(F.lds + MISC_OFF) + 8);
    const int bx = (int)blockIdx.x;

    REP(0) p0_prologue(F);
    xcd_barrier(bar);
    {
      { pg8::DenseSched S; S.init(NTOK, 1024, 1024, F.w<bf16>(WS_WINI), F.G, bx);
        EpiInProj<true> E{F.w<bf16>(WS_ZPOOL), F.w<bf16>(WS_Q), F.w<bf16>(WS_K), F.w<bf16>(WS_V), F.w<bf16>(WS_QI), F.w<bf16>(WS_KI), F.w<bf16>(WS_GATE), F.w<float>(WS_WI)};
        pg8::gemm_phase<EpiInProj<true>, pg8::DenseSched, true>(F.lds, (const char*)F.w<bf16>(WS_H), 1024, S, E); }
      { pg8::DenseSched S; S.init(NTOK, 3584, 512, F.w<bf16>(WS_WIN), F.G, bx, 1);
        EpiInProj<false> E{F.w<bf16>(WS_ZPOOL), F.w<bf16>(WS_Q), F.w<bf16>(WS_K), F.w<bf16>(WS_V), F.w<bf16>(WS_QI), F.w<bf16>(WS_KI), F.w<bf16>(WS_GATE), F.w<float>(WS_WI)};
        pg8::gemm_phase<EpiInProj<false>, pg8::DenseSched, true, true, 0x78787878, 0x7c7c7c7c>(F.lds, (const char*)F.w<bf16>(WS_H8X), 512, S, E);
        { const int nidle = S.split ? 128 : F.G; if (bx < nidle) p0_copy<true>(F, IT_W1_END - NW1T + bx, IT_W1_END, nidle, 1 << 30, 0); } } }
    xcd_barrier(bar);
    REP(2) { p2_pooled(F); p2_scores_select(F); }
    xcd_barrier(bar);
    { pg8::DenseSched S; S.init(NTOK, 1024, 512, (F.w<bf16>(WS_WPC)), F.G, bx);
      EpiGate<false> E{(F.w<bf16>(WS_MERGED)), (F.w<bf16>(WS_GATE)), 0};
      pg8::gemm_phase<EpiGate<false>, pg8::DenseSched, true>(F.lds, (const char*)(F.w<bf16>(WS_POOLED)), 512, S, E); }
    REP(4) p4_attn_dense(F, (char*)lds);
    panel_wait(F, CW_PANC, 8u);
    { pg8::DenseSched S; S.init(NTOK, 1024, 256, (F.w<bf16>(WS_WBA)), F.G, bx);
      EpiGate<true> E{(F.w<bf16>(WS_MERGED)), (F.w<bf16>(WS_GATE)), 1024};
      pg8::gemm_phase<EpiGate<true>, pg8::DenseSched, true, true, 0x78787878, 0x78787878>(F.lds, (const char*)(F.w<bf16>(WS_AO)), 256, S, E);
      }
    panel_signal(F, CW_PANA);
    panel_wait(F, CW_PANA, 4u);
    REP(6) { pg8::DenseSched S; S.init(NTOK, 1024, 1024, (F.w<bf16>(WS_WOUT)), F.G, bx);
      EpiResidual E{F.in(IN_X), F.w<bf16>(WS_X1)};
      pg8::gemm_phase<EpiResidual, pg8::DenseSched, true>(F.lds, (const char*)(F.w<bf16>(WS_MERGED)), 1024, S, E);
      }
    panel_signal(F, CW_PANB);
    p7_router(F);
    xcd_barrier(bar);
    build_moe_tab(F); moe_gather_fill(F, F.w<int>(WS_LIST), F.in(IN_B1));
    REP(8) { MoeSched1 S{(const LAS int*)(F.lds + TAB_OFF), (const LAS int*)(F.lds + TAB_OFF + 4096), (const char*)(F.w<bf16>(WS_W1)), F.G, bx};
      EpiSwiGLU E{F.w<unsigned char>(WS_ACT), (const LAS float*)(F.lds + BIAS_OFF)};
      pg8::gemm_phase<EpiSwiGLU, MoeSched1, true, true, 0x78787878, 0x7c7c7c7c>(F.lds, (const char*)(F.w<bf16>(WS_H)), 512, S, E); }
    { const int T = ((const LAS int*)(F.lds + TAB_OFF))[64], rem = (T * 8) % F.G, nid = F.G - rem, base = IT_END - NW2T; int cover = nid * TAIL_PER; if (cover > NW2T) cover = NW2T;
      if (bx >= rem) p0_copy<true>(F, base + (bx - rem), base + cover, nid, 1 << 30, 0);
      if (cover < NW2T) p0_copy<true>(F, base + cover + bx, IT_END, F.G, 1 << 30, 0); }
    xcd_barrier(bar);
    moe_rows_fill(F, F.w<int>(WS_LIST), F.w<float>(WS_TOKGATE), F.in(IN_B2));
    REP(9) { MoeSched2 S{(const LAS int*)(F.lds + TAB_OFF), (const char*)(F.w<bf16>(WS_W2)), F.G, bx};
      EpiMoeOut E{F.w<unsigned char>(WS_YS), (const LAS float*)(F.lds + BIAS_OFF), (const LAS int*)(F.lds + TAB_OFF + 4096)};
      pg8::gemm_phase<EpiMoeOut, MoeSched2, true, true, 0x78787878, 0x7d7d7d7d>(F.lds, (const char*)(F.w<bf16>(WS_ACT)), 512, S, E); }
    xcd_barrier(bar);
    REP(10) p10_final(F);
}

#ifndef PROBE_PH
#define PROBE_PH -1
#endif
#if PROBE_PH >= 0
__global__ void __launch_bounds__(NWAVES * 64, 2) probe_kernel(Args args) {
    extern __shared__ __attribute__((aligned(16))) unsigned char lds[];
    Frame F; F.lds = (LAS unsigned char*)lds; F.tid = threadIdx.x; F.lane = F.tid & 63; F.wave = __builtin_amdgcn_readfirstlane(F.tid >> 6);
    F.G = gridDim.x; F.gw = blockIdx.x * NWAVES + F.wave; F.ngw = F.G * NWAVES; F.ws = args.ws;
    if (PROBE_PH == 0) p0_prologue(F);
    if (PROBE_PH == 2) { p2_pooled(F); p2_scores_select(F); }
    if (PROBE_PH == 3) p3_select(F);
    if (PROBE_PH == 4) p4_attn_gather(F);
    if (PROBE_PH == 10) p10_final(F);
    if (PROBE_PH == 20) p2_scores_select(F);
    if (PROBE_PH == 21) p2_pooled(F);
    const int bx = (int)blockIdx.x;
    if (PROBE_PH == 1) {
      { pg8::DenseSched S; S.init(NTOK, 1024, 1024, F.w<bf16>(WS_WINI), F.G, bx);
        EpiInProj<true> E{F.w<bf16>(WS_ZPOOL), F.w<bf16>(WS_Q), F.w<bf16>(WS_K), F.w<bf16>(WS_V), F.w<bf16>(WS_QI), F.w<bf16>(WS_KI), F.w<bf16>(WS_GATE), F.w<float>(WS_WI)};
        pg8::gemm_phase<EpiInProj<true>, pg8::DenseSched, true>(F.lds, (const char*)F.w<bf16>(WS_H), 1024, S, E); }
      { pg8::DenseSched S; S.init(NTOK, 3584, 512, F.w<bf16>(WS_WIN), F.G, bx, 1);
        EpiInProj<false> E{F.w<bf16>(WS_ZPOOL), F.w<bf16>(WS_Q), F.w<bf16>(WS_K), F.w<bf16>(WS_V), F.w<bf16>(WS_QI), F.w<bf16>(WS_KI), F.w<bf16>(WS_GATE), F.w<float>(WS_WI)};
        pg8::gemm_phase<EpiInProj<false>, pg8::DenseSched, true, true, 0x78787878, 0x7c7c7c7c>(F.lds, (const char*)F.w<bf16>(WS_H8X), 512, S, E); } }
    if (PROBE_PH == 6) { pg8::DenseSched S; S.init(NTOK, 1024, 1024, F.w<bf16>(WS_WOUT), F.G, bx);
      EpiResidual E{F.in(IN_X), F.w<bf16>(WS_X1)};
      pg8::gemm_phase<EpiResidual, pg8::DenseSched, true>(F.lds, (const char*)F.w<bf16>(WS_MERGED), 1024, S, E); }
    if (PROBE_PH == 7) p7_router(F);
    if (PROBE_PH == 8) { build_moe_tab(F); moe_gather_fill(F, F.w<int>(WS_LIST), F.in(IN_B1)); MoeSched1 S{(const LAS int*)(F.lds + TAB_OFF), (const LAS int*)(F.lds + TAB_OFF + 4096), (const char*)F.w<bf16>(WS_W1), F.G, bx};
      EpiSwiGLU E{F.w<unsigned char>(WS_ACT), (const LAS float*)(F.lds + BIAS_OFF)};
      pg8::gemm_phase<EpiSwiGLU, MoeSched1, true, true, 0x78787878, 0x7c7c7c7c>(F.lds, (const char*)F.w<bf16>(WS_H), 512, S, E); }
    if (PROBE_PH == 9) { build_moe_tab(F); moe_rows_fill(F, F.w<int>(WS_LIST), F.w<float>(WS_TOKGATE), F.in(IN_B2)); MoeSched2 S{(const LAS int*)(F.lds + TAB_OFF), (const char*)F.w<bf16>(WS_W2), F.G, bx};
      EpiMoeOut E{F.w<unsigned char>(WS_YS), (const LAS float*)(F.lds + BIAS_OFF), (const LAS int*)(F.lds + TAB_OFF + 4096)};
      pg8::gemm_phase<EpiMoeOut, MoeSched2, true, true, 0x78787878, 0x7d7d7d7d>(F.lds, (const char*)F.w<bf16>(WS_ACT), 512, S, E); }
    if (PROBE_PH == 40) p4_attn_dense(F, (char*)lds);
    if (PROBE_PH == 99) { }
}
#endif

extern "C" void kernel_launch(void* const* d_in, const int* in_sizes, int n_in, void* d_out, int out_size, void* d_ws, size_t ws_size, hipStream_t stream) {
    static int grid = 0;
    if (grid == 0) {
        if (n_in != 17 || in_sizes[0] != NTOK * D || out_size != NTOK * D || ws_size < WS_END) { fprintf(stderr, "kernel_launch: unexpected problem shape (n_in %d, in0 %d, out %d, ws %zu)\n", n_in, n_in > 0 ? in_sizes[0] : -1, out_size, ws_size); grid = -1; return; }
        int dev = 0, cus = 0, per_cu = 0;
        if (hipGetDevice(&dev) != hipSuccess || hipDeviceGetAttribute(&cus, hipDeviceAttributeMultiprocessorCount, dev) != hipSuccess) { grid = -1; return; }
        if (hipFuncSetAttribute((const void*)fwd_kernel, hipFuncAttributeMaxDynamicSharedMemorySize, LDS_BYTES) != hipSuccess) { fprintf(stderr, "kernel_launch: hipFuncSetAttribute failed\n"); grid = -1; return; }
        if (hipOccupancyMaxActiveBlocksPerMultiprocessor(&per_cu, (const void*)fwd_kernel, NWAVES * 64, LDS_BYTES) != hipSuccess || per_cu < 1) fprintf(stderr, "kernel_launch: occupancy query reports %d\n", per_cu);
#if PROBE_PH >= 0
        (void)hipFuncSetAttribute((const void*)probe_kernel, hipFuncAttributeMaxDynamicSharedMemorySize, LDS_BYTES);
#endif
        (void)hipGetLastError();
        grid = cus;
    }
    if (grid < 0) return;
    if (hipMemsetAsync((char*)d_ws + WS_CTL, 0, CTL_ZERO_BYTES, stream) != hipSuccess) return;
    Args a{};
    for (int i = 0; i < 17; ++i) a.in[i] = (const float*)d_in[i];
    a.out = (float*)d_out; a.ws = (unsigned char*)d_ws;
    hipLaunchKernelGGL(fwd_kernel, dim3(grid), dim3(NWAVES * 64), LDS_BYTES, stream, a);
#if PROBE_PH >= 0
    hipLaunchKernelGGL(probe_kernel, dim3(grid), dim3(NWAVES * 64), LDS_BYTES, stream, a);
#endif
}
```

```cpp
#include <hip/hip_runtime.h>
#include <cstdio>
#include <cstdint>
#include <hip/hip_bf16.h>
#include <cmath>
#ifndef DUP
#define DUP 0
#endif
#define REP(k) for (int rep_ = 0; rep_ < 1 + ((DUP >> (k)) & 1); ++rep_)

#define LAS __attribute__((address_space(3)))
#define GAS __attribute__((address_space(1)))
typedef unsigned short bf16;
typedef short bf16x8 __attribute__((ext_vector_type(8)));
typedef float f32x4 __attribute__((ext_vector_type(4)));
typedef float f32x2 __attribute__((ext_vector_type(2)));
typedef float f32x16 __attribute__((ext_vector_type(16)));
typedef unsigned u32x4 __attribute__((ext_vector_type(4)));
typedef unsigned u32x2 __attribute__((ext_vector_type(2)));
typedef unsigned long long u64;

constexpr int NB = 4, SEQ = 4096, NTOK = NB * SEQ, D = 1024;
constexpr int DIN = 4420, DINP = 4608;
constexpr int NE = 32, DFF = 1024, TOPK = 256;
constexpr float RMS_EPS = 1e-5f;
constexpr float LOG2E = 1.4426950408889634f;
constexpr float QSCALE = 0.125f * LOG2E;
constexpr int ACT_ROWS = 73728;
constexpr int NWAVES = 8;

constexpr size_t MiB = 1u << 20;
constexpr size_t WS_CTL = 0, CTL_ZERO_BYTES = 128 * 1024;
constexpr size_t WS_WIN = 2 * MiB;
constexpr size_t WS_WINI = 6 * MiB;
constexpr size_t WS_H8X = 80 * MiB;
constexpr size_t WS_WPC = 11 * MiB;
constexpr size_t WS_WBA = 12 * MiB;
constexpr size_t WS_WOUT = 13 * MiB;
constexpr size_t WS_W1 = 16 * MiB;
constexpr size_t WS_W2 = 144 * MiB;
constexpr size_t WS_H = 208 * MiB;
constexpr size_t WS_ZPOOL = 240 * MiB;
constexpr size_t WS_Q = 256 * MiB, WS_K = 272 * MiB, WS_V = 288 * MiB;
constexpr size_t WS_QI = 304 * MiB;
constexpr size_t WS_KI = 312 * MiB;
constexpr size_t WS_WI = 314 * MiB;
constexpr size_t WS_GATE = 316 * MiB;
constexpr size_t WS_POOLED = 380 * MiB;
constexpr size_t WS_AO = 396 * MiB;
constexpr size_t WS_MERGED = 412 * MiB;
constexpr size_t WS_X1 = 444 * MiB;
constexpr size_t WS_SC = 508 * MiB;
constexpr size_t WS_YS = 508 * MiB;
constexpr size_t WS_MASK = 764 * MiB;
constexpr size_t WS_SELIDX = 772 * MiB;
constexpr size_t WS_TOKGATE = 788 * MiB;
constexpr size_t WS_LIST = 790 * MiB;
constexpr size_t WS_ACT = 792 * MiB;
constexpr size_t WS_END = 936 * MiB;
constexpr int CW_BAR = 4096;
constexpr int CW_ECNT = 16384;
constexpr int CW_PANA = 18432, CW_PANB = 20480, CW_PANC = 22528, CW_PAND = 24576, CW_PANE = 26624;

constexpr int RING_BYTES = 131072;
constexpr int LDSCTL_OFF = RING_BYTES, MISC_OFF = LDSCTL_OFF + 320;
constexpr int TAB_OFF = RING_BYTES + 1024;
constexpr int LDS_BYTES = 163840;
constexpr int BIAS_OFF = TAB_OFF + 14336;

#define RLX_AGENT __ATOMIC_RELAXED, __HIP_MEMORY_SCOPE_AGENT
#define LDS_WAIT() asm volatile("s_waitcnt lgkmcnt(0)" ::: "memory")
#define VM_WAIT() asm volatile("s_waitcnt vmcnt(0)" ::: "memory")
#define STORE16_WT(p, v) asm volatile("global_store_dwordx4 %0, %1, off sc0 sc1\n\ts_nop 1" :: "v"((GAS void*)(p)), "v"(v) : "memory")
#define STORE8_WT(p, v)  asm volatile("global_store_dwordx2 %0, %1, off sc0 sc1\n\ts_nop 1" :: "v"((GAS void*)(p)), "v"(v) : "memory")
__device__ __forceinline__ unsigned f2bf(float f) { unsigned u = __builtin_bit_cast(unsigned, f); return (u + 0x7fffu + ((u >> 16) & 1u)) >> 16; }
__device__ __forceinline__ unsigned pk2(float lo, float hi) { return f2bf(lo) | (f2bf(hi) << 16); }
__device__ __forceinline__ float bflo(unsigned w) { return __uint_as_float(w << 16); }
__device__ __forceinline__ float bfhi(unsigned w) { return __uint_as_float(w & 0xffff0000u); }
__device__ __forceinline__ unsigned cvt_pk_bf16(float lo, float hi) { unsigned r; asm volatile("v_cvt_pk_bf16_f32 %0, %1, %2" : "=v"(r) : "v"(lo), "v"(hi)); return r; }
#define DPPF(v, ctrl, rmask) __int_as_float(__builtin_amdgcn_update_dpp(0, __float_as_int(v), ctrl, rmask, 0xf, false))
#define DPPU(v, ctrl, rmask) ((unsigned)__builtin_amdgcn_update_dpp(0, (int)(v), ctrl, rmask, 0xf, false))
__device__ __forceinline__ float wave_sum(float v) {
    v += DPPF(v, 0x111, 0xf); v += DPPF(v, 0x112, 0xf); v += DPPF(v, 0x114, 0xf); v += DPPF(v, 0x118, 0xf); v += DPPF(v, 0x142, 0xa); v += DPPF(v, 0x143, 0xc);
    return __int_as_float(__builtin_amdgcn_readlane(__float_as_int(v), 63));
}
__device__ __forceinline__ unsigned wave_max_u32(unsigned v) {
    v = max(v, DPPU(v, 0x111, 0xf)); v = max(v, DPPU(v, 0x112, 0xf)); v = max(v, DPPU(v, 0x114, 0xf)); v = max(v, DPPU(v, 0x118, 0xf)); v = max(v, DPPU(v, 0x142, 0xa)); v = max(v, DPPU(v, 0x143, 0xc));
    return (unsigned)__builtin_amdgcn_readlane((int)v, 63);
}
__device__ __forceinline__ float sigmoidf_(float x) { return __builtin_amdgcn_rcpf(1.0f + __builtin_amdgcn_exp2f(x * -1.4426950408889634f)); }

namespace pg8 {
constexpr int BM = 256, BK = 64, HALF = 128, HTB = HALF * BK * 2, STAGE_BYTES = 8 * HTB, NXCD = 8, WGM = 8;
__host__ __device__ __forceinline__ int lds_byte(int r, int c) { const int st = (r >> 4) * 2 + (c >> 5), rr = r & 15, cc = c & 31, ob = rr * 64 + cc * 2; return st * 1024 + (ob ^ (((ob >> 9) & 1) << 5)); }
__host__ __device__ __forceinline__ void stage_rc(int b, int& R, int& C) { const int st = b / 1024, sb = b % 1024, swz = sb ^ (((sb >> 9) & 1) << 5); R = (st >> 1) * 16 + swz / 64; C = (st & 1) * 32 + (swz % 64) / 2; }
__host__ __device__ __forceinline__ int perm32(int rho) { const int n = rho >> 4, i = rho & 15; return 8 * (i >> 2) + 4 * n + (i & 3); }

struct LaneRC { int R[2], C[2]; };
struct Unit { unsigned aoff[2][2]; const char* b0; const char* b1; int row0; int pn; int aux; int aux2; int aux3; int raw; };

__device__ __forceinline__ int xcd_remap(int L, int nwg) { const int q = nwg / NXCD, r = nwg % NXCD, xcd = L % NXCD, off = L / NXCD; return (xcd < r ? xcd * (q + 1) : r * (q + 1) + (xcd - r) * q) + off; }

struct DenseSched {
    int nM, nN, nwg, G, c, K; const char* Bt;
    __device__ __forceinline__ void init(int M, int N, int K_, const void* Bt_, int G_, int c_, int split_ = 0) { nM = M / BM; nN = N / BM; nwg = nM * nN; G = G_; c = c_; K = K_; Bt = (const char*)Bt_; split = (split_ && G_ == 256 && nwg == 896) ? 1 : 0; }
    int split;
    __device__ __forceinline__ bool next(int i, Unit& u, const LaneRC& rc) const {
        long L = (long)i * G + c;
        if (split) { if (i >= 3) { if (c < 128 || i >= 4) return false; L = 768 + (c - 128); } }
        if (L >= nwg) return false;
        const int wgid = xcd_remap((int)L, nwg);
        const int nig = WGM * nN, gid = wgid / nig, fm = gid * WGM, gsz = (nM - fm) < WGM ? (nM - fm) : WGM;
        const int pm = fm + ((wgid % nig) % gsz), pn = (wgid % nig) / gsz;
#pragma unroll
        for (int h = 0; h < 2; ++h)
#pragma unroll
            for (int i2 = 0; i2 < 2; ++i2) u.aoff[h][i2] = (unsigned)((pm * BM + h * HALF + rc.R[i2]) * K + rc.C[i2]) * 2u;
        u.b0 = Bt + (size_t)pn * BM * K * 2; u.b1 = u.b0 + (size_t)HALF * K * 2; u.row0 = pm * BM; u.pn = pn; u.aux = 0; u.aux2 = 0; u.aux3 = 0; u.raw = 0; return true;
    }
    __device__ __forceinline__ void finish(Unit&, const LaneRC&) const {}
    __device__ __forceinline__ bool unit_pm(int i, int& pm) const {
        long L = (long)i * G + c;
        if (split) { if (i >= 3) { if (c < 128 || i >= 4) return false; L = 768 + (c - 128); } }
        if (L >= nwg) return false;
        const int wgid = xcd_remap((int)L, nwg);
        const int nig = WGM * nN, gid = wgid / nig, fm = gid * WGM, gsz = (nM - fm) < WGM ? (nM - fm) : WGM;
        pm = fm + ((wgid % nig) % gsz); return true;
    }
};

typedef int i32x8 __attribute__((ext_vector_type(8))); typedef int i32x4 __attribute__((ext_vector_type(4)));
template <bool FP8> struct FragT;
template <> struct FragT<false> { struct type { bf16x8 k[2]; };
    static __device__ __forceinline__ void load(type& d, const LAS unsigned char* p) { d.k[0] = *(const LAS bf16x8*)p; d.k[1] = *(const LAS bf16x8*)(p + 1024); }
    static __device__ __forceinline__ f32x4 mma16(const type& b, const type& a, f32x4 c, int k) { return __builtin_amdgcn_mfma_f32_16x16x32_bf16(b.k[k], a.k[k], c, 0, 0, 0); }
    static __device__ __forceinline__ f32x4 mma8(const type&, const type&, f32x4 c, int, int) { return c; } };
template <> struct FragT<true> { typedef i32x8 type;
    static __device__ __forceinline__ void load(type& d, const LAS unsigned char* p) { const i32x4 lo = *(const LAS i32x4*)p, hi = *(const LAS i32x4*)(p + 1024); d = __builtin_shufflevector(lo, hi, 0, 1, 2, 3, 4, 5, 6, 7); }
    static __device__ __forceinline__ f32x4 mma16(const type&, const type&, f32x4 c, int) { return c; }
    static __device__ __forceinline__ f32x4 mma8(const type& b, const type& a, f32x4 c, int scw, int sca) { asm volatile("v_mfma_scale_f32_16x16x128_f8f6f4 %0, %1, %2, %0, %3, %4 op_sel_hi:[0,0,0]" : "+v"(c) : "v"(b), "v"(a), "v"(scw), "v"(sca)); return c; } };
template <class Epi, class Sched, bool ALIGN_EPI, bool FP8 = false, int SCW = 0x7f7f7f7f, int SCA = 0x7f7f7f7f>
__device__ __forceinline__ void gemm_phase(LAS unsigned char* lds, const char* gA, const int K, const Sched& S, const Epi& E) {
    int tid_ = threadIdx.x; asm volatile("" : "+v"(tid_));
    const int tid = tid_, wid = __builtin_amdgcn_readfirstlane(tid >> 6), lane = tid & 63, wr = wid >> 2, wc = wid & 3, fr = lane & 15, fq = lane >> 4;
    const int nt = K / BK;
    LaneRC rc; unsigned voffB[2];
#pragma unroll
    for (int i = 0; i < 2; ++i) { int R, C; stage_rc(tid * 16 + i * 8192, R, C); rc.R[i] = R; rc.C[i] = C; const int Rb = Epi::PERM ? ((R & ~31) + perm32(R & 31)) : R; voffB[i] = (unsigned)(Rb * K + C) * 2u; }
    const size_t kstep = (size_t)(BK * 2);
    const unsigned ldsw = (unsigned)wid * 1024u;
    const int aoff = lds_byte(wr * 64 + fr, fq * 8), boff = lds_byte(wc * 32 + fr, fq * 8);
#define PG8_SA(b, h) (((b) * 2 + (h)) * HTB)
#define PG8_SB(b, h) ((4 + (b) * 2 + (h)) * HTB)
#define PG8_STAGE(bufoff, gbase, voff) do { _Pragma("unroll") for (int _i = 0; _i < 2; ++_i) \
        __builtin_amdgcn_global_load_lds((const unsigned*)((const char*)(gbase) + (voff)[_i]), (LAS unsigned*)(lds + (bufoff) + ldsw + _i * 8192), 16, 0, 0); } while (0)
#define PG8_LDA(dst, b, h) do { _Pragma("unroll") for (int m = 0; m < 4; ++m) FragT<FP8>::load(dst[m], lds + PG8_SA(b, h) + aoff + m * 2048); } while (0)
#define PG8_LDB(dst, b, h) do { _Pragma("unroll") for (int n = 0; n < 2; ++n) FragT<FP8>::load(dst[n], lds + PG8_SB(b, h) + boff + n * 2048); } while (0)
#define PG8_MMA(ai, bj, At, Bt) do { __builtin_amdgcn_s_setprio(1); \
        if constexpr (FP8) { _Pragma("unroll") for (int m = 0; m < 4; ++m) _Pragma("unroll") for (int n = 0; n < 2; ++n) \
            acc[ai][bj][m][n] = FragT<FP8>::mma8(Bt[n], At[m], acc[ai][bj][m][n], SCW, SCA); } \
        else { _Pragma("unroll") for (int m = 0; m < 4; ++m) _Pragma("unroll") for (int n = 0; n < 2; ++n) _Pragma("unroll") for (int k = 0; k < 2; ++k) \
            acc[ai][bj][m][n] = FragT<FP8>::mma16(Bt[n], At[m], acc[ai][bj][m][n], k); } \
        __builtin_amdgcn_s_setprio(0); } while (0)
#define PG8_WAIT_V(n) asm volatile("s_waitcnt vmcnt(" #n ")" ::: "memory")
#define PG8_WAIT_L(n) asm volatile("s_waitcnt lgkmcnt(" #n ")" ::: "memory")
#define PG8_BAR __builtin_amdgcn_s_barrier()
#define PG8_SCHED __builtin_amdgcn_sched_barrier(0)
    Unit cur, nxt; int ui = 0;
    if (!S.next(0, cur, rc)) return;
    S.finish(cur, rc);
    f32x4 acc[2][2][4][2];
#pragma unroll
    for (int a = 0; a < 2; ++a)
#pragma unroll
        for (int b = 0; b < 2; ++b)
#pragma unroll
            for (int m = 0; m < 4; ++m)
#pragma unroll
                for (int n = 0; n < 2; ++n) acc[a][b][m][n] = (f32x4){0.f, 0.f, 0.f, 0.f};
    typedef typename FragT<FP8>::type frag_t;
    frag_t At[4], B0[2], B1[2];
    PG8_STAGE(PG8_SB(0, 0), cur.b0, voffB); PG8_STAGE(PG8_SB(0, 1), cur.b1, voffB); PG8_STAGE(PG8_SA(0, 0), gA, cur.aoff[0]); PG8_STAGE(PG8_SA(0, 1), gA, cur.aoff[1]);
    if (wr == 1) PG8_BAR;
    PG8_WAIT_V(2); PG8_BAR;
    PG8_STAGE(PG8_SB(1, 0), cur.b0 + kstep, voffB); PG8_STAGE(PG8_SA(1, 0), gA + kstep, cur.aoff[0]); PG8_STAGE(PG8_SB(1, 1), cur.b1 + kstep, voffB);
    PG8_WAIT_V(6); PG8_BAR;
    for (;;) {
        const bool has_next = S.next(ui + 1, nxt, rc);
        if (!has_next) nxt = cur;
#define PG8_TRIP(A1, A2, AO2, B2_0, B2_1) do { \
            const char* a1 = (A1); const char* a2 = (A2); const char* b2_0 = (B2_0); const char* b2_1 = (B2_1); const char* a3 = a2 + kstep; const char* b3_0 = b2_0 + kstep; const char* b3_1 = b2_1 + kstep; \
              \
            PG8_LDB(B0, 0, 0); PG8_LDB(B1, 0, 1); PG8_SCHED; PG8_LDA(At, 0, 0); PG8_STAGE(PG8_SA(1, 1), a1, cur.aoff[1]); \
            PG8_WAIT_V(8); PG8_WAIT_L(0); PG8_BAR; PG8_MMA(0, 0, At, B0); PG8_MMA(0, 1, At, B1); PG8_BAR; PG8_SCHED; \
              \
            PG8_LDA(At, 0, 1); PG8_STAGE(PG8_SB(0, 0), b2_0, voffB); PG8_STAGE(PG8_SB(0, 1), b2_1, voffB); PG8_STAGE(PG8_SA(0, 0), a2, (AO2)[0]); \
            PG8_WAIT_V(8); PG8_WAIT_L(0); PG8_BAR; PG8_MMA(1, 0, At, B0); PG8_MMA(1, 1, At, B1); PG8_BAR; PG8_SCHED; \
              \
            PG8_LDB(B0, 1, 0); PG8_LDB(B1, 1, 1); PG8_SCHED; PG8_LDA(At, 1, 0); PG8_STAGE(PG8_SA(0, 1), a2, (AO2)[1]); \
            PG8_WAIT_V(8); PG8_WAIT_L(0); PG8_BAR; PG8_MMA(0, 0, At, B0); PG8_MMA(0, 1, At, B1); PG8_BAR; PG8_SCHED; \
              \
            PG8_LDA(At, 1, 1); PG8_STAGE(PG8_SB(1, 0), b3_0, voffB); PG8_STAGE(PG8_SB(1, 1), b3_1, voffB); PG8_STAGE(PG8_SA(1, 0), a3, (AO2)[0]); \
            PG8_WAIT_V(8); PG8_WAIT_L(0); PG8_BAR; PG8_MMA(1, 0, At, B0); PG8_MMA(1, 1, At, B1); PG8_BAR; PG8_SCHED; } while (0)
#pragma unroll 1
        for (int t = 0; t < nt; t += 2) {
            const bool last = (t == nt - 2);
            unsigned ao2[2][2];
#pragma unroll
            for (int h = 0; h < 2; ++h)
#pragma unroll
                for (int i2 = 0; i2 < 2; ++i2) ao2[h][i2] = last ? nxt.aoff[h][i2] : cur.aoff[h][i2];
            PG8_TRIP(gA + (size_t)(t + 1) * kstep, last ? gA : gA + (size_t)(t + 2) * kstep, ao2, last ? nxt.b0 : cur.b0 + (size_t)(t + 2) * kstep, last ? nxt.b1 : cur.b1 + (size_t)(t + 2) * kstep);
        }
        if constexpr (ALIGN_EPI) { if (wr == 0) PG8_BAR; }
        if constexpr (FP8) asm volatile("s_nop 15\n\ts_nop 7" ::: "memory");
        E(acc, cur, wr, wc, fr, fq);
        if (!has_next) break;
#pragma unroll
        for (int a = 0; a < 2; ++a)
#pragma unroll
            for (int b = 0; b < 2; ++b)
#pragma unroll
                for (int m = 0; m < 4; ++m)
#pragma unroll
                    for (int n = 0; n < 2; ++n) acc[a][b][m][n] = (f32x4){0.f, 0.f, 0.f, 0.f};
        cur = nxt; ++ui;
        if constexpr (ALIGN_EPI) { if (wr == 1) PG8_BAR; }
    }
    PG8_WAIT_V(0);
    if constexpr (!ALIGN_EPI) { if (wr == 0) PG8_BAR; }
    PG8_BAR;
#undef PG8_SA
#undef PG8_SB
#undef PG8_STAGE
#undef PG8_LDA
#undef PG8_LDB
#undef PG8_MMA
#undef PG8_TRIP
#undef PG8_WAIT_V
#undef PG8_WAIT_L
#undef PG8_BAR
#undef PG8_SCHED
}
}

#define XB_TMO      128
#define XB_XCNT(j)  (256  + 64 * (j))
#define XB_XSUB(j)  (1280 + 64 * (j))
#define XB_XGEN(j)  (2304 + 64 * (j))
#define XB_TOP      3328
#define XB_TOPGEN   3392
#define XCD_BAR_WORDS 3456
#define XB_SPIN_CAP (1u << 18)
__device__ __forceinline__ unsigned xb_ld(unsigned* p)              { return __hip_atomic_load(p, __ATOMIC_RELAXED, __HIP_MEMORY_SCOPE_AGENT); }
__device__ __forceinline__ unsigned xb_add(unsigned* p, unsigned v) { return __hip_atomic_fetch_add(p, v, __ATOMIC_RELAXED, __HIP_MEMORY_SCOPE_AGENT); }
__device__ __forceinline__ unsigned xb_xcc_id() { return (unsigned)__builtin_amdgcn_s_getreg((3 << 11) | 20) & 0xFu; }
#define XB_SPIN(cond, bar) do { unsigned _sp = 0; while (cond) { __builtin_amdgcn_s_sleep(1); \
    if ((++_sp & 255u) == 0u) { if (xb_ld(&(bar)[XB_TMO])) break; if (_sp > XB_SPIN_CAP) { atomicAdd(&(bar)[XB_TMO], 1u); break; } } } } while (0)
struct XcdBarrier { unsigned* bar; unsigned x; volatile LAS unsigned* st; };
__device__ __forceinline__ XcdBarrier xcd_barrier_post(unsigned* bar, volatile LAS unsigned* st) {
    XcdBarrier b; b.bar = bar; b.x = xb_xcc_id(); b.st = st;
    if (threadIdx.x == 0) (void)xb_add(&bar[XB_XCNT(b.x)], 1u);
    return b;
}
__device__ __forceinline__ void xcd_barrier_complete(unsigned* bar, unsigned x, unsigned& nloc, unsigned& nx) {
    const unsigned G = gridDim.x * gridDim.y * gridDim.z;
    unsigned sum, cnt, mine, sp = 0u;
    for (;;) {
        sum = 0u; cnt = 0u; mine = 0u;
#pragma unroll
        for (unsigned j = 0; j < 16; ++j) { const unsigned c = xb_ld(&bar[XB_XCNT(j)]); sum += c; cnt += (c > 0u) ? 1u : 0u; mine = (j == x) ? c : mine; }
        if (sum == G) break;
        __builtin_amdgcn_s_sleep(1);
        if ((++sp & 255u) == 0u) { if (xb_ld(&bar[XB_TMO])) break; if (sp > XB_SPIN_CAP) { atomicAdd(&bar[XB_TMO], 1u); break; } }
    }
    nloc = mine > 0u ? mine : 1u; nx = cnt > 0u ? cnt : 1u;
}
__device__ __forceinline__ void xcd_barrier(const XcdBarrier& b) {
    asm volatile("s_waitcnt vmcnt(0)" ::: "memory");
    __syncthreads();
    if (threadIdx.x == 0) {
        unsigned* bar = b.bar;
        __builtin_amdgcn_s_waitcnt(0);
        unsigned nloc = b.st[0], nx = b.st[1];
        if (nloc == 0u) { xcd_barrier_complete(bar, b.x, nloc, nx); b.st[0] = nloc; b.st[1] = nx; }
        const unsigned old = xb_add(&bar[XB_XSUB(b.x)], 1u);
        const unsigned gen = old / nloc;
        if (old + 1u == (gen + 1u) * nloc) {
            __builtin_amdgcn_fence(__ATOMIC_RELEASE, "agent");
            asm volatile("s_waitcnt vmcnt(0)" ::: "memory");
            const unsigned og = xb_add(&bar[XB_TOP], 1u);
            const unsigned tg = og / nx;
            if (og + 1u == (tg + 1u) * nx) xb_add(&bar[XB_TOPGEN], 1u);
            else XB_SPIN(xb_ld(&bar[XB_TOPGEN]) == tg, bar);
            __builtin_amdgcn_fence(__ATOMIC_ACQUIRE, "agent");
            xb_add(&bar[XB_XGEN(b.x)], 1u);
            asm volatile("s_waitcnt vmcnt(0)" ::: "memory");
        } else {
            XB_SPIN(xb_ld(&bar[XB_XGEN(b.x)]) == gen, bar);
            __builtin_amdgcn_fence(__ATOMIC_ACQUIRE, "agent");
            asm volatile("s_waitcnt vmcnt(0)" ::: "memory");
        }
    }
    __syncthreads();
}

namespace attn_body {
using bf16=__hip_bfloat16;
using bf16x8=__attribute__((ext_vector_type(8)))short;
using s16x4=__attribute__((ext_vector_type(4)))short;
using f32x16=__attribute__((ext_vector_type(16)))float;
using u32x4=__attribute__((ext_vector_type(4)))unsigned;
using u32x2v=__attribute__((ext_vector_type(2)))unsigned;
constexpr float AO_PRESCALE=128.0f;
constexpr int BATCH=4,NHEAD=8,SEQ=4096,D=64,DM=NHEAD*D;
constexpr int NW=8,QBLK=32,QB=QBLK*NW,KVBLK=64,NQB=SEQ/QB;
constexpr int ATTN_PITCH=DM, ATTN_UNIT_ROWS=QB;
__device__ __forceinline__ int crow(int r,int hi){return (r&3)+8*(r>>2)+4*hi;}
#define SBAR() __builtin_amdgcn_sched_barrier(0)
__device__ __forceinline__ void amask(f32x16&p0,f32x16&p1,const u32x2v mk,int hi){
  const unsigned a=mk.x>>(2*hi), b=mk.y>>(2*hi); const unsigned NEGI=0xff800000u;
  #define AM1(r,src) { int m0_,m1_; asm("v_bfe_i32 %0, %1, %2, 1":"=v"(m0_):"v"(src),"n"((((r)&3)>>1)+4*((r)>>2))); asm("v_bfe_i32 %0, %1, %2, 1":"=v"(m1_):"v"(src),"n"((((r)&3)>>1)+4*((r)>>2)+16)); \
      float x0_=p0[r],x1_=p1[r]; asm("v_bfi_b32 %0, %1, %2, %3":"=v"(x0_):"v"(m0_),"v"(x0_),"s"(NEGI)); asm("v_bfi_b32 %0, %1, %2, %3":"=v"(x1_):"v"(m1_),"v"(x1_),"s"(NEGI)); p0[r]=x0_; p1[r]=x1_; }
  AM1(0,a) AM1(1,b) AM1(2,a) AM1(3,b) AM1(4,a) AM1(5,b) AM1(6,a) AM1(7,b) AM1(8,a) AM1(9,b) AM1(10,a) AM1(11,b) AM1(12,a) AM1(13,b) AM1(14,a) AM1(15,b)
  #undef AM1
}
__device__ __forceinline__ void abias(f32x16&p0,f32x16&p1,int jb,int qrel,int hi,const __attribute__((address_space(3))) float*lut){
  const int d00=qrel+128-64*jb-4*hi;
  #pragma unroll
  for(int r=0;r<16;++r){ const int d0=d00-((r&3)+8*(r>>2)); const unsigned i0=(unsigned)d0<127u?(unsigned)d0:127u; const unsigned i1=(unsigned)(d0-32)<127u?(unsigned)(d0-32):127u;
    p0[r]+=lut[i0]; p1[r]+=lut[i1]; }
}

constexpr int NSLOT=3, SLOTB=8192;
constexpr int LDS_K=0, LDS_V=NSLOT*SLOTB, LDS_WS=2*NSLOT*SLOTB, LDS_OST=LDS_WS+NW*64*4, LDS_MK=LDS_OST+NW*4096, LDS_BYTES=LDS_MK+NW*512;
constexpr float C2=0.125f*1.4426950408889634f;
__device__ __forceinline__ void glds16(const void*gsrc,unsigned lds_dst){unsigned keep;
  asm volatile("s_mov_b32 %0, m0\n\ts_mov_b32 m0, %2\n\ts_nop 0\n\tglobal_load_lds_dwordx4 %1, off\n\ts_mov_b32 m0, %0":"=&s"(keep):"v"(gsrc),"s"(lds_dst):"memory");}
__device__ __forceinline__ void glds4(const void*gsrc,unsigned lds_dst){unsigned keep;
  asm volatile("s_mov_b32 %0, m0\n\ts_mov_b32 m0, %2\n\ts_nop 0\n\tglobal_load_lds_dword %1, off\n\ts_mov_b32 m0, %0":"=&s"(keep):"v"(gsrc),"s"(lds_dst):"memory");}
__device__ __forceinline__ float max3f(float a,float b,float c){float r;asm("v_max3_f32 %0, %1, %2, %3":"=v"(r):"v"(a),"v"(b),"v"(c));return r;}
__device__ __forceinline__ float max2f(float a,float b){float r;asm("v_max_f32_e32 %0, %1, %2":"=v"(r):"v"(a),"v"(b));return r;}
__device__ __forceinline__ float fadd_s(float a,float b){float r;asm("v_add_f32_e32 %0, %1, %2":"=v"(r):"v"(a),"v"(b));return r;}
__device__ __forceinline__ float fsub_s(float a,float b){float r;asm("v_sub_f32_e32 %0, %1, %2":"=v"(r):"v"(a),"v"(b));return r;}
typedef float f32x2_t __attribute__((ext_vector_type(2))); typedef __bf16 bf16x2_t __attribute__((ext_vector_type(2)));
__device__ __forceinline__ unsigned cvtpk_s(float lo,float hi){f32x2_t v={lo,hi};bf16x2_t b=__builtin_convertvector(v,bf16x2_t);return __builtin_bit_cast(unsigned,b);}
#define WAIT_BAR(N) asm volatile("s_waitcnt vmcnt(" #N ") lgkmcnt(0)\n\ts_barrier":::"memory")

__device__ __forceinline__ void qkt(f32x16&p0,f32x16&p1,const char*Kslot,const bf16x8*qr,const f32x16&negm,int r32,int hi){
  const char*kb=Kslot+hi*1024+r32*16;
  #pragma unroll
  for(int d0=0;d0<4;++d0){
    const bf16x8 b0=*reinterpret_cast<const bf16x8*>(kb+d0*2048);
    const bf16x8 b1=*reinterpret_cast<const bf16x8*>(kb+d0*2048+512);
    if(d0==0){p0=__builtin_amdgcn_mfma_f32_32x32x16_bf16(b0,qr[0],negm,0,0,0);p1=__builtin_amdgcn_mfma_f32_32x32x16_bf16(b1,qr[0],negm,0,0,0);}
    else{p0=__builtin_amdgcn_mfma_f32_32x32x16_bf16(b0,qr[d0],p0,0,0,0);p1=__builtin_amdgcn_mfma_f32_32x32x16_bf16(b1,qr[d0],p1,0,0,0);}}
}
typedef __attribute__((address_space(3))) const char* lds_cptr;
typedef short v4i16_t __attribute__((ext_vector_type(4)));
__device__ __forceinline__ void kload8(bf16x8*kf,lds_cptr kp){
  kf[0]=*(const __attribute__((address_space(3))) bf16x8*)(kp);      kf[1]=*(const __attribute__((address_space(3))) bf16x8*)(kp+512);
  kf[2]=*(const __attribute__((address_space(3))) bf16x8*)(kp+2048); kf[3]=*(const __attribute__((address_space(3))) bf16x8*)(kp+2560);
  kf[4]=*(const __attribute__((address_space(3))) bf16x8*)(kp+4096); kf[5]=*(const __attribute__((address_space(3))) bf16x8*)(kp+4608);
  kf[6]=*(const __attribute__((address_space(3))) bf16x8*)(kp+6144); kf[7]=*(const __attribute__((address_space(3))) bf16x8*)(kp+6656);
}
__device__ __forceinline__ void kload2(bf16x8*kf,lds_cptr kp,int j){ kf[2*j]=*(const __attribute__((address_space(3))) bf16x8*)(kp+j*2048); kf[2*j+1]=*(const __attribute__((address_space(3))) bf16x8*)(kp+j*2048+512); }
__device__ __forceinline__ s16x4 vtr(lds_cptr p){ return __builtin_bit_cast(s16x4,__builtin_amdgcn_ds_read_tr16_b64_v4i16((__attribute__((address_space(3))) v4i16_t*)p)); }
__device__ __forceinline__ float rowmax(const f32x16&p0,const f32x16&p1){
  float a=max3f(p0[0],p0[1],p1[0]),b=max3f(p0[2],p0[3],p1[1]);a=max3f(a,p1[2],p1[3]);
  #pragma unroll
  for(int r=4;r<16;r+=4){a=max3f(a,p0[r],p0[r+1]);b=max3f(b,p0[r+2],p0[r+3]);a=max3f(a,p1[r],p1[r+1]);b=max3f(b,p1[r+2],p1[r+3]);}
  const float m=max2f(a,b);
  auto rr=__builtin_amdgcn_permlane32_swap(__float_as_uint(m),__float_as_uint(m),false,false);
  return max2f(__uint_as_float(rr[0]),__uint_as_float(rr[1]));
}
__device__ __forceinline__ void pv(f32x16*o,int vb,bf16x8 pa0,bf16x8 pa1,bf16x8 pa2,bf16x8 pa3){
  #pragma unroll
  for(int d0=0;d0<2;++d0){s16x4 lo[4],hi[4];
    #pragma unroll
    for(int ks=0;ks<4;++ks){
      asm volatile("ds_read_b64_tr_b16 %0,%1 offset:%c2":"=&v"(lo[ks]):"v"(vb),"i"(d0*4096+ks*1024):"memory");
      asm volatile("ds_read_b64_tr_b16 %0,%1 offset:%c2":"=&v"(hi[ks]):"v"(vb),"i"(d0*4096+ks*1024+512):"memory");}
    asm volatile("s_waitcnt lgkmcnt(0)":::"memory");SBAR();
    #define PK(k) (bf16x8){lo[k][0],lo[k][1],lo[k][2],lo[k][3],hi[k][0],hi[k][1],hi[k][2],hi[k][3]}
    o[d0]=__builtin_amdgcn_mfma_f32_32x32x16_bf16(pa0,PK(0),o[d0],0,0,0);
    o[d0]=__builtin_amdgcn_mfma_f32_32x32x16_bf16(pa1,PK(1),o[d0],0,0,0);
    o[d0]=__builtin_amdgcn_mfma_f32_32x32x16_bf16(pa2,PK(2),o[d0],0,0,0);
    o[d0]=__builtin_amdgcn_mfma_f32_32x32x16_bf16(pa3,PK(3),o[d0],0,0,0);
    #undef PK
  }
}

#ifndef ATTN_STORE16
#define ATTN_STORE16(p,v) asm volatile("global_store_dwordx4 %0, %1, off sc0 sc1\n\ts_nop 1" :: "v"((GAS void*)(p)), "v"(v) : "memory")
#endif
template<int THRL> __device__ __forceinline__ void attn_unit(int b,int h,int qb,const bf16*Q,const bf16*__restrict__ K,const bf16*__restrict__ V,bf16*O,const unsigned long long*MK,const __attribute__((address_space(3))) float*lut,char*shm){
  int tid_=threadIdx.x; asm volatile("":"+v"(tid_)); const int tid=tid_,lane=tid&63,r32=lane&31,hi=lane>>5; const int wid=__builtin_amdgcn_readfirstlane(tid>>6);
  const long rowbase=(long)b*SEQ; const int q0=qb*QB;
  const bf16*Qw=Q+(rowbase+q0+wid*QBLK)*DM+h*D;
  const bf16*Kh=K+rowbase*DM+h*D,*Vh=V+rowbase*DM+h*D;
  const unsigned lds0=(unsigned)(uintptr_t)shm;
  float*wsf=(float*)(shm+LDS_WS)+wid*64;
  const bf16*ksrc=Kh+(long)lane*DM+wid*8;
  const bf16*vsrc=Vh+(long)(16*(wid&3)+(lane>>2))*DM+(wid>>2)*32+(lane&3)*8;
  const unsigned kdst=lds0+LDS_K+wid*1024, vdst=lds0+LDS_V+wid*1024;
  #define DMA_K(t,slot) glds16(ksrc+(long)(t)*KVBLK*DM,(unsigned)__builtin_amdgcn_readfirstlane(kdst+(slot)))
  #define DMA_V(t,slot) glds16(vsrc+(long)(t)*KVBLK*DM,(unsigned)__builtin_amdgcn_readfirstlane(vdst+(slot)))
  const int vb0=(int)(lds0+LDS_V)+((lane>>4)&1)*32+(lane&3)*8+(4*hi+((lane&15)>>2))*64;
  const char*Kbase=shm+LDS_K; bf16x8 kf[8];
  const lds_cptr shm3=(lds_cptr)shm; const lds_cptr kp0=shm3+LDS_K+hi*1024+r32*16; const lds_cptr vp0=shm3+LDS_V+((lane>>4)&1)*32+(lane&3)*8+(4*hi+((lane&15)>>2))*64; const lds_cptr mkp=shm3+LDS_MK+wid*512+r32*4;
  const int NT=(q0+QB)/KVBLK;
  const char*msrc=(const char*)(MK+(rowbase+q0+wid*QBLK+r32)*(SEQ/64))+hi*4; const unsigned mdst=lds0+LDS_MK+wid*512;
  #define DMA_M(t) glds4(msrc+(long)(t)*8,(unsigned)__builtin_amdgcn_readfirstlane(mdst+(((t)&1)<<8)))
  DMA_M(0);DMA_M(1);
  DMA_K(0,0);DMA_V(0,0);DMA_K(1,SLOTB);
  bf16x8 qr[4];
  #pragma unroll
  for(int d0=0;d0<4;++d0)qr[d0]=*reinterpret_cast<const bf16x8*>(&Qw[(long)r32*DM+d0*16+hi*8]);
  float mhat=0.f,l_reg=0.f;f32x16 o[2];o[0]=f32x16{};o[1]=f32x16{};const f32x16 negm=f32x16{};
  const int qrel=wid*QBLK+r32;
  #define MREAD(t) (u32x2v){*(const __attribute__((address_space(3))) unsigned*)(mkp+(((t)&1)<<8)),*(const __attribute__((address_space(3))) unsigned*)(mkp+(((t)&1)<<8)+128)}
  #define CMASK(P0,P1,t,MC) do{int jb_=(t)-(NT-6); if(jb_>=0 && 32*wid+65-64*jb_<113 && 64*jb_-128<=32*wid+31)abias(P0,P1,jb_,qrel,hi,lut); const u32x2v mk_=MREAD(t); amask(P0,P1,mk_,hi);}while(0)
  bool resc=false;
  #define START(P0,P1) do{ const float rm=rowmax(P0,P1); resc=false; \
    { const float dl=__builtin_fmaxf(rm,-1000.f); mhat=fadd_s(mhat,dl); \
      _Pragma("unroll") for(int r=0;r<16;++r){P0[r]=fsub_s(P0[r],dl);P1[r]=fsub_s(P1[r],dl);} \
      } \
    _Pragma("unroll") for(int r=0;r<16;++r)P0[r]=__builtin_amdgcn_exp2f(P0[r]); }while(0)
  #define RESC() do{ if(resc){ asm volatile("s_waitcnt lgkmcnt(0)":::"memory"); \
      _Pragma("unroll") for(int d_=0;d_<2;++d_) _Pragma("unroll") for(int r=0;r<16;++r)o[d_][r]*=wsf[crow(r,hi)]; } }while(0)
  f32x16 pA0,pA1,pB0,pB1;
  int sl_prev=0,sl_cur=0,sl_next=SLOTB;
  #define ROT() do{sl_prev=sl_cur;sl_cur=sl_next;sl_next=(sl_next==(NSLOT-1)*SLOTB)?0:sl_next+SLOTB;}while(0)
  DMA_K(2,2*SLOTB);
  WAIT_BAR(3);
  qkt(pA0,pA1,Kbase,qr,negm,r32,hi);asm volatile("s_nop 15\n\ts_nop 7":"+v"(pA0),"+v"(pA1));CMASK(pA0,pA1,0,0);
  START(pA0,pA1);
  _Pragma("unroll") for(int r=0;r<16;++r)pA1[r]=__builtin_amdgcn_exp2f(pA1[r]);
  WAIT_BAR(0);
  DMA_K(3,0);DMA_V(1,SLOTB);
  ROT();
  kload8(kf,kp0+sl_cur);
  WAIT_BAR(2);
  s16x4 vlo[8],vhi[8]; u32x4 pw0,pw1,pw2,pw3;
  #define PKW(P,B) cvtpk_s(P[B],P[B+1])
  #define PAF(k) __builtin_bit_cast(bf16x8,pw##k)
  #define VFR(i) (bf16x8){vlo[i][0],vlo[i][1],vlo[i][2],vlo[i][3],vhi[i][0],vhi[i][1],vhi[i][2],vhi[i][3]}
  #define PIN(x) asm volatile("":"+v"(x))
  #define MX3(a,b,c) __builtin_fmaxf(__builtin_fmaxf((a),(b)),(c))
  #define GAPA(MF,A0,A1,A2,A3,W0,W1,PW) do{ MF; sacc+=A0; sacc+=A1; sacc+=A2; sacc+=A3; PIN(sacc); W0; W1; PIN(PW); SBAR(); }while(0)
  #define EX(v) __builtin_amdgcn_exp2f(v)
  #define GAPB(MF,X,B) do{ MF; X[B]=EX(X[B]); X[B+1]=EX(X[B+1]); X[B+2]=EX(X[B+2]); X[B+3]=EX(X[B+3]); PIN(X); SBAR(); }while(0)
  #define VRD(i) do{ vlo[i]=vtr(vp_+(((i)>>2)*4096+((i)&3)*1024)); vhi[i]=vtr(vp_+(((i)>>2)*4096+((i)&3)*1024+512)); }while(0)
  #define KRD(G,j) do{ if(G){ kload2(kf,kp0+sl_next,j); SBAR(); } }while(0)
  #define STEP(C0,C1,P0,P1,t,GK,GV,GL,MC,MN,GM) do{ SBAR(); if(GM){DMA_M((t)+1);} \
    const lds_cptr vp_=vp0+sl_prev; \
    VRD(0); SBAR(); float sacc=(P0[0]+P0[1]); \
    GAPA(C0=__builtin_amdgcn_mfma_f32_32x32x16_bf16(kf[0],qr[0],negm,0,0,0), P0[2],P0[3],P0[4],P0[5],     pw0[0]=PKW(P0,0), pw0[1]=PKW(P0,2), pw0); \
    VRD(4); SBAR(); GAPA(C1=__builtin_amdgcn_mfma_f32_32x32x16_bf16(kf[1],qr[0],negm,0,0,0), P0[6],P0[7],P0[8],P0[9],     pw0[2]=PKW(P0,4), pw0[3]=PKW(P0,6), pw0); \
    VRD(1); SBAR(); GAPA(C0=__builtin_amdgcn_mfma_f32_32x32x16_bf16(kf[2],qr[1],C0,0,0,0),   P0[10],P0[11],P0[12],P0[13], pw1[0]=PKW(P0,8), pw1[1]=PKW(P0,10), pw1); \
    VRD(5); SBAR(); GAPA(C1=__builtin_amdgcn_mfma_f32_32x32x16_bf16(kf[3],qr[1],C1,0,0,0),   P0[14],P0[15],P1[0],P1[1],   pw1[2]=PKW(P0,12),pw1[3]=PKW(P0,14), pw1); \
    VRD(2); SBAR(); GAPA(C0=__builtin_amdgcn_mfma_f32_32x32x16_bf16(kf[4],qr[2],C0,0,0,0),   P1[2],P1[3],P1[4],P1[5],     pw2[0]=PKW(P1,0), pw2[1]=PKW(P1,2), pw2); \
    VRD(6); SBAR(); GAPA(C1=__builtin_amdgcn_mfma_f32_32x32x16_bf16(kf[5],qr[2],C1,0,0,0),   P1[6],P1[7],P1[8],P1[9],     pw2[2]=PKW(P1,4), pw2[3]=PKW(P1,6), pw2); \
    VRD(3); SBAR(); GAPA(C0=__builtin_amdgcn_mfma_f32_32x32x16_bf16(kf[6],qr[3],C0,0,0,0),   P1[10],P1[11],P1[12],P1[13], pw3[0]=PKW(P1,8), pw3[1]=PKW(P1,10), pw3); \
    VRD(7); SBAR(); GAPA(C1=__builtin_amdgcn_mfma_f32_32x32x16_bf16(kf[7],qr[3],C1,0,0,0),   P1[14],P1[15],0.f,0.f,       pw3[2]=PKW(P1,12),pw3[3]=PKW(P1,14), pw3); \
    l_reg+=sacc; \
    if(GK){DMA_K((t)+3,sl_cur);} if(GV){DMA_V((t)+1,sl_next);} \
    _Pragma("unroll") for(int r=0;r<16;++r){C0[r]-=mhat;C1[r]-=mhat;} \
    CMASK(C0,C1,t,MC); \
    { float a=MX3(C0[0],C0[1],C1[0]),b=MX3(C0[2],C0[3],C1[1]); a=MX3(a,C1[2],C1[3]); \
      _Pragma("unroll") for(int r=4;r<16;r+=4){a=MX3(a,C0[r],C0[r+1]);b=MX3(b,C0[r+2],C0[r+3]);a=MX3(a,C1[r],C1[r+1]);b=MX3(b,C1[r+2],C1[r+3]);} \
      float rm=__builtin_fmaxf(a,b); { auto rr=__builtin_amdgcn_permlane32_swap(__float_as_uint(rm),__float_as_uint(rm),false,false); rm=__builtin_fmaxf(__uint_as_float(rr[0]),__uint_as_float(rr[1])); } \
      resc=false; \
      if(__builtin_expect(__any(rm>(float)THRL),0)){ const float dl=__builtin_fmaxf(rm,0.f); mhat+=dl; \
        _Pragma("unroll") for(int r=0;r<16;++r){C0[r]-=dl;C1[r]-=dl;} \
        const float f=__builtin_amdgcn_exp2f(-dl); l_reg*=f; if(hi==0)wsf[r32]=f; resc=true; } } \
    SBAR(); \
    GAPB(o[0]=__builtin_amdgcn_mfma_f32_32x32x16_bf16(PAF(0),VFR(0),o[0],0,0,0), C0,0); \
    GAPB(o[1]=__builtin_amdgcn_mfma_f32_32x32x16_bf16(PAF(0),VFR(4),o[1],0,0,0), C0,4); \
    KRD(GL,0); GAPB(o[0]=__builtin_amdgcn_mfma_f32_32x32x16_bf16(PAF(1),VFR(1),o[0],0,0,0), C0,8); \
    KRD(GL,1); GAPB(o[1]=__builtin_amdgcn_mfma_f32_32x32x16_bf16(PAF(1),VFR(5),o[1],0,0,0), C0,12); \
    KRD(GL,2); GAPB(o[0]=__builtin_amdgcn_mfma_f32_32x32x16_bf16(PAF(2),VFR(2),o[0],0,0,0), C1,0); \
    KRD(GL,3); GAPB(o[1]=__builtin_amdgcn_mfma_f32_32x32x16_bf16(PAF(2),VFR(6),o[1],0,0,0), C1,4); \
    GAPB(o[0]=__builtin_amdgcn_mfma_f32_32x32x16_bf16(PAF(3),VFR(3),o[0],0,0,0), C1,8); \
    GAPB(o[1]=__builtin_amdgcn_mfma_f32_32x32x16_bf16(PAF(3),VFR(7),o[1],0,0,0), C1,12); \
    }while(0)
  int t=1;
  #undef CMASK
  #define CMASK(P0,P1,t,MC) do{ const u32x2v mk_=MREAD(t); amask(P0,P1,mk_,hi);}while(0)
  for(;t+7<NT;t+=2){
    STEP(pB0,pB1,pA0,pA1,t,true,true,true,0,0,true);     WAIT_BAR(2); RESC(); ROT();
    STEP(pA0,pA1,pB0,pB1,t+1,true,true,true,0,0,true);   WAIT_BAR(2); RESC(); ROT();
  }
  #undef CMASK
  #define CMASK(P0,P1,t,MC) do{int jb_=(t)-(NT-6); if(jb_>=0 && 32*wid+65-64*jb_<113 && 64*jb_-128<=32*wid+31)abias(P0,P1,jb_,qrel,hi,lut); const u32x2v mk_=MREAD(t); amask(P0,P1,mk_,hi);}while(0)
  #define ENDW(tt,M) do{ if((tt)+3<NT){WAIT_BAR(2);} else if((tt)+2<NT){WAIT_BAR(1);} else {WAIT_BAR(0);} }while(0)
  for(;t+1<NT;t+=2){
    STEP(pB0,pB1,pA0,pA1,t,(t+3<NT),(t+1<NT),(t+1<NT),0,0,(t+1<NT));       ENDW(t,0);   RESC(); ROT();
    STEP(pA0,pA1,pB0,pB1,t+1,(t+4<NT),(t+2<NT),(t+2<NT),0,0,(t+2<NT));     ENDW(t+1,0); RESC(); ROT();
  }
  STEP(pB0,pB1,pA0,pA1,NT-1,false,false,false,0,0,false); RESC();
  { float sacc=pB0[0]+pB0[1]; _Pragma("unroll") for(int r=2;r<16;++r)sacc+=pB0[r]; _Pragma("unroll") for(int r=0;r<16;++r)sacc+=pB1[r]; l_reg+=sacc;
    pw0=(u32x4){PKW(pB0,0),PKW(pB0,2),PKW(pB0,4),PKW(pB0,6)};pw1=(u32x4){PKW(pB0,8),PKW(pB0,10),PKW(pB0,12),PKW(pB0,14)};pw2=(u32x4){PKW(pB1,0),PKW(pB1,2),PKW(pB1,4),PKW(pB1,6)};pw3=(u32x4){PKW(pB1,8),PKW(pB1,10),PKW(pB1,12),PKW(pB1,14)};
    SBAR(); pv(o,vb0+sl_cur,PAF(0),PAF(1),PAF(2),PAF(3)); }
  #undef PKW
  #undef PAF
  #undef VFR
  #undef PIN
  #undef MX3
  #undef GAPA
  #undef GAPB
  #undef EX
  #undef VRD
  #undef KRD
  #undef STEP
  #undef ENDW
  {auto rr=__builtin_amdgcn_permlane32_swap(__float_as_uint(l_reg),__float_as_uint(l_reg),false,false);l_reg=__uint_as_float(rr[0])+__uint_as_float(rr[1]);}
  if(hi==0)wsf[32+r32]=l_reg;asm volatile("s_waitcnt lgkmcnt(0)":::"memory");
  float rli[16];
  #pragma unroll
  for(int r=0;r<16;++r)rli[r]=__builtin_amdgcn_rcpf(wsf[32+crow(r,hi)]);
  unsigned char*Ow=(unsigned char*)O+(rowbase+q0+wid*QBLK)*(long)DM+h*D;
  { unsigned char*stg=(unsigned char*)(shm+LDS_OST)+wid*4096;
    #pragma unroll
    for(int r=0;r<16;++r){const int orow=crow(r,hi); const float sc=rli[r]*AO_PRESCALE;
      #pragma unroll
      for(int d0=0;d0<2;++d0){const float x=__builtin_amdgcn_fmed3f(o[d0][r]*sc,-448.f,448.f); stg[orow*64+d0*32+r32]=(unsigned char)(__builtin_amdgcn_cvt_pk_fp8_f32(x,x,0,false)&0xff);}}
    asm volatile("s_waitcnt lgkmcnt(0)":::"memory");
    #pragma unroll
    for(int i=0;i<2;++i){const int row=i*16+(lane>>2),ch=lane&3; const u32x4 v=*(const u32x4*)(stg+row*64+ch*16); ATTN_STORE16(Ow+(long)row*DM+ch*16,v);} }
  asm volatile("s_waitcnt lgkmcnt(0)\n\ts_barrier":::"memory");
  #undef DMA_K
  #undef DMA_V
  #undef DMA_M
  #undef MREAD
  #undef CMASK
  #undef START
  #undef RESC
  #undef ROT
}
constexpr int ATTN_LDS_BYTES=LDS_BYTES;
struct AttnTensors { const bf16* Q; const bf16* K; const bf16* V; bf16* O; const unsigned long long* MK; };
struct AttnUnit { int bh; int qb; };
struct StaticOrder {
  int vcu; unsigned* pan; unsigned* mpan; unsigned* tmo;
  __device__ __forceinline__ explicit StaticOrder(int grid,int block,unsigned* pan_,unsigned* mpan_,unsigned* tmo_):vcu((block%8)*(grid/8)+block/8),pan(pan_),mpan(mpan_),tmo(tmo_){}
  __device__ __forceinline__ bool next(int i,AttnUnit&u)const{ if(i>=2)return false; const int s=vcu&7; u.bh=vcu>>3; u.qb=(i==0)?s:15-s; return true; }
  __device__ __forceinline__ void a_ready(const AttnUnit&u)const{
    if(threadIdx.x==0){ unsigned*p=mpan+32*((u.bh/NHEAD)*16+u.qb); unsigned sp=0;
      while(__hip_atomic_load(p,__ATOMIC_RELAXED,__HIP_MEMORY_SCOPE_AGENT)<8u){ __builtin_amdgcn_s_sleep(1); if((++sp&255u)==0u){ if(__hip_atomic_load(tmo,__ATOMIC_RELAXED,__HIP_MEMORY_SCOPE_AGENT))break; if(sp>(1u<<18)){ atomicAdd(tmo,1u); break; } } }
      __builtin_amdgcn_fence(__ATOMIC_ACQUIRE,"agent"); asm volatile("s_waitcnt vmcnt(0)":::"memory"); }
    __syncthreads(); }
  __device__ __forceinline__ void done(const AttnUnit&u)const{ asm volatile("s_waitcnt vmcnt(0)":::"memory"); __syncthreads(); if(threadIdx.x==0)(void)__hip_atomic_fetch_add(pan+32*((u.bh/NHEAD)*16+u.qb),1u,__ATOMIC_RELAXED,__HIP_MEMORY_SCOPE_AGENT); }
};
template<class Sched,int THRL=8> __device__ __forceinline__ void attn_phase(char*lds,const AttnTensors&T,const __attribute__((address_space(3))) float*lut8,const Sched&S){
  AttnUnit u;
  for(int i=0;S.next(i,u);++i){ S.a_ready(u); attn_unit<THRL>(u.bh/NHEAD,u.bh%NHEAD,u.qb,T.Q,T.K,T.V,T.O,T.MK,lut8+(u.bh%NHEAD)*128,lds); S.done(u); }
}
#undef SBAR
#undef WAIT_BAR
}

struct Args { const float* in[17]; float* out; unsigned char* ws; };
enum { IN_X = 0, IN_MIXN, IN_WIN, IN_POOLW, IN_POOLS, IN_WBP, IN_WBA, IN_RELB, IN_WOUT, IN_FFNN, IN_WR, IN_BR, IN_W1, IN_B1, IN_W2, IN_B2, IN_FINN, IN_OUT = 17 };
struct Frame {
    LAS unsigned char* lds;
    unsigned char* ws;
    int tid, lane, wave, G, gw, ngw;
    __device__ __forceinline__ const float* in(int i) const {
        auto kp = __builtin_amdgcn_kernarg_segment_ptr(); u64 p;
        asm volatile("s_load_dwordx2 %0, %1, %2\n\ts_waitcnt lgkmcnt(0)" : "=s"(p) : "s"(kp), "s"(i * 8) : "memory");
        return (const float*)(const GAS float*)p; }
    __device__ __forceinline__ float* outp() const { return (float*)in(IN_OUT); }
    template <class T> __device__ __forceinline__ T* w(size_t off) const { return (T*)(ws + off); }
    __device__ __forceinline__ unsigned* ctl() const { return (unsigned*)(ws + WS_CTL); }
};

__device__ __forceinline__ void refresh(Frame& F) { int t = threadIdx.x; asm volatile("" : "+v"(t)); F.tid = t; F.lane = t & 63; }

__device__ __forceinline__ void panel_signal(Frame& F, int cw) {
    asm volatile("s_waitcnt vmcnt(0)" ::: "memory");
    __syncthreads();
    if (threadIdx.x == 0) { pg8::DenseSched s; s.init(NTOK, 1024, 0, nullptr, (int)gridDim.x, (int)blockIdx.x); for (int i = 0;; ++i) { int pm; if (!s.unit_pm(i, pm)) break; (void)xb_add(F.ctl() + cw + 32 * pm, 1u); } }
}
__device__ __forceinline__ void panel_poll(Frame& F, int cw, int pm, unsigned need) { unsigned* bar = F.ctl() + CW_BAR; unsigned* p = F.ctl() + cw + 32 * pm; XB_SPIN(xb_ld(p) < need, bar); }
__device__ __forceinline__ void panel_wait(Frame& F, int cw, unsigned need) {
    if (threadIdx.x == 0) { pg8::DenseSched s; s.init(NTOK, 1024, 0, nullptr, (int)gridDim.x, (int)blockIdx.x); for (int i = 0;; ++i) { int pm; if (!s.unit_pm(i, pm)) break; panel_poll(F, cw, pm, need); }
        __builtin_amdgcn_fence(__ATOMIC_ACQUIRE, "agent"); asm volatile("s_waitcnt vmcnt(0)" ::: "memory"); }
    __syncthreads();
}

template <bool INDEXER> struct EpiInProj {
    static constexpr bool PERM = true;
    bf16 *zpool, *q, *k, *v, *qi, *ki, *gate; float* wi;
    __device__ __forceinline__ void operator()(const f32x4 (&acc)[2][2][4][2], const pg8::Unit& u, int wr, int wc, int fr, int fq) const {
        const int pn = u.pn, row0 = u.row0 + wr * 64 + fr;
        if (INDEXER && pn == 1) {
#pragma unroll
            for (int ai = 0; ai < 2; ++ai)
#pragma unroll
                for (int m = 0; m < 4; ++m) { const int row = row0 + ai * 128 + m * 16;
                    const f32x4 v0 = acc[ai][0][m][0], v1 = acc[ai][0][m][1];
                    if (wc < 2) { u32x4 w; w.x = cvt_pk_bf16(v0[0], v0[1]); w.y = cvt_pk_bf16(v0[2], v0[3]); w.z = cvt_pk_bf16(v1[0], v1[1]); w.w = cvt_pk_bf16(v1[2], v1[3]);
                        *(u32x4*)(ki + (size_t)row * 64 + wc * 32 + 8 * fq) = w; }
                    else if (wc == 2 && fq == 0) { *(f32x4*)(wi + (size_t)row * 4) = v0; } }
            return;
        }
        bf16* base; int ldc, colt, mode = 0; float sc = 1.f;
        if (INDEXER) { if (pn == 0) { base = qi; ldc = 256; colt = 0; } else { base = zpool; ldc = 512; colt = (pn - 2) * 256; } }
        else if (pn < 2) { base = q; ldc = 512; colt = pn * 256; sc = QSCALE; }
        else if (pn < 4) { base = k; ldc = 512; colt = (pn - 2) * 256; }
        else if (pn < 6) { base = v; ldc = 512; colt = (pn - 4) * 256; }
        else { base = gate; ldc = 2048; colt = (pn - 6) * 256; mode = 1; }
        const int col0 = colt + wc * 32 + 8 * fq;
#pragma unroll
        for (int ai = 0; ai < 2; ++ai)
#pragma unroll
            for (int m = 0; m < 4; ++m) { bf16* rowp = base + (size_t)(row0 + ai * 128 + m * 16) * ldc + col0;
#pragma unroll
                for (int bj = 0; bj < 2; ++bj) { f32x4 v0 = acc[ai][bj][m][0], v1 = acc[ai][bj][m][1];
                    if (mode == 1) {
#pragma unroll
                        for (int j = 0; j < 4; ++j) { v0[j] = sigmoidf_(v0[j]); v1[j] = sigmoidf_(v1[j]); } }
                    else { v0 = v0 * sc; v1 = v1 * sc; }
                    u32x4 w; w.x = cvt_pk_bf16(v0[0], v0[1]); w.y = cvt_pk_bf16(v0[2], v0[3]); w.z = cvt_pk_bf16(v1[0], v1[1]); w.w = cvt_pk_bf16(v1[2], v1[3]);
                    *(u32x4*)(rowp + bj * 128) = w; } }
    }
};
__device__ __forceinline__ void store16_wt(const void* base, unsigned byteoff, u32x4 v) { asm volatile("global_store_dwordx4 %0, %1, %2 sc0 sc1\n\ts_nop 1" :: "v"(byteoff), "v"(v), "s"((GAS const void*)base) : "memory"); }
template <bool ADD> struct EpiGate {
    static constexpr bool PERM = true;
    bf16* merged; const bf16* gate; int goff;
    __device__ __forceinline__ void operator()(const f32x4 (&acc)[2][2][4][2], const pg8::Unit& u, int wr, int wc, int fr, int fq) const {
        const int row0 = u.row0 + wr * 64 + fr, col0 = u.pn * 256 + wc * 32 + 8 * fq;
#pragma unroll
        for (int ai = 0; ai < 2; ++ai)
#pragma unroll
            for (int m = 0; m < 4; ++m) { const size_t row = (size_t)(row0 + ai * 128 + m * 16);
#pragma unroll
                for (int bj = 0; bj < 2; ++bj) { const int col = col0 + bj * 128;
                    const u32x4 g = *(const u32x4*)(gate + row * 2048 + goff + col);
                    f32x4 v0 = acc[ai][bj][m][0], v1 = acc[ai][bj][m][1];
                    v0[0] *= bflo(g.x); v0[1] *= bfhi(g.x); v0[2] *= bflo(g.y); v0[3] *= bfhi(g.y); v1[0] *= bflo(g.z); v1[1] *= bfhi(g.z); v1[2] *= bflo(g.w); v1[3] *= bfhi(g.w);
                    if (ADD) { const u32x4 p = *(const u32x4*)(merged + row * 1024 + col);
                        v0[0] += bflo(p.x); v0[1] += bfhi(p.x); v0[2] += bflo(p.y); v0[3] += bfhi(p.y); v1[0] += bflo(p.z); v1[1] += bfhi(p.z); v1[2] += bflo(p.w); v1[3] += bfhi(p.w); }
                    u32x4 w; w.x = cvt_pk_bf16(v0[0], v0[1]); w.y = cvt_pk_bf16(v0[2], v0[3]); w.z = cvt_pk_bf16(v1[0], v1[1]); w.w = cvt_pk_bf16(v1[2], v1[3]);
                    if (ADD) store16_wt((const char*)merged + ((size_t)(ai * 128 + m * 16) * 1024 + bj * 128) * 2, (unsigned)(row0 * 1024 + col0) * 2u, w);
                    else *(u32x4*)(merged + row * 1024 + col) = w; } }
    }
};
struct EpiResidual {
    static constexpr bool PERM = true;
    const float* x; bf16* x1;
    __device__ __forceinline__ void operator()(const f32x4 (&acc)[2][2][4][2], const pg8::Unit& u, int wr, int wc, int fr, int fq) const {
        const int row0 = u.row0 + wr * 64 + fr, col0 = u.pn * 256 + wc * 32 + 8 * fq;
#pragma unroll
        for (int ai = 0; ai < 2; ++ai)
#pragma unroll
            for (int m = 0; m < 4; ++m) { const size_t off = (size_t)(row0 + ai * 128 + m * 16) * D + col0;
#pragma unroll
                for (int bj = 0; bj < 2; ++bj) { const f32x4 b0 = *(const f32x4*)(x + off + bj * 128), b1 = *(const f32x4*)(x + off + bj * 128 + 4);
                    const f32x4 v0 = b0 + acc[ai][bj][m][0], v1 = b1 + acc[ai][bj][m][1];
                    u32x4 w; w.x = cvt_pk_bf16(v0[0], v0[1]); w.y = cvt_pk_bf16(v0[2], v0[3]); w.z = cvt_pk_bf16(v1[0], v1[1]); w.w = cvt_pk_bf16(v1[2], v1[3]);
                    store16_wt((const char*)x1 + ((size_t)(ai * 128 + m * 16) * D + bj * 128) * 2, (unsigned)(row0 * D + col0) * 2u, w); } }
    }
};
__device__ __forceinline__ float clamp448(float x) { return __builtin_amdgcn_fmed3f(x, -448.0f, 448.0f); }
__device__ __forceinline__ unsigned pk4_fp8(float a, float b, float c, float d) { int w = 0; w = __builtin_amdgcn_cvt_pk_fp8_f32(a, b, w, false); w = __builtin_amdgcn_cvt_pk_fp8_f32(c, d, w, true); return (unsigned)w; }
constexpr float ACT_PRESCALE = 4.0f, H_PRESCALE = 8.0f, W_PRESCALE = 128.0f, YS_PRESCALE = 64.0f;
struct EpiSwiGLU {
    static constexpr bool PERM = true;
    unsigned char* act; const LAS float* bias;
    __device__ __forceinline__ void operator()(const f32x4 (&acc)[2][2][4][2], const pg8::Unit& u, int wr, int wc, int fr, int fq) const {
        const int row0 = u.row0 + wr * 64 + fr, colr = u.pn * 128 + wc * 32 + 8 * fq;
        const LAS float* bg = bias + u.raw * 256 + wc * 32 + 8 * fq; const LAS float* bu = bg + 128;
        const f32x4 bg0 = *(const LAS f32x4*)bg, bg1 = *(const LAS f32x4*)(bg + 4), bu0 = *(const LAS f32x4*)bu, bu1 = *(const LAS f32x4*)(bu + 4);
#pragma unroll
        for (int ai = 0; ai < 2; ++ai)
#pragma unroll
            for (int m = 0; m < 4; ++m) { const size_t row = (size_t)(row0 + ai * 128 + m * 16);
                f32x4 g0 = acc[ai][0][m][0] + bg0, g1 = acc[ai][0][m][1] + bg1, u0 = acc[ai][1][m][0] + bu0, u1 = acc[ai][1][m][1] + bu1, r0, r1;
#pragma unroll
                for (int j = 0; j < 4; ++j) {
                    { const float g = fminf(g0[j], 7.0f), uu = fminf(fmaxf(u0[j], -7.0f), 7.0f); r0[j] = g * sigmoidf_(1.702f * g) * (uu + 1.0f) * ACT_PRESCALE; }
                    { const float g = fminf(g1[j], 7.0f), uu = fminf(fmaxf(u1[j], -7.0f), 7.0f); r1[j] = g * sigmoidf_(1.702f * g) * (uu + 1.0f) * ACT_PRESCALE; } }
                u32x2 w; w.x = pk4_fp8(r0[0], r0[1], r0[2], r0[3]); w.y = pk4_fp8(r1[0], r1[1], r1[2], r1[3]);
                *(u32x2*)(act + row * 1024 + colr) = w; }
    }
};
struct EpiMoeOut {
    static constexpr bool PERM = true;
    unsigned char* ys; const LAS float* bias; const LAS int* rows;
    __device__ __forceinline__ void operator()(const f32x4 (&acc)[2][2][4][2], const pg8::Unit& u, int wr, int wc, int fr, int fq) const {
        const int nvalid = u.aux2, slot = u.raw;
        const int col0 = u.pn * 256 + wc * 32 + 8 * fq;
#pragma unroll
        for (int bj = 0; bj < 2; ++bj) {
            const f32x4 bv0 = *(const LAS f32x4*)(bias + slot * 256 + wc * 32 + 8 * fq + bj * 128), bv1 = *(const LAS f32x4*)(bias + slot * 256 + wc * 32 + 8 * fq + bj * 128 + 4);
#pragma unroll
            for (int ai = 0; ai < 2; ++ai)
#pragma unroll
                for (int m = 0; m < 4; ++m) { const int r = ai * 128 + wr * 64 + m * 16 + fr;
                    if (r < nvalid) { const int ts = rows[(slot * 256 + r) * 2]; const float gt = __int_as_float(rows[(slot * 256 + r) * 2 + 1]) * YS_PRESCALE; unsigned char* rowp = ys + (size_t)ts * 1024 + col0;
                        const f32x4 v0 = (acc[ai][bj][m][0] + bv0) * gt, v1 = (acc[ai][bj][m][1] + bv1) * gt;
                        u32x2 w; w.x = pk4_fp8(clamp448(v0[0]), clamp448(v0[1]), clamp448(v0[2]), clamp448(v0[3])); w.y = pk4_fp8(clamp448(v1[0]), clamp448(v1[1]), clamp448(v1[2]), clamp448(v1[3]));
                        *(u32x2*)(rowp + bj * 128) = w; } }
            asm volatile("" ::: "memory");
        }
    }
};

struct MoeSched1 {
    const LAS int* tab; const LAS int* gath; const char* W1T; int G, c;
    __device__ __forceinline__ bool next(int i, pg8::Unit& u, const pg8::LaneRC& rc) const {
        const int T = tab[64], nwg = T * 8; const long L = (long)i * G + c; if (L >= nwg) return false;
        const int wgid = pg8::xcd_remap((int)L, nwg), mt = wgid >> 3, pn = wgid & 7;
        const int te = tab[128 + mt], e = te >> 16, lt = te & 0xffff, cnt = tab[e], pos0 = lt * 256;
#pragma unroll
        for (int h = 0; h < 2; ++h)
#pragma unroll
            for (int i2 = 0; i2 < 2; ++i2) u.aoff[h][i2] = (unsigned)(gath[i * 256 + h * 128 + rc.R[i2]] * 512 + rc.C[i2]) * 2u;
        u.b0 = W1T + ((size_t)e * 2048 + (size_t)pn * 128) * 1024; u.b1 = u.b0 + (size_t)1024 * 1024;
        u.row0 = tab[32 + e] + pos0; u.pn = pn; u.aux = e; u.aux2 = (cnt - pos0 < 256) ? (cnt - pos0) : 256; u.aux3 = pos0; u.raw = i; return true;
    }
    __device__ __forceinline__ void finish(pg8::Unit&, const pg8::LaneRC&) const {}
};
__device__ __forceinline__ void moe_gather_fill(Frame& F, const int* list, const float* b1) {
    const LAS int* tab = (const LAS int*)(F.lds + TAB_OFF); LAS int* gath = (LAS int*)(F.lds + TAB_OFF + 4096); LAS float* bias = (LAS float*)(F.lds + BIAS_OFF);
    const int T = tab[64], nwg = T * 8;
    for (int q = F.tid; q < 9 * 256; q += 512) { const int i = q >> 8, r = q & 255; const long L = (long)i * F.G + (int)blockIdx.x; int tok = 0; float bv = 0.f;
        if (L < nwg) { const int wgid = pg8::xcd_remap((int)L, nwg), mt = wgid >> 3, pn = wgid & 7; const int te = tab[128 + mt], e = te >> 16, lt = te & 0xffff, cnt = tab[e], pos = lt * 256 + r;
            if (pos < cnt) tok = list[(size_t)e * NTOK + pos] >> 2;
            bv = b1[(size_t)e * 2048 + (r < 128 ? 0 : 1024) + pn * 128 + (r & 127)]; }
        gath[q] = tok; bias[q] = bv; }
    __syncthreads();
}
struct MoeSched2 {
    const LAS int* tab; const char* W2T; int G, c;
    __device__ __forceinline__ bool next(int i, pg8::Unit& u, const pg8::LaneRC& rc) const {
        const int T = tab[64], nwg = T * 4; const long L = (long)i * G + c; if (L >= nwg) return false;
        const int wgid = pg8::xcd_remap((int)L, nwg), mt = wgid >> 2, pn = wgid & 3;
        const int te = tab[128 + mt], e = te >> 16, lt = te & 0xffff, cnt = tab[e], pos0 = lt * 256, row0 = tab[32 + e] + pos0;
#pragma unroll
        for (int h = 0; h < 2; ++h)
#pragma unroll
            for (int i2 = 0; i2 < 2; ++i2) u.aoff[h][i2] = (unsigned)((row0 + h * 128 + rc.R[i2]) * 512 + rc.C[i2]) * 2u;
        u.b0 = W2T + ((size_t)e * 1024 + (size_t)pn * 256) * 1024; u.b1 = u.b0 + (size_t)128 * 1024;
        u.row0 = row0; u.pn = pn; u.aux = e; u.aux2 = (cnt - pos0 < 256) ? (cnt - pos0) : 256; u.aux3 = pos0; u.raw = i; return true;
    }
    __device__ __forceinline__ void finish(pg8::Unit&, const pg8::LaneRC&) const {}
};

struct TItem { const float* src; unsigned char* dst; size_t rowpitch; int ldw, k0, col0, nvalid, row0, kbyte0, fp8; };
__device__ __forceinline__ TItem p0_item(int it, const float* w_in, const float* w_ba, const float* w_out, const float* w1, const float* w2, unsigned char* ws) {
    TItem t; constexpr int I_INI = 16 * 4, I_BA = 4 * 4, I_OUT = 16 * 4, I_IN8 = 8 * 14, I_W1 = 32 * 8 * 8;
    int r = it; t.fp8 = 0; t.nvalid = 256;
    if (r < I_INI) { const int kb = r >> 2, nb = r & 3; t.src = w_in; t.dst = ws + WS_WINI; t.ldw = DIN; t.rowpitch = 2048; t.k0 = kb * 64; t.kbyte0 = kb * 128; t.row0 = nb * 256;
        if (nb == 0) { t.col0 = 2048; } else if (nb == 1) { t.col0 = 2304; t.nvalid = 68; } else { t.col0 = (nb - 2) * 256; } return t; } r -= I_INI;
    if (r < I_OUT) { const int kb = r / 4, nb = r % 4; t.src = w_out; t.dst = ws + WS_WOUT; t.ldw = 1024; t.rowpitch = 2048; t.k0 = kb * 64; t.kbyte0 = kb * 128; t.col0 = nb * 256; t.row0 = nb * 256; return t; } r -= I_OUT;
    t.fp8 = 1; t.rowpitch = 1024;
    if (r < I_IN8) { const int kb = r / 14, nb = r % 14; t.src = w_in; t.dst = ws + WS_WIN; t.ldw = DIN; t.k0 = kb * 128; t.kbyte0 = kb * 128; t.row0 = nb * 256;
        t.col0 = (nb < 6) ? 512 + nb * 256 : 2372 + (nb - 6) * 256; return t; } r -= I_IN8;
    if (r < I_BA) { const int kb = r / 4, nb = r % 4; t.src = w_ba; t.dst = ws + WS_WBA; t.ldw = 1024; t.rowpitch = 512; t.k0 = kb * 128; t.kbyte0 = kb * 128; t.col0 = nb * 256; t.row0 = nb * 256; return t; } r -= I_BA;
    if (r < I_W1) { const int e = r >> 6, q = r & 63, kb = q >> 3, nb = q & 7; t.src = w1 + (size_t)e * 1024 * 2048; t.dst = ws + WS_W1 + (size_t)e * 2048 * 1024; t.ldw = 2048; t.k0 = kb * 128; t.kbyte0 = kb * 128; t.col0 = nb * 256; t.row0 = nb * 256; return t; } r -= I_W1;
    { const int e = r >> 5, q = r & 31, kb = q >> 2, nb = q & 3; t.src = w2 + (size_t)e * 1024 * 1024; t.dst = ws + WS_W2 + (size_t)e * 1024 * 1024; t.ldw = 1024; t.k0 = kb * 128; t.kbyte0 = kb * 128; t.col0 = nb * 256; t.row0 = nb * 256; return t; }
}
template <bool ONLY8> __device__ __forceinline__ void p0_load(const TItem& t, int wave, int lane, float (&v)[16][4]) {
    const int rpw = (ONLY8 || t.fp8) ? 16 : 8;
#pragma unroll
    for (int r = 0; r < 16; ++r) if (r < rpw) { const float* row = t.src + (size_t)(t.k0 + wave * rpw + r) * t.ldw + t.col0;
#pragma unroll
        for (int j = 0; j < 4; ++j) { const int n = lane + 64 * j; v[r][j] = (n < t.nvalid) ? __builtin_nontemporal_load(row + n) : 0.f; } }
}
constexpr int IT_W1_BEG = 256, IT_W1_END = 256 + 2048, IT_END = IT_W1_END + 1024, NW1T = 512, NW2T = 512, TAIL_PER = 12;
constexpr int MINI_W1_ITEMS = 2048 - NW1T, MINI_ITEMS = MINI_W1_ITEMS + (1024 - NW2T);
template <bool ONLY8> __device__ __forceinline__ void p0_copy(Frame& F, int j, const int j_end, const int stride, const int skip_at, const int skip_n) {
    refresh(F);
    const float* w_in = F.in(IN_WIN); const float* w_ba = F.in(IN_WBA); const float* w_out = F.in(IN_WOUT); const float* w1 = F.in(IN_W1); const float* w2 = F.in(IN_W2);
    constexpr int TPITCH = 144, TBYTES = 256 * TPITCH;
    const int wave = F.wave, lane = F.lane, tid = F.tid;
    __syncthreads();
    float v[16][4];
    int buf = 0;
    TItem cur; if (j < j_end) { cur = p0_item(j + (j >= skip_at ? skip_n : 0), w_in, w_ba, w_out, w1, w2, F.ws); p0_load<ONLY8>(cur, wave, lane, v); }
    while (j < j_end) {
        LAS unsigned char* T = F.lds + buf * TBYTES;
        if (ONLY8 || cur.fp8) {
#pragma unroll
            for (int jj = 0; jj < 4; ++jj) { u32x4 o; o.x = pk4_fp8(clamp448(v[0][jj] * W_PRESCALE), clamp448(v[1][jj] * W_PRESCALE), clamp448(v[2][jj] * W_PRESCALE), clamp448(v[3][jj] * W_PRESCALE)); o.y = pk4_fp8(clamp448(v[4][jj] * W_PRESCALE), clamp448(v[5][jj] * W_PRESCALE), clamp448(v[6][jj] * W_PRESCALE), clamp448(v[7][jj] * W_PRESCALE));
                o.z = pk4_fp8(clamp448(v[8][jj] * W_PRESCALE), clamp448(v[9][jj] * W_PRESCALE), clamp448(v[10][jj] * W_PRESCALE), clamp448(v[11][jj] * W_PRESCALE)); o.w = pk4_fp8(clamp448(v[12][jj] * W_PRESCALE), clamp448(v[13][jj] * W_PRESCALE), clamp448(v[14][jj] * W_PRESCALE), clamp448(v[15][jj] * W_PRESCALE));
                *(LAS u32x4*)(T + (lane + 64 * jj) * TPITCH + wave * 16) = o; }
        } else {
#pragma unroll
            for (int jj = 0; jj < 4; ++jj) { u32x4 o; o.x = pk2(v[0][jj], v[1][jj]); o.y = pk2(v[2][jj], v[3][jj]); o.z = pk2(v[4][jj], v[5][jj]); o.w = pk2(v[6][jj], v[7][jj]);
                *(LAS u32x4*)(T + (lane + 64 * jj) * TPITCH + wave * 16) = o; }
        }
        const int nj = j + stride; TItem nxt = cur;
        if (nj < j_end) { nxt = p0_item(nj + (nj >= skip_at ? skip_n : 0), w_in, w_ba, w_out, w1, w2, F.ws); p0_load<ONLY8>(nxt, wave, lane, v); }
        __syncthreads();
#pragma unroll
        for (int i = 0; i < 4; ++i) { const int p = tid + 512 * i, row = p >> 3, c = p & 7; const u32x4 o = *(const LAS u32x4*)(T + row * TPITCH + c * 16);
            *(u32x4*)(cur.dst + (size_t)(cur.row0 + row) * cur.rowpitch + cur.kbyte0 + c * 16) = o; }
        cur = nxt; j = nj; buf ^= 1;
    }
    __syncthreads();
}
__device__ __forceinline__ void p0_prologue(Frame& F) {
    refresh(F);
    const float* pool_w = F.in(IN_POOLW); const float* pool_scale = F.in(IN_POOLS); const float* w_bp = F.in(IN_WBP); const float* x = F.in(IN_X); const float* mix_norm = F.in(IN_MIXN);
    p0_copy<false>(F, (int)blockIdx.x, IT_W1_BEG, (int)gridDim.x, 1 << 30, 0);
    {
        const int gt = F.gw * 64 + F.lane, ngt = F.ngw * 64;
        for (int idx = gt; idx < 4 * 32 * 1024; idx += ngt) { const int d = idx & 1023, cq = (idx >> 10) & 31, g = idx >> 15;
            const float* pw = pool_w + ((size_t)g * 128 + cq * 4) * 128; const float* ps = pool_scale + g * 128; const float* wb = w_bp + (size_t)(g * 128) * 1024 + d;
            float a0 = 0.f, a1 = 0.f, a2 = 0.f, a3 = 0.f;
#pragma unroll 16
            for (int j = 0; j < 128; ++j) { const float wv = wb[(size_t)j * 1024] * ps[j]; a0 += pw[j] * wv; a1 += pw[128 + j] * wv; a2 += pw[256 + j] * wv; a3 += pw[384 + j] * wv; }
            u32x2 o; o.x = pk2(a0, a1); o.y = pk2(a2, a3);
            *(u32x2*)(F.w<bf16>(WS_WPC) + (size_t)d * 512 + g * 128 + cq * 4) = o; }
    }
    {
        const int lane = F.lane, st = F.ngw; bf16* Hh = F.w<bf16>(WS_H); unsigned* H8 = F.w<unsigned>(WS_H8X);
        f32x4 va[4], vb[4]; int m = F.gw;
        auto ld = [&](f32x4 (&v)[4], int mm) { const f32x4* xr = (const f32x4*)(x + (size_t)mm * D) + lane;
#pragma unroll
            for (int j = 0; j < 4; ++j) v[j] = __builtin_nontemporal_load(xr + 64 * j); };
        auto row = [&](const f32x4 (&v)[4], int mm) { float ss = 0.f;
#pragma unroll
            for (int j = 0; j < 4; ++j) ss += (v[j].x * v[j].x + v[j].y * v[j].y) + (v[j].z * v[j].z + v[j].w * v[j].w);
            const float rstd = 1.0f / sqrtf(wave_sum(ss) * (1.f / D) + RMS_EPS);
            const f32x4* gr = (const f32x4*)mix_norm + lane; u32x2* o8 = (u32x2*)(Hh + (size_t)mm * D) + lane;
#pragma unroll
            for (int j = 0; j < 4; ++j) { const f32x4 g = gr[64 * j]; const float h0 = v[j].x * rstd * g.x, h1 = v[j].y * rstd * g.y, h2 = v[j].z * rstd * g.z, h3 = v[j].w * rstd * g.w;
                u32x2 w; w.x = pk2(h0, h1); w.y = pk2(h2, h3); o8[64 * j] = w;
                H8[(size_t)mm * 256 + lane + 64 * j] = pk4_fp8(clamp448(h0 * H_PRESCALE), clamp448(h1 * H_PRESCALE), clamp448(h2 * H_PRESCALE), clamp448(h3 * H_PRESCALE)); } };
        if (m < NTOK) ld(va, m);
        while (m < NTOK) { const int m2 = m + st, m3 = m2 + st;
            if (m2 < NTOK) ld(vb, m2);
            row(va, m);
            if (m3 < NTOK) ld(va, m3);
            if (m2 < NTOK) row(vb, m2);
            m = m3; }
    }
}

__device__ __forceinline__ unsigned pk_f16(float a, float b) { const unsigned short x = __builtin_bit_cast(unsigned short, (_Float16)a), y = __builtin_bit_cast(unsigned short, (_Float16)b); return (unsigned)x | ((unsigned)y << 16); }
typedef _Float16 f16x2 __attribute__((ext_vector_type(2)));
__device__ __forceinline__ unsigned pk_f16v(f32x2 v) { return __builtin_bit_cast(unsigned, __builtin_convertvector(v, f16x2)); }
__device__ __forceinline__ void score_seg(int b, int qb, int kb0, int nkb, const bf16* QI, const bf16* KI, const float* WI, unsigned short* SC, LAS unsigned char* stile, int lane) {
    const int r32 = lane & 31, hi = lane >> 5;
    const size_t qrow = (size_t)b * SEQ + 32 * qb + r32;
    bf16x8 qf[4][4];
#pragma unroll
    for (int h = 0; h < 4; ++h)
#pragma unroll
        for (int kk = 0; kk < 4; ++kk) qf[h][kk] = *(const bf16x8*)(QI + qrow * 256 + h * 64 + kk * 16 + hi * 8);
    const f32x4 wv = *(const f32x4*)(WI + qrow * 4);
    const bf16* kip = KI + ((size_t)b * SEQ + r32) * 64 + hi * 8;
    const int kb1 = kb0 + nkb - 1;
    auto body = [&](const bf16x8 (&kf)[4], int kc) {
        f32x2 s2[8];
#pragma unroll
        for (int h = 0; h < 4; ++h) { f32x16 a;
#pragma unroll
            for (int i = 0; i < 16; ++i) a[i] = 0.f;
#pragma unroll
            for (int kk = 0; kk < 4; ++kk) a = __builtin_amdgcn_mfma_f32_32x32x16_bf16(kf[kk], qf[h][kk], a, 0, 0, 0);
            const f32x2 w2 = {wv[h], wv[h]};
#pragma unroll
            for (int j = 0; j < 8; ++j) { f32x2 r; r.x = __int_as_float(max(__float_as_int(a[2 * j]), 0)); r.y = __int_as_float(max(__float_as_int(a[2 * j + 1]), 0));
                s2[j] = (h == 0) ? (w2 * r + (f32x2){0.f, 0.f}) : (w2 * r + s2[j]); } }
#pragma unroll
        for (int g = 0; g < 4; ++g) { u32x2 o; o.x = pk_f16v(s2[2 * g]); o.y = pk_f16v(s2[2 * g + 1]); *(LAS u32x2*)(stile + r32 * 80 + (8 * g + 4 * hi) * 2) = o; }
        LDS_WAIT(); asm volatile("" ::: "memory");
#pragma unroll
        for (int i = 0; i < 2; ++i) { const int rr = i * 16 + (lane >> 2), cc = lane & 3; const u32x4 o = *(const LAS u32x4*)(stile + rr * 80 + cc * 16);
            *(u32x4*)(SC + ((size_t)b * SEQ + 32 * qb + rr) * SEQ + 32 * kc + cc * 8) = o; }
        LDS_WAIT(); asm volatile("" ::: "memory");
    };
    bf16x8 kA[4], kB[4];
#pragma unroll
    for (int kk = 0; kk < 4; ++kk) kA[kk] = *(const bf16x8*)(kip + (size_t)(32 * kb0) * 64 + kk * 16);
    asm volatile("" :: "v"(kA[0]), "v"(kA[1]), "v"(kA[2]), "v"(kA[3]), "v"(wv), "v"(qf[0][0]), "v"(qf[0][1]), "v"(qf[0][2]), "v"(qf[0][3]), "v"(qf[1][0]), "v"(qf[1][1]), "v"(qf[1][2]), "v"(qf[1][3]), "v"(qf[2][0]), "v"(qf[2][1]), "v"(qf[2][2]), "v"(qf[2][3]), "v"(qf[3][0]), "v"(qf[3][1]), "v"(qf[3][2]), "v"(qf[3][3]));
#pragma unroll 1
    for (int kc = kb0; kc <= kb1; kc += 2) {
        { const int kn = (kc + 1 <= kb1) ? kc + 1 : kb1;
#pragma unroll
          for (int kk = 0; kk < 4; ++kk) kB[kk] = *(const bf16x8*)(kip + (size_t)(32 * kn) * 64 + kk * 16); }
        __builtin_amdgcn_sched_barrier(0);
        body(kA, kc);
        if (kc + 1 > kb1) break;
        { const int kn = (kc + 2 <= kb1) ? kc + 2 : kb1;
#pragma unroll
          for (int kk = 0; kk < 4; ++kk) kA[kk] = *(const bf16x8*)(kip + (size_t)(32 * kn) * 64 + kk * 16); }
        __builtin_amdgcn_sched_barrier(0);
        body(kB, kc + 1);
    }
}
template <int W> __device__ __forceinline__ void pooled_group(const bf16* zp, bf16* po, int tok0, int ch) {
    const int t0 = tok0 & (SEQ - 1);
    u32x4 v[7 + W];
#pragma unroll
    for (int r = 0; r < 7 + W; ++r) { const int rel = r - (W - 1); v[r] = (u32x4){0u, 0u, 0u, 0u}; if (t0 + rel >= 0) v[r] = *(const u32x4*)(zp + (size_t)(tok0 + rel) * 512 + ch * 8); }
    float s[8];
#pragma unroll
    for (int j = 0; j < 8; ++j) s[j] = 0.f;
#pragma unroll
    for (int r = 0; r < W; ++r) { s[0] += bflo(v[r].x); s[1] += bfhi(v[r].x); s[2] += bflo(v[r].y); s[3] += bfhi(v[r].y); s[4] += bflo(v[r].z); s[5] += bfhi(v[r].z); s[6] += bflo(v[r].w); s[7] += bfhi(v[r].w); }
#pragma unroll
    for (int j = 0; j < 8; ++j) {
        if (j > 0) { const u32x4 a = v[W - 1 + j], b = v[j - 1];
            s[0] += bflo(a.x) - bflo(b.x); s[1] += bfhi(a.x) - bfhi(b.x); s[2] += bflo(a.y) - bflo(b.y); s[3] += bfhi(a.y) - bfhi(b.y); s[4] += bflo(a.z) - bflo(b.z); s[5] += bfhi(a.z) - bfhi(b.z); s[6] += bflo(a.w) - bflo(b.w); s[7] += bfhi(a.w) - bfhi(b.w); }
        const int n = (t0 + j + 1 < W) ? t0 + j + 1 : W; const float inv = 1.0f / (float)n; const u32x4 cur = v[W - 1 + j];
        u32x4 o; o.x = pk2(s[0] * inv - bflo(cur.x), s[1] * inv - bfhi(cur.x)); o.y = pk2(s[2] * inv - bflo(cur.y), s[3] * inv - bfhi(cur.y));
        o.z = pk2(s[4] * inv - bflo(cur.z), s[5] * inv - bfhi(cur.z)); o.w = pk2(s[6] * inv - bflo(cur.w), s[7] * inv - bfhi(cur.w));
        STORE16_WT(po + (size_t)(tok0 + j) * 512 + ch * 8, o); }
}
__device__ __forceinline__ void p2_pooled(Frame& F) {
    refresh(F);
    const bf16* zp = F.w<bf16>(WS_ZPOOL); bf16* po = F.w<bf16>(WS_POOLED);
    for (int wv = F.gw; wv < NTOK / 8 * 64 / 64; wv += F.ngw) {
        const int g = wv & 3, tg = (wv >> 2) * 4 + (F.lane >> 4), ch = g * 16 + (F.lane & 15), tok0 = tg * 8;
        if (g == 0) pooled_group<2>(zp, po, tok0, ch); else if (g == 1) pooled_group<4>(zp, po, tok0, ch); else if (g == 2) pooled_group<8>(zp, po, tok0, ch); else pooled_group<16>(zp, po, tok0, ch);
        VM_WAIT();
        if (F.lane == 0) (void)__hip_atomic_fetch_add(F.ctl() + CW_PAND + 32 * (wv >> 5), 1u, RLX_AGENT);
    }
}

__device__ __forceinline__ unsigned sortable(float v) { const unsigned u = __float_as_uint(v); return u ^ ((u >> 31) ? 0xFFFFFFFFu : 0x80000000u); }
__device__ __forceinline__ unsigned dpp_scan64(unsigned v) {
    v += (unsigned)__builtin_amdgcn_update_dpp(0, (int)v, 0x111, 0xf, 0xf, false);
    v += (unsigned)__builtin_amdgcn_update_dpp(0, (int)v, 0x112, 0xf, 0xf, false);
    v += (unsigned)__builtin_amdgcn_update_dpp(0, (int)v, 0x114, 0xf, 0xf, false);
    v += (unsigned)__builtin_amdgcn_update_dpp(0, (int)v, 0x118, 0xf, 0xf, false);
    v += (unsigned)__builtin_amdgcn_update_dpp(0, (int)v, 0x142, 0xa, 0xf, false);
    v += (unsigned)__builtin_amdgcn_update_dpp(0, (int)v, 0x143, 0xc, 0xf, false);
    return v;
}
__device__ __forceinline__ unsigned umed3(unsigned a, unsigned b, unsigned c) { unsigned r; asm("v_med3_u32 %0, %1, %2, %3" : "=v"(r) : "v"(a), "v"(b), "v"(c)); return r; }
__device__ __forceinline__ void find_bin256(LAS unsigned* hist, int lane, int& k, int& bin, int& bincnt) {
    u32x4 h = *(const LAS u32x4*)(hist + 4 * lane);
#pragma unroll
    for (int c_ = 1; c_ < 8; ++c_) { const u32x4 hc = *(const LAS u32x4*)(hist + c_ * 256 + 4 * lane); h.x += hc.x; h.y += hc.y; h.z += hc.z; h.w += hc.w; }
    const unsigned ls = (h.x + h.y) + (h.z + h.w);
    const unsigned pre = dpp_scan64(ls);
    const unsigned tot = (unsigned)__builtin_amdgcn_readlane((int)pre, 63);
    const unsigned above = tot - pre;
    const bool mine = (above < (unsigned)k) && (above + ls >= (unsigned)k);
    unsigned c = above; int sub; unsigned cnt;
    if (c + h.w >= (unsigned)k) { sub = 3; cnt = h.w; } else { c += h.w; if (c + h.z >= (unsigned)k) { sub = 2; cnt = h.z; } else { c += h.z; if (c + h.y >= (unsigned)k) { sub = 1; cnt = h.y; } else { c += h.y; sub = 0; cnt = h.x; } } }
    const u64 bm = __ballot(mine);
    const int L = (int)__builtin_ctzll(bm | (1ull << 63));
    bin = 4 * L + __builtin_amdgcn_readlane(sub, L); const int ab = __builtin_amdgcn_readlane((int)c, L); bincnt = __builtin_amdgcn_readlane((int)cnt, L);
    k -= ab;
}
__device__ __forceinline__ void p3_load_row(const unsigned short* sc, int row, unsigned (&v)[32], int lane) {
    const int t = row & (SEQ - 1), n = t + 1;
    const int ngrp = (n <= TOPK) ? 0 : ((n + 1023) >> 10); const unsigned* srow = (const unsigned*)(sc + (size_t)row * SEQ) + lane;
#pragma unroll
    for (int g = 0; g < 4; ++g) if (g < ngrp) {
#pragma unroll
        for (int i = 0; i < 8; ++i) v[g * 8 + i] = srow[(g * 8 + i) * 64]; }
}
__device__ __forceinline__ unsigned p3_keys(unsigned w, int e0, int t) {
    unsigned x = w ^ 0x80008000u ^ (((w >> 15) & 0x00010001u) * 0x7fffu);
    if (e0 > t) x = 0u; else if (e0 + 1 > t) x &= 0xffffu;
    return x;
}
struct NoStage { __device__ __forceinline__ void operator()(int) const {} };
template <class LD = NoStage> __device__ __forceinline__ void p3_select_row(Frame& F, int row, LAS unsigned* hist, const unsigned (&key)[32], const LD& ld = LD()) {
    const int lane = F.lane, t = row & (SEQ - 1), n = t + 1;
    u64* mrow = (F.w<u64>(WS_MASK)) + (size_t)row * 64;
    if (n <= TOPK) {
        const int lo = lane * 64; unsigned we, wo;
        if (t >= lo + 63) { we = ~0u; wo = ~0u; } else if (t >= lo) { const int ce = ((t - lo) >> 1) + 1, co = (t - lo + 1) >> 1; we = (ce >= 32) ? ~0u : ((1u << ce) - 1u); wo = (co >= 32) ? ~0u : ((1u << co) - 1u); } else { we = 0u; wo = 0u; }
        { const u32x2 mv = {we, wo}; STORE8_WT(mrow + lane, mv); }
        ld(0); ld(1); ld(2); ld(3);
        return;
    }
    const int ngrp = (n + 1023) >> 10;
#define HZERO() do { _Pragma("unroll") for (int j_ = 0; j_ < 9; ++j_) { if (j_ < 8 || lane < 16) *(LAS u32x4*)(hist + 4 * lane + 256 * j_) = (u32x4){0u, 0u, 0u, 0u}; } LDS_WAIT(); } while (0)
    int k = TOPK, bin, bincnt; unsigned T; LAS unsigned* hmine = hist + (lane & 7) * 256;
    ld(0);
    unsigned m0 = 0u, m1 = 0u, m2 = 0u, m3 = 0u;
#pragma unroll
    for (int g = 0; g < 4; ++g) if (g < ngrp) {
#pragma unroll
        for (int i = 0; i < 8; ++i) { const unsigned kv = key[g * 8 + i], kA = kv & 0xffffu, kB = kv >> 16;
            m3 = umed3(m2, m3, kA); m2 = umed3(m1, m2, kA); m1 = umed3(m0, m1, kA); m0 = max(m0, kA);
            m3 = umed3(m2, m3, kB); m2 = umed3(m1, m2, kB); m1 = umed3(m0, m1, kB); m0 = max(m0, kB); } }
    const unsigned Lc = 0xffffu - wave_max_u32(0xffffu - m3);
    ld(1);
    HZERO();
#pragma unroll
    for (int g = 0; g < 4; ++g) if (g < ngrp) {
#pragma unroll
        for (int i = 0; i < 8; ++i) { const unsigned kv = key[g * 8 + i], kA = kv & 0xffffu, kB = kv >> 16;
            if (kA >= Lc) __hip_atomic_fetch_add(hmine + (kA >> 8), 1u, __ATOMIC_RELAXED, __HIP_MEMORY_SCOPE_WORKGROUP);
            if (kB >= Lc) __hip_atomic_fetch_add(hmine + (kB >> 8), 1u, __ATOMIC_RELAXED, __HIP_MEMORY_SCOPE_WORKGROUP); } }
    LDS_WAIT(); asm volatile("" ::: "memory");
    find_bin256(hist, lane, k, bin, bincnt); T = (unsigned)bin << 8;
    LDS_WAIT(); asm volatile("" ::: "memory");
    ld(2);
    if (bincnt != k) {
        const unsigned b0 = (unsigned)bin;
        HZERO();
#pragma unroll
        for (int g = 0; g < 4; ++g) if (g < ngrp) {
#pragma unroll
            for (int i = 0; i < 8; ++i) { const unsigned kv = key[g * 8 + i];
                if (((kv >> 8) & 0xffu) == b0 && (kv & 0xffffu) >= Lc) __hip_atomic_fetch_add(hmine + (kv & 0xffu), 1u, __ATOMIC_RELAXED, __HIP_MEMORY_SCOPE_WORKGROUP);
                if ((kv >> 24) == b0 && (kv >> 16) >= Lc) __hip_atomic_fetch_add(hmine + ((kv >> 16) & 0xffu), 1u, __ATOMIC_RELAXED, __HIP_MEMORY_SCOPE_WORKGROUP); } }
        LDS_WAIT(); asm volatile("" ::: "memory");
        find_bin256(hist, lane, k, bin, bincnt); T |= (unsigned)bin;
        LDS_WAIT(); asm volatile("" ::: "memory");
    }
#undef HZERO
    ld(3);
    T = max(T, Lc);
    const bool exact = (bincnt == k); const int krem = k;
    LAS u32x2* mw = (LAS u32x2*)(hist + 2112);
    mw[lane] = (u32x2){0u, 0u};
    if (exact) {
#pragma unroll
        for (int g = 0; g < 4; ++g) if (g < ngrp) {
#pragma unroll
            for (int i8 = 0; i8 < 8; ++i8) { const int i = g * 8 + i8; const unsigned kv = key[i]; const u64 bA = __ballot((kv & 0xffffu) >= T), bB = __ballot((kv >> 16) >= T);
                if (lane == 0) *(LAS u32x4*)(mw + 2 * i) = (u32x4){(unsigned)bA, (unsigned)bB, (unsigned)(bA >> 32), (unsigned)(bB >> 32)}; } }
    } else {
        const u64 lt_mask = (1ull << lane) - 1ull; int base_eq = 0;
#pragma unroll
        for (int g = 0; g < 4; ++g) if (g < ngrp) {
#pragma unroll
            for (int i8 = 0; i8 < 8; ++i8) { const int i = g * 8 + i8; const unsigned kv = key[i], kA = kv & 0xffffu, kB = kv >> 16;
                const bool eqA = kA == T, eqB = kB == T;
                const u64 beA = __ballot(eqA), beB = __ballot(eqB);
                const int rA = base_eq + __popcll(beA & lt_mask) + __popcll(beB & lt_mask), rB = rA + (eqA ? 1 : 0);
                const u64 bA = __ballot(kA > T || (eqA && rA < krem)), bB = __ballot(kB > T || (eqB && rB < krem));
                if (lane == 0) { mw[2 * i] = (u32x2){(unsigned)bA, (unsigned)bB}; mw[2 * i + 1] = (u32x2){(unsigned)(bA >> 32), (unsigned)(bB >> 32)}; }
                base_eq += __popcll(beA) + __popcll(beB); } }
    }
    LDS_WAIT(); asm volatile("" ::: "memory");
    { const u32x2 w = mw[lane]; STORE8_WT(mrow + lane, w); }
    LDS_WAIT(); asm volatile("" ::: "memory");
}
__device__ __forceinline__ void p3_select(Frame& F) {
    refresh(F);
    LAS unsigned* hist = (LAS unsigned*)(F.lds + F.wave * 9216);
    const unsigned short* sc = F.w<unsigned short>(WS_SC);
    for (int j = F.gw; j < 2048; j += F.ngw) {
        unsigned v[32], key[32];
        p3_load_row(sc, j, v, F.lane);
#pragma unroll 1
        for (int q = 0; q < 8; ++q) { const int b = q >> 1, t = (q & 1) ? (SEQ - 1 - j) : j, row = b * SEQ + t;
            const int n = t + 1;
            if (n > TOPK) {
                const int ngrp = (n + 1023) >> 10;
#pragma unroll
                for (int g = 0; g < 4; ++g) {
                    if (g < ngrp) {
#pragma unroll
                        for (int i = 0; i < 8; ++i) key[g * 8 + i] = p3_keys(v[g * 8 + i], (g * 8 + i) * 128 + 2 * F.lane, t);
                    } else {
#pragma unroll
                        for (int i = 0; i < 8; ++i) key[g * 8 + i] = 0u;
                    } }
            }
            if (q < 7) { const int q2 = q + 1, b2 = q2 >> 1, t2 = (q2 & 1) ? (SEQ - 1 - j) : j; p3_load_row(sc, b2 * SEQ + t2, v, F.lane); }
            p3_select_row(F, row, hist, key);
        }
    }
}

struct MiniJob { const float* src; unsigned char* dst; int ldw; };
__device__ __forceinline__ MiniJob mini_job(int mi, const float* w1, const float* w2, unsigned char* ws) {
    MiniJob j; const int it = mi >> 3, cg = mi & 7;
    if (it < MINI_W1_ITEMS) { const int e = it >> 6, q = it & 63, kb = q >> 3, nb = q & 7; j.ldw = 2048;
        j.src = w1 + (size_t)e * 1024 * 2048 + (size_t)(kb * 128) * 2048 + nb * 256 + cg * 32; j.dst = ws + WS_W1 + ((size_t)e * 2048 + nb * 256 + cg * 32) * 1024 + kb * 128; }
    else { const int r = it - MINI_W1_ITEMS, e = r >> 5, q = r & 31, kb = q >> 2, nb = q & 3; j.ldw = 1024;
        j.src = w2 + (size_t)e * 1024 * 1024 + (size_t)(kb * 128) * 1024 + nb * 256 + cg * 32; j.dst = ws + WS_W2 + ((size_t)e * 1024 + nb * 256 + cg * 32) * 1024 + kb * 128; }
    return j;
}
__device__ __forceinline__ void mini_load(const MiniJob& j, int lane, f32x4 (&cv)[16], int jj) {
    const float* p = j.src + (size_t)(4 * (lane >> 3)) * j.ldw + 4 * (lane & 7);
#pragma unroll
    for (int r = 0; r < 4; ++r) cv[jj * 4 + r] = __builtin_nontemporal_load((const f32x4*)(p + (size_t)(32 * jj + r) * j.ldw));
}
__device__ __forceinline__ void mini_finish(const MiniJob& j, int lane, const f32x4 (&cv)[16], LAS unsigned char* tile) {
    const int k4 = lane >> 3, p = lane & 7;
#pragma unroll
    for (int jj = 0; jj < 4; ++jj) { unsigned d[4];
#pragma unroll
        for (int r = 0; r < 4; ++r) { const f32x4 v = cv[jj * 4 + r]; d[r] = pk4_fp8(clamp448(v.x * W_PRESCALE), clamp448(v.y * W_PRESCALE), clamp448(v.z * W_PRESCALE), clamp448(v.w * W_PRESCALE)); }
        const unsigned a01l = __builtin_amdgcn_perm(d[1], d[0], 0x05010400u), a01h = __builtin_amdgcn_perm(d[1], d[0], 0x07030602u), a23l = __builtin_amdgcn_perm(d[3], d[2], 0x05010400u), a23h = __builtin_amdgcn_perm(d[3], d[2], 0x07030602u);
        const unsigned t0 = __builtin_amdgcn_perm(a23l, a01l, 0x05040100u), t1 = __builtin_amdgcn_perm(a23l, a01l, 0x07060302u), t2 = __builtin_amdgcn_perm(a23h, a01h, 0x05040100u), t3 = __builtin_amdgcn_perm(a23h, a01h, 0x07060302u);
        LAS unsigned char* tp = tile + (4 * p) * 144 + 32 * jj + 4 * k4;
        *(LAS unsigned*)tp = t0; *(LAS unsigned*)(tp + 144) = t1; *(LAS unsigned*)(tp + 288) = t2; *(LAS unsigned*)(tp + 432) = t3; }
    LDS_WAIT(); asm volatile("" ::: "memory");
    { const int n = lane >> 1, h = lane & 1;
#pragma unroll
      for (int i = 0; i < 4; ++i) { const u32x4 o = *(const LAS u32x4*)(tile + n * 144 + h * 64 + i * 16); *(u32x4*)(j.dst + (size_t)n * 1024 + h * 64 + i * 16) = o; } }
    LDS_WAIT(); asm volatile("" ::: "memory");
}
__device__ __forceinline__ void p2_scores_select(Frame& F) {
    refresh(F);
    const int lane = F.lane, wave = F.wave;
    const bf16* QI = F.w<bf16>(WS_QI); const bf16* KI = F.w<bf16>(WS_KI); const float* WI = F.w<float>(WS_WI); unsigned short* SC = F.w<unsigned short>(WS_SC);
    const float* w1 = F.in(IN_W1); const float* w2 = F.in(IN_W2);
    for (int unit = blockIdx.x; unit < 256; unit += F.G) {
        const int b = unit >> 6, p = unit & 63, na = p + 1;
        { LAS unsigned char* stile = F.lds + wave * 2560;
          int idx = (wave * 129) >> 3; const int end = ((wave + 1) * 129) >> 3;
          while (idx < end) { int qb, kb, len;
              if (idx < na) { qb = p; kb = idx; len = (na - idx < end - idx) ? (na - idx) : (end - idx); } else { qb = 127 - p; kb = idx - na; len = end - idx; }
              score_seg(b, qb, kb, len, QI, KI, WI, SC, stile, lane); idx += len; } }
        VM_WAIT(); __syncthreads();
        { refresh(F); const int lane = F.lane; int b_ = b, p_ = p, w_ = wave; asm volatile("" : "+s"(b_), "+s"(p_), "+s"(w_));
          LAS unsigned* hist = (LAS unsigned*)(F.lds + w_ * 9216);
          unsigned v[32], key[32];
#pragma unroll
          for (int i = 0; i < 32; ++i) { v[i] = 0u; key[i] = 0u; }
          auto rowof = [&](int q) { return b_ * SEQ + ((q & 1) ? 32 * (127 - p_) : 32 * p_) + 4 * w_ + (q >> 1); };
          p3_load_row(SC, rowof(0), v, lane);
#pragma unroll 1
          for (int q = 0; q < 8; ++q) { const int row = rowof(q), t = row & (SEQ - 1), n = t + 1;
              const MiniJob mj = mini_job(__builtin_amdgcn_readfirstlane((unit * 8 + w_) * 8 + q), w1, w2, F.ws); f32x4 cv[16];
              if (n > TOPK) {
                  const int ngrp = (n + 1023) >> 10;
#pragma unroll
                  for (int g = 0; g < 4; ++g) {
                      if (g < ngrp) {
#pragma unroll
                          for (int i = 0; i < 8; ++i) key[g * 8 + i] = p3_keys(v[g * 8 + i], (g * 8 + i) * 128 + 2 * lane, t);
                      } else {
#pragma unroll
                          for (int i = 0; i < 8; ++i) key[g * 8 + i] = 0u;
                      } }
              }
              if (q < 7) p3_load_row(SC, rowof(q + 1), v, lane);
              auto stage = [&](int part) { if (part == 0) mini_load(mj, lane, cv, 0); else if (part == 1) mini_load(mj, lane, cv, 1); else if (part == 2) mini_load(mj, lane, cv, 2); else mini_load(mj, lane, cv, 3); };
              p3_select_row(F, row, hist, key, stage);
              mini_finish(mj, lane, cv, F.lds + 73728 + w_ * 4608);
          } }
        VM_WAIT(); __syncthreads();
        if (threadIdx.x == 0) { (void)__hip_atomic_fetch_add(F.ctl() + CW_PANE + 32 * (b * 16 + (p >> 3)), 1u, RLX_AGENT); (void)__hip_atomic_fetch_add(F.ctl() + CW_PANE + 32 * (b * 16 + ((127 - p) >> 3)), 1u, RLX_AGENT); }
    }
}

__device__ __forceinline__ int t5_bucket(int n) {
    if (n < 16) return n;
    const int th[16] = {16, 19, 21, 24, 27, 31, 35, 40, 46, 52, 59, 67, 77, 87, 99, 113};
    int b = 16;
#pragma unroll
    for (int i = 1; i < 16; ++i) if (n >= th[i]) b = 16 + i;
    return b;
}
__device__ __forceinline__ void p4_attn_gather(Frame& F) {
    refresh(F);
    const float* rel_bias = F.in(IN_RELB);
    LAS float* biasl = (LAS float*)(F.lds);
    for (int i = F.tid; i < 1024; i += 512) { const int h = i >> 7, d = i & 127; biasl[i] = rel_bias[t5_bucket(d) * 8 + h] * LOG2E; }
    __syncthreads();
    const int lane = F.lane, h = lane >> 3;
    const float bias_far = rel_bias[31 * 8 + h] * LOG2E;
    for (int row = F.gw; row < NTOK; row += F.ngw) {
        const int t = row & (SEQ - 1), b0 = row - t, cnt = (t + 1 < TOPK) ? t + 1 : TOPK;
        const int* irow = (F.w<int>(WS_SELIDX)) + (size_t)row * 256;
        int myidx[4];
        { const u32x4 v = *(const u32x4*)(irow + lane * 4); myidx[0] = (int)v.x; myidx[1] = (int)v.y; myidx[2] = (int)v.z; myidx[3] = (int)v.w; }
        float q[8];
        { const u32x4 v = *(const u32x4*)((F.w<bf16>(WS_Q)) + (size_t)row * 512 + lane * 8); q[0] = bflo(v.x); q[1] = bfhi(v.x); q[2] = bflo(v.y); q[3] = bfhi(v.y); q[4] = bflo(v.z); q[5] = bfhi(v.z); q[6] = bflo(v.w); q[7] = bfhi(v.w); }
        float m = -1e30f, lsum = 0.f, o[8];
#pragma unroll
        for (int j = 0; j < 8; ++j) o[j] = 0.f;
        for (int c0 = 0; c0 < cnt; c0 += 8) {
            u32x4 kv[8], vv[8]; int kid[8]; float lg[8];
#pragma unroll
            for (int j = 0; j < 8; ++j) { const int kk = c0 + j; int id = __shfl(myidx[j & 3], kk >> 2); if (kk >= cnt) id = 0; kid[j] = id;
                kv[j] = *(const u32x4*)((F.w<bf16>(WS_K)) + (size_t)(b0 + id) * 512 + lane * 8); vv[j] = *(const u32x4*)((F.w<bf16>(WS_V)) + (size_t)(b0 + id) * 512 + lane * 8); }
            float cm = -1e30f;
#pragma unroll
            for (int j = 0; j < 8; ++j) { const u32x4 kx = kv[j];
                float d = q[0] * bflo(kx.x) + q[1] * bfhi(kx.x) + q[2] * bflo(kx.y) + q[3] * bfhi(kx.y) + q[4] * bflo(kx.z) + q[5] * bfhi(kx.z) + q[6] * bflo(kx.w) + q[7] * bfhi(kx.w);
                d += __shfl_xor(d, 1); d += __shfl_xor(d, 2); d += __shfl_xor(d, 4);
                const int dist = t - kid[j];
                const float bs = (dist < 128) ? biasl[h * 128 + (dist < 0 ? 0 : dist)] : bias_far;
                lg[j] = (c0 + j < cnt) ? d + bs : -INFINITY;
                cm = fmaxf(cm, lg[j]); }
            const float mn = fmaxf(m, cm), f = __builtin_amdgcn_exp2f(m - mn);
            lsum *= f;
#pragma unroll
            for (int i = 0; i < 8; ++i) o[i] *= f;
            m = mn;
#pragma unroll
            for (int j = 0; j < 8; ++j) { const float p = __builtin_amdgcn_exp2f(lg[j] - m); lsum += p; const u32x4 vx = vv[j];
                o[0] += p * bflo(vx.x); o[1] += p * bfhi(vx.x); o[2] += p * bflo(vx.y); o[3] += p * bfhi(vx.y); o[4] += p * bflo(vx.z); o[5] += p * bfhi(vx.z); o[6] += p * bflo(vx.w); o[7] += p * bfhi(vx.w); }
        }
        const float inv = 1.0f / lsum;
        u32x4 w; w.x = pk2(o[0] * inv, o[1] * inv); w.y = pk2(o[2] * inv, o[3] * inv); w.z = pk2(o[4] * inv, o[5] * inv); w.w = pk2(o[6] * inv, o[7] * inv);
        *(u32x4*)((F.w<bf16>(WS_AO)) + (size_t)row * 512 + lane * 8) = w;
    }
}

__device__ __forceinline__ void p4_attn_dense(Frame& F, char* lds_generic) {
    refresh(F);
    const float* rel_bias = F.in(IN_RELB);
    LAS float* lut8 = (LAS float*)(F.lds + TAB_OFF);
    for (int i = F.tid; i < 1024; i += 512) { const int h = i >> 7, d = i & 127; lut8[i] = (d < 113) ? (rel_bias[t5_bucket(d) * 8 + h] - rel_bias[31 * 8 + h]) * LOG2E : 0.f; }
    __syncthreads();
    const attn_body::AttnTensors AT{(const attn_body::bf16*)F.w<bf16>(WS_Q), (const attn_body::bf16*)F.w<bf16>(WS_K), (const attn_body::bf16*)F.w<bf16>(WS_V), (attn_body::bf16*)F.w<bf16>(WS_AO), (const unsigned long long*)F.w<u64>(WS_MASK)};
    const attn_body::StaticOrder S(F.G, (int)blockIdx.x, F.ctl() + CW_PANC, F.ctl() + CW_PANE, F.ctl() + CW_BAR + XB_TMO);
    attn_body::attn_phase<attn_body::StaticOrder>(lds_generic, AT, lut8, S);
}
__device__ __forceinline__ void p7_router(Frame& F) {
    refresh(F);
    const float* w_router = F.in(IN_WR); const float* b_router = F.in(IN_BR); const float* ffn_norm = F.in(IN_FFNN);
    LAS float* X = (LAS float*)F.lds; LAS int* rt = (LAS int*)(F.lds + TAB_OFF); LAS float* LG = (LAS float*)(F.lds + TAB_OFF + 4096); LAS float* RS = (LAS float*)(F.lds + TAB_OFF + 8192);
    const int lane = F.lane, wave = F.wave, n = lane & 31, hi = lane >> 5;
    float bw[64];
#pragma unroll
    for (int q = 0; q < 16; ++q) { const int k0 = 128 * wave + 8 * q + 4 * hi; const f32x4 g = *(const f32x4*)(ffn_norm + k0);
        bw[4 * q] = w_router[(size_t)k0 * 32 + n] * g.x; bw[4 * q + 1] = w_router[(size_t)(k0 + 1) * 32 + n] * g.y; bw[4 * q + 2] = w_router[(size_t)(k0 + 2) * 32 + n] * g.z; bw[4 * q + 3] = w_router[(size_t)(k0 + 3) * 32 + n] * g.w; }
    const f32x4 g0 = *(const f32x4*)(ffn_norm + 8 * lane), g1 = *(const f32x4*)(ffn_norm + 8 * lane + 4), g2 = *(const f32x4*)(ffn_norm + 512 + 8 * lane), g3 = *(const f32x4*)(ffn_norm + 512 + 8 * lane + 4);
    if (F.tid < 32) rt[F.tid] = 0;
    const float brt = b_router[F.tid & 31];
    __syncthreads();
    for (int tg = blockIdx.x; tg < NTOK / 64; tg += F.G) {
        if (threadIdx.x == 0) { panel_poll(F, CW_PANB, tg >> 2, 4u); __builtin_amdgcn_fence(__ATOMIC_ACQUIRE, "agent"); asm volatile("s_waitcnt vmcnt(0)" ::: "memory"); }
        __syncthreads();
#pragma unroll 1
        for (int grp = 0; grp < 2; ++grp) {
            const int tokg = tg * 64 + grp * 32;
            { u32x4 xa[4], xb[4];
#pragma unroll
              for (int i = 0; i < 4; ++i) { const bf16* xr = F.w<bf16>(WS_X1) + (size_t)(tokg + 4 * wave + i) * D + 8 * lane; xa[i] = *(const u32x4*)xr; xb[i] = *(const u32x4*)(xr + 512); }
#pragma unroll
              for (int i = 0; i < 4; ++i) { const int t = 4 * wave + i;
                const f32x4 a0 = {bflo(xa[i].x), bfhi(xa[i].x), bflo(xa[i].y), bfhi(xa[i].y)}, a1 = {bflo(xa[i].z), bfhi(xa[i].z), bflo(xa[i].w), bfhi(xa[i].w)};
                const f32x4 b0 = {bflo(xb[i].x), bfhi(xb[i].x), bflo(xb[i].y), bfhi(xb[i].y)}, b1 = {bflo(xb[i].z), bfhi(xb[i].z), bflo(xb[i].w), bfhi(xb[i].w)};
                float ss = (a0.x * a0.x + a0.y * a0.y) + (a0.z * a0.z + a0.w * a0.w); ss += (a1.x * a1.x + a1.y * a1.y) + (a1.z * a1.z + a1.w * a1.w);
                ss += (b0.x * b0.x + b0.y * b0.y) + (b0.z * b0.z + b0.w * b0.w); ss += (b1.x * b1.x + b1.y * b1.y) + (b1.z * b1.z + b1.w * b1.w);
                LAS float* xrow = X + t * 1024; const int sw = t & 15;
                *(LAS f32x4*)(xrow + (((2 * lane) ^ sw) << 2)) = a0; *(LAS f32x4*)(xrow + (((2 * lane + 1) ^ sw) << 2)) = a1;
                *(LAS f32x4*)(xrow + (((128 + 2 * lane) ^ sw) << 2)) = b0; *(LAS f32x4*)(xrow + (((129 + 2 * lane) ^ sw) << 2)) = b1;
                const float rstd = 1.0f / sqrtf(wave_sum(ss) * (1.f / D) + RMS_EPS), rp = rstd * H_PRESCALE;
                if (lane == 0) RS[t] = rstd;
                unsigned char* hr = F.w<unsigned char>(WS_H) + (size_t)(tokg + t) * D + 8 * lane;
                u32x2 o;
                o.x = pk4_fp8(a0.x * rp * g0.x, a0.y * rp * g0.y, a0.z * rp * g0.z, a0.w * rp * g0.w); o.y = pk4_fp8(a1.x * rp * g1.x, a1.y * rp * g1.y, a1.z * rp * g1.z, a1.w * rp * g1.w); *(u32x2*)hr = o;
                o.x = pk4_fp8(b0.x * rp * g2.x, b0.y * rp * g2.y, b0.z * rp * g2.z, b0.w * rp * g2.w); o.y = pk4_fp8(b1.x * rp * g3.x, b1.y * rp * g3.y, b1.z * rp * g3.z, b1.w * rp * g3.w); *(u32x2*)(hr + 512) = o; } }
            __syncthreads();
            f32x16 acc;
#pragma unroll
            for (int i = 0; i < 16; ++i) acc[i] = 0.f;
            { const LAS float* xrow = X + n * 1024; const int sw = n & 15;
#pragma unroll
              for (int q = 0; q < 16; ++q) { const f32x4 a = *(const LAS f32x4*)(xrow + (((32 * wave + 2 * q + hi) ^ sw) << 2));
                acc = __builtin_amdgcn_mfma_f32_32x32x2f32(a.x, bw[4 * q], acc, 0, 0, 0); acc = __builtin_amdgcn_mfma_f32_32x32x2f32(a.y, bw[4 * q + 1], acc, 0, 0, 0);
                acc = __builtin_amdgcn_mfma_f32_32x32x2f32(a.z, bw[4 * q + 2], acc, 0, 0, 0); acc = __builtin_amdgcn_mfma_f32_32x32x2f32(a.w, bw[4 * q + 3], acc, 0, 0, 0); } }
            __syncthreads();
            { LAS float* P = X + wave * 1024;
#pragma unroll
              for (int i = 0; i < 16; ++i) P[((i & 3) + 8 * (i >> 2) + 4 * hi) * 32 + n] = acc[i]; }
            __syncthreads();
#pragma unroll
            for (int o = 0; o < 2; ++o) { const int idx = F.tid + 512 * o; float s = X[idx];
#pragma unroll
                for (int w = 1; w < 8; ++w) s += X[w * 1024 + idx];
                LG[idx] = s * RS[idx >> 5] + brt; }
            __syncthreads();
#pragma unroll 1
            for (int pass = 0; pass < 2; ++pass) {
                const int t0 = 4 * wave + 2 * pass, tok0 = tokg + t0;
                f32x2 lg; lg.x = LG[t0 * 32 + (lane >> 1)]; lg.y = LG[(t0 + 1) * 32 + (lane >> 1)];
#pragma unroll
                for (int tk = 0; tk < 2; ++tk) {
                    const float v = (tk ? lg.y : lg.x) + 0.f;
                    unsigned sk = sortable(v);
                    float tv[4]; int te[4];
#pragma unroll
                    for (int r = 0; r < 4; ++r) { const unsigned mk = wave_max_u32(sk); const u64 bal = __ballot(sk == mk); const int ln = (int)__builtin_ctzll(bal | (1ull << 63)); const int bi = ln >> 1;
                        tv[r] = __int_as_float(__builtin_amdgcn_readlane(__float_as_int(v), ln)); te[r] = bi; sk = ((lane >> 1) == bi) ? 0u : sk; }
                    const float e1 = __expf(tv[1] - tv[0]), e2 = __expf(tv[2] - tv[0]), e3 = __expf(tv[3] - tv[0]), inv = 1.0f / (1.0f + e1 + e2 + e3);
                    const float gt[4] = {inv, e1 * inv, e2 * inv, e3 * inv};
                    if (lane == 0) { const int tok = tok0 + tk, sl = (tok - tg * 64) * 4;
#pragma unroll
                        for (int r = 0; r < 4; ++r) { const int lp = __hip_atomic_fetch_add(rt + te[r], 1, __ATOMIC_RELAXED, __HIP_MEMORY_SCOPE_WORKGROUP); rt[64 + sl + r] = te[r]; rt[320 + sl + r] = lp; (F.w<float>(WS_TOKGATE))[(size_t)tok * 4 + r] = gt[r]; } }
                }
            }
        }
        __syncthreads();
        if (F.tid < 32) { const int c = rt[F.tid]; int base = 0; if (c) base = (int)__hip_atomic_fetch_add(F.ctl() + CW_ECNT + 64 * F.tid, (unsigned)c, RLX_AGENT); rt[32 + F.tid] = base; }
        __syncthreads();
        if (F.tid < 256) { const int e = rt[64 + F.tid], pos = rt[32 + e] + rt[320 + F.tid]; (F.w<int>(WS_LIST))[(size_t)e * NTOK + pos] = (tg * 64 + (F.tid >> 2)) * 4 + (F.tid & 3); }
        __syncthreads();
        if (F.tid < 32) rt[F.tid] = 0;
        __syncthreads();
    }
}
__device__ __forceinline__ void moe_rows_fill(Frame& F, const int* list, const float* tokgate, const float* b2) {
    const LAS int* tab = (const LAS int*)(F.lds + TAB_OFF); LAS int* rows = (LAS int*)(F.lds + TAB_OFF + 4096); LAS float* bias = (LAS float*)(F.lds + BIAS_OFF);
    const int T = tab[64], nwg = T * 4;
    for (int q = F.tid; q < 5 * 256; q += 512) { const int i = q >> 8, r = q & 255; const long L = (long)i * F.G + (int)blockIdx.x; int ts = 0; float g = 0.f;
        float bv = 0.f;
        if (L < nwg) { const int wgid = pg8::xcd_remap((int)L, nwg), mt = wgid >> 2, pn = wgid & 3; const int te = tab[128 + mt], e = te >> 16, lt = te & 0xffff, cnt = tab[e], pos = lt * 256 + r;
            if (pos < cnt) { ts = list[(size_t)e * NTOK + pos]; g = tokgate[ts]; }
            bv = b2[(size_t)e * 1024 + pn * 256 + r]; }
        rows[2 * q] = ts; rows[2 * q + 1] = __float_as_int(g); bias[q] = bv; }
    __syncthreads();
}
__device__ __forceinline__ void build_moe_tab(Frame& F) {
    refresh(F);
    LAS int* tab = (LAS int*)(F.lds + TAB_OFF);
    if (F.tid < 32) tab[F.tid] = (int)__hip_atomic_load(F.ctl() + CW_ECNT + 64 * F.tid, RLX_AGENT);
    __syncthreads();
    if (F.tid == 0) { int off = 0, T = 0;
        for (int e = 0; e < 32; ++e) { const int c = tab[e], nt = (c + 255) >> 8; tab[32 + e] = off; for (int lt = 0; lt < nt; ++lt) tab[128 + T++] = (e << 16) | lt; off += nt * 256; }
        tab[64] = T; }
    __syncthreads();
}
struct FinRow { u32x2 x[4]; unsigned y[4][4]; };
__device__ __forceinline__ void p10_load(FinRow& r, const bf16* x1, const unsigned char* ys, int m, int lane) {
    const u32x2* xr = (const u32x2*)(x1 + (size_t)m * D) + lane;
#pragma unroll
    for (int j = 0; j < 4; ++j) r.x[j] = __builtin_nontemporal_load(xr + 64 * j);
#pragma unroll
    for (int kq = 0; kq < 4; ++kq) { const unsigned* yr = (const unsigned*)(ys + ((size_t)m * 4 + kq) * D) + lane;
#pragma unroll
        for (int j = 0; j < 4; ++j) r.y[kq][j] = __builtin_nontemporal_load(yr + 64 * j); }
}
__device__ __forceinline__ void p10_row(const FinRow& r, const float* final_norm, float* out, int m, int lane) {
    f32x4 v[4]; float s = 0.f;
#pragma unroll
    for (int j = 0; j < 4; ++j) { f32x4 ysum = {0.f, 0.f, 0.f, 0.f};
#pragma unroll
        for (int kq = 0; kq < 4; ++kq) { const int y = (int)r.y[kq][j]; const auto lo = __builtin_amdgcn_cvt_pk_f32_fp8(y, false), hi2 = __builtin_amdgcn_cvt_pk_f32_fp8(y, true); ysum.x += lo[0]; ysum.y += lo[1]; ysum.z += hi2[0]; ysum.w += hi2[1]; }
        v[j] = (f32x4){bflo(r.x[j].x), bfhi(r.x[j].x), bflo(r.x[j].y), bfhi(r.x[j].y)} + ysum * (1.0f / YS_PRESCALE);
        s += (v[j].x * v[j].x + v[j].y * v[j].y) + (v[j].z * v[j].z + v[j].w * v[j].w); }
    const float rstd = 1.0f / sqrtf(wave_sum(s) * (1.f / D) + RMS_EPS);
    const f32x4* gr = (const f32x4*)final_norm + lane; f32x4* o = (f32x4*)(out + (size_t)m * D) + lane;
#pragma unroll
    for (int j = 0; j < 4; ++j) { const f32x4 g = gr[64 * j]; __builtin_nontemporal_store(v[j] * rstd * g, o + 64 * j); }
}
__device__ __forceinline__ void p10_final(Frame& F) {
    refresh(F);
    const float* final_norm = F.in(IN_FINN); float* out = F.outp();
    const bf16* x1 = F.w<bf16>(WS_X1); const unsigned char* ys = F.w<unsigned char>(WS_YS);
    const int lane = F.lane, st = F.ngw;
    FinRow A, B; int m = F.gw;
    if (m < NTOK) p10_load(A, x1, ys, m, lane);
    while (m < NTOK) {
        const int m2 = m + st, m3 = m2 + st;
        if (m2 < NTOK) p10_load(B, x1, ys, m2, lane);
        p10_row(A, final_norm, out, m, lane);
        if (m3 < NTOK) p10_load(A, x1, ys, m3, lane);
        if (m2 < NTOK) p10_row(B, final_norm, out, m2, lane);
        m = m3;
    }
}

__global__ void __launch_bounds__(NWAVES * 64, 2) fwd_kernel(Args args) {
    extern __shared__ __attribute__((aligned(16))) unsigned char lds[];
    Frame F;
    F.lds = (LAS unsigned char*)lds;
    F.tid = threadIdx.x; F.lane = F.tid & 63; F.wave = __builtin_amdgcn_readfirstlane(F.tid >> 6);
    F.G = gridDim.x; F.gw = blockIdx.x * NWAVES + F.wave; F.ngw = F.G * NWAVES;
    F.ws = args.ws;
    for (int u = F.tid; u < (LDS_BYTES - LDSCTL_OFF) / 4; u += NWAVES * 64) ((LAS unsigned*)(F.lds + LDSCTL_OFF))[u] = 0u;
    __syncthreads();
    XcdBarrier bar = xcd_barrier_post(F.ctl() + CW_BAR, (volatile LAS unsigned*)(F.lds + MISC_OFF) + 8);
    const int bx = (int)blockIdx.x;

    REP(0) p0_prologue(F);
    xcd_barrier(bar);
    {
      { pg8::DenseSched S; S.init(NTOK, 1024, 1024, F.w<bf16>(WS_WINI), F.G, bx);
        EpiInProj<true> E{F.w<bf16>(WS_ZPOOL), F.w<bf16>(WS_Q), F.w<bf16>(WS_K), F.w<bf16>(WS_V), F.w<bf16>(WS_QI), F.w<bf16>(WS_KI), F.w<bf16>(WS_GATE), F.w<float>(WS_WI)};
        pg8::gemm_phase<EpiInProj<true>, pg8::DenseSched, true>(F.lds, (const char*)F.w<bf16>(WS_H), 1024, S, E); }
      { pg8::DenseSched S; S.init(NTOK, 3584, 512, F.w<bf16>(WS_WIN), F.G, bx, 1);
        EpiInProj<false> E{F.w<bf16>(WS_ZPOOL), F.w<bf16>(WS_Q), F.w<bf16>(WS_K), F.w<bf16>(WS_V), F.w<bf16>(WS_QI), F.w<bf16>(WS_KI), F.w<bf16>(WS_GATE), F.w<float>(WS_WI)};
        pg8::gemm_phase<EpiInProj<false>, pg8::DenseSched, true, true, 0x78787878, 0x7c7c7c7c>(F.lds, (const char*)F.w<bf16>(WS_H8X), 512, S, E);
        { const int nidle = S.split ? 128 : F.G; if (bx < nidle) p0_copy<true>(F, IT_W1_END - NW1T + bx, IT_W1_END, nidle, 1 << 30, 0); } } }
    xcd_barrier(bar);
    REP(2) { p2_pooled(F); p2_scores_select(F); }
    panel_wait(F, CW_PAND, 32u);
    { pg8::DenseSched S; S.init(NTOK, 1024, 512, (F.w<bf16>(WS_WPC)), F.G, bx);
      EpiGate<false> E{(F.w<bf16>(WS_MERGED)), (F.w<bf16>(WS_GATE)), 0};
      pg8::gemm_phase<EpiGate<false>, pg8::DenseSched, true>(F.lds, (const char*)(F.w<bf16>(WS_POOLED)), 512, S, E); }
    REP(4) p4_attn_dense(F, (char*)lds);
    panel_wait(F, CW_PANC, 8u);
    { pg8::DenseSched S; S.init(NTOK, 1024, 256, (F.w<bf16>(WS_WBA)), F.G, bx);
      EpiGate<true> E{(F.w<bf16>(WS_MERGED)), (F.w<bf16>(WS_GATE)), 1024};
      pg8::gemm_phase<EpiGate<true>, pg8::DenseSched, true, true, 0x78787878, 0x78787878>(F.lds, (const char*)(F.w<bf16>(WS_AO)), 256, S, E);
      }
    panel_signal(F, CW_PANA);
    panel_wait(F, CW_PANA, 4u);
    REP(6) { pg8::DenseSched S; S.init(NTOK, 1024, 1024, (F.w<bf16>(WS_WOUT)), F.G, bx);
      EpiResidual E{F.in(IN_X), F.w<bf16>(WS_X1)};
      pg8::gemm_phase<EpiResidual, pg8::DenseSched, true>(F.lds, (const char*)(F.w<bf16>(WS_MERGED)), 1024, S, E);
      }
    panel_signal(F, CW_PANB);
    p7_router(F);
    xcd_barrier(bar);
    build_moe_tab(F); moe_gather_fill(F, F.w<int>(WS_LIST), F.in(IN_B1));
    REP(8) { MoeSched1 S{(const LAS int*)(F.lds + TAB_OFF), (const LAS int*)(F.lds + TAB_OFF + 4096), (const char*)(F.w<bf16>(WS_W1)), F.G, bx};
      EpiSwiGLU E{F.w<unsigned char>(WS_ACT), (const LAS float*)(F.lds + BIAS_OFF)};
      pg8::gemm_phase<EpiSwiGLU, MoeSched1, true, true, 0x78787878, 0x7c7c7c7c>(F.lds, (const char*)(F.w<bf16>(WS_H)), 512, S, E); }
    { const int T = ((const LAS int*)(F.lds + TAB_OFF))[64], rem = (T * 8) % F.G, nid = F.G - rem, base = IT_END - NW2T; int cover = nid * TAIL_PER; if (cover > NW2T) cover = NW2T;
      if (bx >= rem) p0_copy<true>(F, base + (bx - rem), base + cover, nid, 1 << 30, 0);
      if (cover < NW2T) p0_copy<true>(F, base + cover + bx, IT_END, F.G, 1 << 30, 0); }
    xcd_barrier(bar);
    moe_rows_fill(F, F.w<int>(WS_LIST), F.w<float>(WS_TOKGATE), F.in(IN_B2));
    REP(9) { MoeSched2 S{(const LAS int*)(F.lds + TAB_OFF), (const char*)(F.w<bf16>(WS_W2)), F.G, bx};
      EpiMoeOut E{F.w<unsigned char>(WS_YS), (const LAS float*)(F.lds + BIAS_OFF), (const LAS int*)(F.lds + TAB_OFF + 4096)};
      pg8::gemm_phase<EpiMoeOut, MoeSched2, true, true, 0x78787878, 0x7d7d7d7d>(F.lds, (const char*)(F.w<bf16>(WS_ACT)), 512, S, E); }
    xcd_barrier(bar);
    REP(10) p10_final(F);
}

#ifndef PROBE_PH
#define PROBE_PH -1
#endif
#if PROBE_PH >= 0
__global__ void __launch_bounds__(NWAVES * 64, 2) probe_kernel(Args args) {
    extern __shared__ __attribute__((aligned(16))) unsigned char lds[];
    Frame F; F.lds = (LAS unsigned char*)lds; F.tid = threadIdx.x; F.lane = F.tid & 63; F.wave = __builtin_amdgcn_readfirstlane(F.tid >> 6);
    F.G = gridDim.x; F.gw = blockIdx.x * NWAVES + F.wave; F.ngw = F.G * NWAVES; F.ws = args.ws;
    if (PROBE_PH == 0) p0_prologue(F);
    if (PROBE_PH == 2) { p2_pooled(F); p2_scores_select(F); }
    if (PROBE_PH == 3) p3_select(F);
    if (PROBE_PH == 4) p4_attn_gather(F);
    if (PROBE_PH == 10) p10_final(F);
    if (PROBE_PH == 20) p2_scores_select(F);
    if (PROBE_PH == 21) p2_pooled(F);
    const int bx = (int)blockIdx.x;
    if (PROBE_PH == 1) {
      { pg8::DenseSched S; S.init(NTOK, 1024, 1024, F.w<bf16>(WS_WINI), F.G, bx);
        EpiInProj<true> E{F.w<bf16>(WS_ZPOOL), F.w<bf16>(WS_Q), F.w<bf16>(WS_K), F.w<bf16>(WS_V), F.w<bf16>(WS_QI), F.w<bf16>(WS_KI), F.w<bf16>(WS_GATE), F.w<float>(WS_WI)};
        pg8::gemm_phase<EpiInProj<true>, pg8::DenseSched, true>(F.lds, (const char*)F.w<bf16>(WS_H), 1024, S, E); }
      { pg8::DenseSched S; S.init(NTOK, 3584, 512, F.w<bf16>(WS_WIN), F.G, bx, 1);
        EpiInProj<false> E{F.w<bf16>(WS_ZPOOL), F.w<bf16>(WS_Q), F.w<bf16>(WS_K), F.w<bf16>(WS_V), F.w<bf16>(WS_QI), F.w<bf16>(WS_KI), F.w<bf16>(WS_GATE), F.w<float>(WS_WI)};
        pg8::gemm_phase<EpiInProj<false>, pg8::DenseSched, true, true, 0x78787878, 0x7c7c7c7c>(F.lds, (const char*)F.w<bf16>(WS_H8X), 512, S, E); } }
    if (PROBE_PH == 6) { pg8::DenseSched S; S.init(NTOK, 1024, 1024, F.w<bf16>(WS_WOUT), F.G, bx);
      EpiResidual E{F.in(IN_X), F.w<bf16>(WS_X1)};
      pg8::gemm_phase<EpiResidual, pg8::DenseSched, true>(F.lds, (const char*)F.w<bf16>(WS_MERGED), 1024, S, E); }
    if (PROBE_PH == 7) p7_router(F);
    if (PROBE_PH == 8) { build_moe_tab(F); moe_gather_fill(F, F.w<int>(WS_LIST), F.in(IN_B1)); MoeSched1 S{(const LAS int*)(F.lds + TAB_OFF), (const LAS int*)(F.lds + TAB_OFF + 4096), (const char*)F.w<bf16>(WS_W1), F.G, bx};
      EpiSwiGLU E{F.w<unsigned char>(WS_ACT), (const LAS float*)(F.lds + BIAS_OFF)};
      pg8::gemm_phase<EpiSwiGLU, MoeSched1, true, true, 0x78787878, 0x7c7c7c7c>(F.lds, (const char*)F.w<bf16>(WS_H), 512, S, E); }
    if (PROBE_PH == 9) { build_moe_tab(F); moe_rows_fill(F, F.w<int>(WS_LIST), F.w<float>(WS_TOKGATE), F.in(IN_B2)); MoeSched2 S{(const LAS int*)(F.lds + TAB_OFF), (const char*)F.w<bf16>(WS_W2), F.G, bx};
      EpiMoeOut E{F.w<unsigned char>(WS_YS), (const LAS float*)(F.lds + BIAS_OFF), (const LAS int*)(F.lds + TAB_OFF + 4096)};
      pg8::gemm_phase<EpiMoeOut, MoeSched2, true, true, 0x78787878, 0x7d7d7d7d>(F.lds, (const char*)F.w<bf16>(WS_ACT), 512, S, E); }
    if (PROBE_PH == 40) p4_attn_dense(F, (char*)lds);
    if (PROBE_PH == 99) { }
}
#endif

extern "C" void kernel_launch(void* const* d_in, const int* in_sizes, int n_in, void* d_out, int out_size, void* d_ws, size_t ws_size, hipStream_t stream) {
    static int grid = 0;
    if (grid == 0) {
        if (n_in != 17 || in_sizes[0] != NTOK * D || out_size != NTOK * D || ws_size < WS_END) { fprintf(stderr, "kernel_launch: unexpected problem shape (n_in %d, in0 %d, out %d, ws %zu)\n", n_in, n_in > 0 ? in_sizes[0] : -1, out_size, ws_size); grid = -1; return; }
        int dev = 0, cus = 0, per_cu = 0;
        if (hipGetDevice(&dev) != hipSuccess || hipDeviceGetAttribute(&cus, hipDeviceAttributeMultiprocessorCount, dev) != hipSuccess) { grid = -1; return; }
        if (hipFuncSetAttribute((const void*)fwd_kernel, hipFuncAttributeMaxDynamicSharedMemorySize, LDS_BYTES) != hipSuccess) { fprintf(stderr, "kernel_launch: hipFuncSetAttribute failed\n"); grid = -1; return; }
        if (hipOccupancyMaxActiveBlocksPerMultiprocessor(&per_cu, (const void*)fwd_kernel, NWAVES * 64, LDS_BYTES) != hipSuccess || per_cu < 1) fprintf(stderr, "kernel_launch: occupancy query reports %d\n", per_cu);
#if PROBE_PH >= 0
        (void)hipFuncSetAttribute((const void*)probe_kernel, hipFuncAttributeMaxDynamicSharedMemorySize, LDS_BYTES);
#endif
        (void)hipGetLastError();
        grid = cus;
    }
    if (grid < 0) return;
    if (hipMemsetAsync((char*)d_ws + WS_CTL, 0, CTL_ZERO_BYTES, stream) != hipSuccess) return;
    Args a{};
    for (int i = 0; i < 17; ++i) a.in[i] = (const float*)d_in[i];
    a.out = (float*)d_out; a.ws = (unsigned char*)d_ws;
    hipLaunchKernelGGL(fwd_kernel, dim3(grid), dim3(NWAVES * 64), LDS_BYTES, stream, a);
#if PROBE_PH >= 0
    hipLaunchKernelGGL(probe_kernel, dim3(grid), dim3(NWAVES * 64), LDS_BYTES, stream, a);
#endif
}
```
